# Optimizing an MI355X kernel written in HIP

```python
import math
import jax, jax.numpy as jnp
from jax import lax
import numpy as np

D_MODEL = 1024
BATCH = 8
SEQ = 4096
DEPTH = 4

FOX_HEADS = 8
FOX_HEAD_DIM = 64
FOX_WIDTH = FOX_HEADS * FOX_HEAD_DIM
Q_BLOCK = 128
RET_HEADS = 8
RET_QK_DIM = 64
RET_V_DIM = 128
RET_QK_WIDTH = RET_HEADS * RET_QK_DIM
RET_V_WIDTH = RET_HEADS * RET_V_DIM
RET_CHUNK = 128
ROPE_BASE = 10000.0
N_BRANCH = 2
IN_COLS = 3 * FOX_WIDTH + FOX_HEADS + 2 * RET_QK_WIDTH + 2 * RET_V_WIDTH + N_BRANCH * D_MODEL
D_FF = 2816
N_EXPERTS = 8
TOP_K = 2
D_FF_EXPERT = 3584
N_DENSE = (DEPTH + 1) // 2
N_MOE = DEPTH // 2
DN_ALPHA = (2 * DEPTH) ** 0.25
DN_BETA = (8 * DEPTH) ** -0.25
LN_EPS = 1e-5
RMS_EPS = 1e-6

kernel_name = "fox_retnet_gated_hybrid_deepnorm_moe"

f32 = jnp.float32


def layer_norm(x, g, b):
    xf = x.astype(f32)
    mu = jnp.mean(xf, axis=-1, keepdims=True)
    var = jnp.mean(jnp.square(xf - mu), axis=-1, keepdims=True)
    y = (xf - mu) * lax.rsqrt(var + LN_EPS) * g.astype(f32) + b.astype(f32)
    return y.astype(x.dtype)


def rotary(x, positions):
    half = x.shape[-1] // 2
    inv_freq = ROPE_BASE ** (-jnp.arange(half, dtype=f32) / half)
    ang = positions.astype(f32)[..., None] * inv_freq
    cos = jnp.cos(ang)[:, :, None, :]
    sin = jnp.sin(ang)[:, :, None, :]
    x1 = x[..., :half].astype(f32)
    x2 = x[..., half:].astype(f32)
    return jnp.concatenate([x1 * cos - x2 * sin, x1 * sin + x2 * cos], axis=-1).astype(x.dtype)


def forgetting_attention(q, k, v, log_f):
    B, S, H, dh = q.shape
    n_blk = S // Q_BLOCK
    c = jnp.cumsum(log_f, axis=1).transpose(0, 2, 1)
    kh = k.transpose(0, 2, 1, 3)
    vh = v.transpose(0, 2, 1, 3)
    qb = q.reshape(B, n_blk, Q_BLOCK, H, dh).transpose(1, 0, 3, 2, 4)
    cb = c.reshape(B, H, n_blk, Q_BLOCK).transpose(2, 0, 1, 3)
    key_pos = jnp.arange(S)
    scale = dh ** -0.5

    def one_block(args):
        i, q_i, c_i = args
        s = jnp.einsum('bhqd,bhkd->bhqk', q_i, kh, preferred_element_type=f32) * scale
        s = s + c_i[..., :, None] - c[..., None, :]
        q_pos = i * Q_BLOCK + jnp.arange(Q_BLOCK)
        causal = key_pos[None, :] <= q_pos[:, None]
        s = jnp.where(causal, s, -jnp.inf)
        p = jax.nn.softmax(s, axis=-1)
        return jnp.einsum('bhqk,bhkd->bhqd', p.astype(vh.dtype), vh)

    out = lax.map(one_block, (jnp.arange(n_blk), qb, cb))
    return out.transpose(1, 0, 3, 2, 4).reshape(B, S, H * dh)


def retention_decays():
    return jnp.log(1.0 - 2.0 ** (-5.0 - jnp.arange(RET_HEADS, dtype=f32)))


def chunkwise_retention(q, k, v, log_gamma):
    B, S, H, dk = q.shape
    dv = v.shape[-1]
    C = RET_CHUNK
    N = S // C
    qc = q.astype(f32).reshape(B, N, C, H, dk)
    kc = k.astype(f32).reshape(B, N, C, H, dk)
    vc = v.astype(f32).reshape(B, N, C, H, dv)
    idx = jnp.arange(C, dtype=f32)
    diff = idx[:, None] - idx[None, :]
    d_intra = jnp.where(diff >= 0,
                        jnp.exp(jnp.maximum(diff, 0.0)[None] * log_gamma[:, None, None]),
                        0.0)
    scores = jnp.einsum('bnihd,bnjhd->bnhij', qc, kc) * d_intra
    intra = jnp.einsum('bnhij,bnjhe->bnihe', scores, vc)
    k_dec = jnp.exp((C - 1 - idx)[:, None] * log_gamma[None, :])
    kv = jnp.einsum('bnjhd,bnjhe->bnhde', kc * k_dec[:, :, None], vc)
    chunk_decay = jnp.exp(C * log_gamma)[:, None, None]

    def step(state, kv_n):
        return chunk_decay * state + kv_n, state

    _, prev = lax.scan(step, jnp.zeros((B, H, dk, dv), f32), jnp.moveaxis(kv, 1, 0))
    prev = jnp.moveaxis(prev, 0, 1)
    q_dec = jnp.exp((idx + 1.0)[:, None] * log_gamma[None, :])
    cross = jnp.einsum('bnihd,bnhde->bnihe', qc * q_dec[:, :, None], prev)
    return (intra + cross).reshape(B, S, H, dv)


def head_rms_norm(y, g, out_dtype):
    B, S, H, dv = y.shape
    yf = y.astype(f32)
    yf = yf * lax.rsqrt(jnp.mean(yf * yf, axis=-1, keepdims=True) + RMS_EPS)
    return (yf.reshape(B, S, H * dv) * g.astype(f32)).astype(out_dtype)


def hybrid_mixer(x, positions, w_in, b_forget, ret_norm_g, w_branch_fox, w_branch_ret, w_out):
    B, S, _ = x.shape
    proj = x @ w_in
    o = 0
    q_a = proj[..., o:o + FOX_WIDTH]; o += FOX_WIDTH
    k_a = proj[..., o:o + FOX_WIDTH]; o += FOX_WIDTH
    v_a = proj[..., o:o + FOX_WIDTH]; o += FOX_WIDTH
    f_logit = proj[..., o:o + FOX_HEADS]; o += FOX_HEADS
    q_b = proj[..., o:o + RET_QK_WIDTH]; o += RET_QK_WIDTH
    k_b = proj[..., o:o + RET_QK_WIDTH]; o += RET_QK_WIDTH
    v_b = proj[..., o:o + RET_V_WIDTH]; o += RET_V_WIDTH
    g_b = proj[..., o:o + RET_V_WIDTH]; o += RET_V_WIDTH
    gate_logits = proj[..., o:o + N_BRANCH * D_MODEL]

    log_f = jax.nn.log_sigmoid(f_logit.astype(f32) + b_forget.astype(f32))
    o_a = forgetting_attention(q_a.reshape(B, S, FOX_HEADS, FOX_HEAD_DIM),
                               k_a.reshape(B, S, FOX_HEADS, FOX_HEAD_DIM),
                               v_a.reshape(B, S, FOX_HEADS, FOX_HEAD_DIM), log_f)

    qr = rotary(q_b.reshape(B, S, RET_HEADS, RET_QK_DIM), positions)
    kr = rotary(k_b.reshape(B, S, RET_HEADS, RET_QK_DIM), positions) * (RET_QK_DIM ** -0.5)
    y = chunkwise_retention(qr, kr, v_b.reshape(B, S, RET_HEADS, RET_V_DIM), retention_decays())
    o_b = jax.nn.silu(g_b) * head_rms_norm(y, ret_norm_g, x.dtype)

    gates = jax.nn.sigmoid(gate_logits).reshape(B, S, N_BRANCH, D_MODEL)
    merged = gates[:, :, 0] * (o_a @ w_branch_fox) + gates[:, :, 1] * (o_b @ w_branch_ret)
    return merged @ w_out


def swiglu(x, w_gate, w_up, w_down):
    return (jax.nn.silu(x @ w_gate) * (x @ w_up)) @ w_down


def moe_swiglu(x, w_router, e_gate, e_up, e_down):
    logits = (x @ w_router).astype(f32)
    top_val, top_idx = lax.top_k(logits, TOP_K)
    top_w = jax.nn.softmax(top_val, axis=-1)
    gate = jnp.sum(jax.nn.one_hot(top_idx, N_EXPERTS, dtype=f32) * top_w[..., None], axis=-2)
    gate = gate.astype(x.dtype)
    out = jnp.zeros_like(x)
    for e in range(N_EXPERTS):
        out = out + gate[..., e:e + 1] * swiglu(x, e_gate[e], e_up[e], e_down[e])
    return out


def setup_inputs(seed: int = 0) -> dict:
    key = jax.random.key(seed)
    ks = jax.random.split(key, 24)
    D = D_MODEL

    def nrm(k, shape, fan_in, gain=1.0):
        return jax.random.normal(k, shape, f32) * (fan_in ** -0.5) * gain

    x = jax.random.normal(ks[0], (BATCH, SEQ, D), f32)
    offsets = jax.random.randint(ks[1], (BATCH, 1), 0, 1024, dtype=jnp.int32)
    positions = (offsets + jnp.arange(SEQ, dtype=jnp.int32)[None, :]).astype(jnp.int32)

    col_scale = jnp.concatenate([
        jnp.ones((2 * FOX_WIDTH,), f32), jnp.full((FOX_WIDTH,), DN_BETA, f32),
        jnp.ones((FOX_HEADS,), f32), jnp.ones((2 * RET_QK_WIDTH,), f32),
        jnp.full((RET_V_WIDTH,), DN_BETA, f32), jnp.ones((RET_V_WIDTH + N_BRANCH * D,), f32)])
    w_in = nrm(ks[2], (DEPTH, D, IN_COLS), D) * col_scale
    b_forget = 1.0 + 3.0 * jax.random.uniform(ks[3], (DEPTH, FOX_HEADS), f32)
    ret_norm_g = 1.0 + 0.02 * jax.random.normal(ks[4], (DEPTH, RET_V_WIDTH), f32)
    w_branch_fox = nrm(ks[5], (DEPTH, FOX_WIDTH, D), FOX_WIDTH, DN_BETA)
    w_branch_ret = nrm(ks[6], (DEPTH, RET_V_WIDTH, D), RET_V_WIDTH, DN_BETA)
    w_out = nrm(ks[7], (DEPTH, D, D), D, DN_BETA)
    ln_mix_g = 1.0 + 0.02 * jax.random.normal(ks[8], (DEPTH, D), f32)
    ln_mix_b = 0.02 * jax.random.normal(ks[9], (DEPTH, D), f32)

    ffn_w_gate = nrm(ks[10], (N_DENSE, D, D_FF), D, DN_BETA)
    ffn_w_up = nrm(ks[11], (N_DENSE, D, D_FF), D, DN_BETA)
    ffn_w_down = nrm(ks[12], (N_DENSE, D_FF, D), D_FF, DN_BETA)

    moe_router = nrm(ks[13], (N_MOE, D, N_EXPERTS), D)
    moe_w_gate = nrm(ks[14], (N_MOE, N_EXPERTS, D, D_FF_EXPERT), D, DN_BETA)
    moe_w_up = nrm(ks[15], (N_MOE, N_EXPERTS, D, D_FF_EXPERT), D, DN_BETA)
    moe_w_down = nrm(ks[16], (N_MOE, N_EXPERTS, D_FF_EXPERT, D), D_FF_EXPERT, DN_BETA)

    ln_ffn_g = 1.0 + 0.02 * jax.random.normal(ks[17], (DEPTH, D), f32)
    ln_ffn_b = 0.02 * jax.random.normal(ks[18], (DEPTH, D), f32)

    return {"x": x, "positions": positions, "w_in": w_in, "b_forget": b_forget,
            "ret_norm_g": ret_norm_g, "w_branch_fox": w_branch_fox, "w_branch_ret": w_branch_ret,
            "w_out": w_out, "ln_mix_g": ln_mix_g, "ln_mix_b": ln_mix_b,
            "ffn_w_gate": ffn_w_gate, "ffn_w_up": ffn_w_up, "ffn_w_down": ffn_w_down,
            "moe_router": moe_router, "moe_w_gate": moe_w_gate, "moe_w_up": moe_w_up,
            "moe_w_down": moe_w_down, "ln_ffn_g": ln_ffn_g, "ln_ffn_b": ln_ffn_b}


def reference(x, positions, w_in, b_forget, ret_norm_g, w_branch_fox, w_branch_ret, w_out,
              ln_mix_g, ln_mix_b, ffn_w_gate, ffn_w_up, ffn_w_down, moe_router, moe_w_gate,
              moe_w_up, moe_w_down, ln_ffn_g, ln_ffn_b):
    for layer in range(DEPTH):
        h = hybrid_mixer(x, positions, w_in[layer], b_forget[layer], ret_norm_g[layer],
                         w_branch_fox[layer], w_branch_ret[layer], w_out[layer])
        x = layer_norm(DN_ALPHA * x + h, ln_mix_g[layer], ln_mix_b[layer])
        i = layer // 2
        if layer % 2 == 0:
            h = swiglu(x, ffn_w_gate[i], ffn_w_up[i], ffn_w_down[i])
        else:
            h = moe_swiglu(x, moe_router[i], moe_w_gate[i], moe_w_up[i], moe_w_down[i])
        x = layer_norm(DN_ALPHA * x + h, ln_ffn_g[layer], ln_ffn_b[layer])
    return x
```

```cpp
#include <hip/hip_runtime.h>
#include <cstdio>
#include <cstdint>
namespace pg8 {
#define PG8_LAS __attribute__((address_space(3)))
typedef unsigned short bf16_t;
typedef short bf16x8 __attribute__((ext_vector_type(8)));
typedef float f32x4 __attribute__((ext_vector_type(4)));
typedef unsigned u32x4 __attribute__((ext_vector_type(4)));
constexpr int BM = 256, BK = 64, HALF = 128, HTB = HALF * BK * 2  , STAGE_BYTES = 8 * HTB, NXCD = 8, WGM = 8;

__host__ __device__ __forceinline__ int lds_byte(int r, int c) { const int st = (r >> 4) * 2 + (c >> 5), rr = r & 15, cc = c & 31, ob = rr * 64 + cc * 2; return st * 1024 + (ob ^ (((ob >> 9) & 1) << 5)); }
__host__ __device__ __forceinline__ void stage_rc(int b, int& R, int& C) { const int st = b / 1024, sb = b % 1024, swz = sb ^ (((sb >> 9) & 1) << 5); R = (st >> 1) * 16 + swz / 64; C = (st & 1) * 32 + (swz % 64) / 2; }
__host__ __device__ __forceinline__ int perm32(int rho) { const int n = rho >> 4, i = rho & 15; return 8 * (i >> 2) + 4 * n + (i & 3); }

__device__ __forceinline__ int lane_id_opaque() { unsigned m_ = ~0u; asm volatile("" : "+s"(m_)); return (int)__builtin_amdgcn_mbcnt_hi(m_, __builtin_amdgcn_mbcnt_lo(m_, 0u)); }
struct Unit { int pm, pn, pb; };
struct Gemm { const bf16_t* A; const bf16_t* Bt; int M, N, K; };

struct StaticOrder {
    int nM, nN, nwg, G, c;
    __host__ __device__ void init(int M, int N, int G_, int c_) { nM = M / BM; nN = N / BM; nwg = nM * nN; G = G_; c = c_; }
    __host__ __device__ bool next(int i, Unit& u) const {
        const long L = (long)i * G + c; if (L >= nwg) return false;
        int wgid = (int)L; { const int q = nwg / NXCD, r = nwg % NXCD, xcd = wgid % NXCD, off = wgid / NXCD; wgid = (xcd < r ? xcd * (q + 1) : r * (q + 1) + (xcd - r) * q) + off; }
        const int nig = WGM * nN, gid = wgid / nig, fm = gid * WGM, gsz = (nM - fm) < WGM ? (nM - fm) : WGM;
        u.pm = fm + ((wgid % nig) % gsz); u.pn = (wgid % nig) / gsz; u.pb = u.pn; return true;
    }
    __device__ __forceinline__ void a_ready(const Unit&) const {}
    __device__ __forceinline__ void done(const Unit&) const {}
};

__device__ __forceinline__ unsigned cvt_pk_bf16(float lo, float hi) { unsigned r; asm volatile("v_cvt_pk_bf16_f32 %0, %1, %2" : "=v"(r) : "v"(lo), "v"(hi)); return r; }
typedef float f32x2 __attribute__((ext_vector_type(2)));
__device__ __forceinline__ f32x2 gelu_pk(f32x2 v) {
    const f32x2 av = __builtin_elementwise_abs(v), d = av * 0.2316418882f + 1.0f;
    f32x2 t; t.x = __builtin_amdgcn_rcpf(d.x); t.y = __builtin_amdgcn_rcpf(d.y);
    f32x2 q = t * 0.5307027145f + (-0.7265760135f); q = q * t + 0.7107068705f; q = q * t + (-0.142248368f); q = q * t + 0.127414796f; q = q * t;
    const f32x2 s = (v * v) * (-0.72134752044f);
    f32x2 e; e.x = __builtin_amdgcn_exp2f(s.x); e.y = __builtin_amdgcn_exp2f(s.y);
    const f32x2 m = v * (q * e), r = v - m;
    f32x2 o; o.x = v.x < 0.f ? m.x : r.x; o.y = v.y < 0.f ? m.y : r.y; return o;
}

template <int ACT  > struct EpiBf16 {
    static constexpr bool PERM = true, AFTER_DRAIN = false; static_assert(ACT == 0 || ACT == 1, "EpiBf16: ACT is 0 (none) or 1 (gelu_pk)");
    bf16_t* O; int ldc; const float* bias; int split_cols; size_t split_stride; float scale0;
    __device__ __forceinline__ void operator()(const f32x4 (&acc)[2][2][4][2], const Unit& u, int wr, int wc, int fr, int fq) const {
        const int row0 = u.pm * BM + wr * 64 + fr; int colt = u.pn * BM; bf16_t* base = O;
        float sc = 1.f; if (split_cols) { const int t = colt / split_cols; base += (size_t)t * split_stride; colt -= t * split_cols; if (t == 0) sc = scale0; }
        const int col0 = colt + wc * 32 + 8 * fq, bcol0 = u.pn * BM + wc * 32 + 8 * fq;
        f32x4 bv[2][2];
#pragma unroll
        for (int bj = 0; bj < 2; ++bj)
#pragma unroll
            for (int n = 0; n < 2; ++n) bv[bj][n] = bias ? *(const f32x4*)(bias + bcol0 + bj * HALF + 4 * n) : (f32x4){0.f, 0.f, 0.f, 0.f};
#pragma unroll
        for (int ai = 0; ai < 2; ++ai)
#pragma unroll
            for (int m = 0; m < 4; ++m) { bf16_t* rowp = base + (size_t)(row0 + ai * HALF + m * 16) * ldc + col0;
#pragma unroll
                for (int bj = 0; bj < 2; ++bj) { f32x4 v0 = acc[ai][bj][m][0] + bv[bj][0], v1 = acc[ai][bj][m][1] + bv[bj][1];
                    if (ACT == 1) { f32x2 a = gelu_pk((f32x2){v0[0], v0[1]}), b = gelu_pk((f32x2){v0[2], v0[3]}), c = gelu_pk((f32x2){v1[0], v1[1]}), d = gelu_pk((f32x2){v1[2], v1[3]});
                        v0 = (f32x4){a.x, a.y, b.x, b.y}; v1 = (f32x4){c.x, c.y, d.x, d.y}; }
                    v0 = v0 * sc; v1 = v1 * sc; u32x4 w; w.x = cvt_pk_bf16(v0[0], v0[1]); w.y = cvt_pk_bf16(v0[2], v0[3]); w.z = cvt_pk_bf16(v1[0], v1[1]); w.w = cvt_pk_bf16(v1[2], v1[3]);
                    *(u32x4*)(rowp + bj * HALF) = w; } }
    }
};

struct PanelStats {
    unsigned* xbuf;
    unsigned* cnt;
    unsigned* tmo;
    int ntn; float eps;
    unsigned code;
    __device__ __forceinline__ bool run(const f32x4 (&v)[2][2][4][2], const Unit& u, int wr, int wc, int fr, int fq, PG8_LAS unsigned char* lds, int wid, int lane) const {
        typedef float f32x2v __attribute__((ext_vector_type(2)));
        PG8_LAS f32x2v* P = (PG8_LAS f32x2v*)lds;
        PG8_LAS f32x2v* S = (PG8_LAS f32x2v*)(lds + 8192);
        PG8_LAS unsigned* flag = (PG8_LAS unsigned*)(lds + 8192 + 2048);
#pragma unroll
        for (int ai = 0; ai < 2; ++ai)
#pragma unroll
            for (int m = 0; m < 4; ++m) {
                float s = 0.f;
#pragma unroll
                for (int bj = 0; bj < 2; ++bj)
#pragma unroll
                    for (int n = 0; n < 2; ++n) { const f32x4 x = v[ai][bj][m][n]; s += (x[0] + x[1]) + (x[2] + x[3]); }
                s += __shfl_xor(s, 16); s += __shfl_xor(s, 32);
                const float mw = s * (1.0f / 64.0f); float q = 0.f;
#pragma unroll
                for (int bj = 0; bj < 2; ++bj)
#pragma unroll
                    for (int n = 0; n < 2; ++n) { const f32x4 d = v[ai][bj][m][n] - mw; q += (d[0] * d[0] + d[1] * d[1]) + (d[2] * d[2] + d[3] * d[3]); }
                q += __shfl_xor(q, 16); q += __shfl_xor(q, 32);
                if (fq == 0) P[(ai * HALF + wr * 64 + m * 16 + fr) * 4 + wc] = (f32x2v){mw, q};
            }
        asm volatile("s_waitcnt lgkmcnt(0)" ::: "memory"); __builtin_amdgcn_s_barrier(); asm volatile("" ::: "memory");
#if defined(BROKEN_EXCHANGE_NO_WAIT)
#warning BROKEN CONTROL BUILD: the row-statistics exchange does not wait; results are wrong by design
        if (blockIdx.x >= 64) { const long long t0_ = clock64(); while (clock64() - t0_ < 60000) __builtin_amdgcn_s_sleep(8); }
#endif
        const int row = wid * 32 + (lane & 31);
        if (lane < 32) {
            const f32x2v a = P[row * 4 + 0], b = P[row * 4 + 1], c = P[row * 4 + 2], d = P[row * 4 + 3];
            const float mt = (a.x + b.x + c.x + d.x) * 0.25f;
            const float da = a.x - mt, db = b.x - mt, dc = c.x - mt, dd = d.x - mt;
            const float m2 = (a.y + b.y) + (c.y + d.y) + 64.0f * ((da * da + db * db) + (dc * dc + dd * dd));
            unsigned long long* slot = (unsigned long long*)xbuf + ((size_t)(u.pm * BM + row) * 4 + u.pn);
            __hip_atomic_store(slot, ((unsigned long long)__float_as_uint(m2) << 32) | __float_as_uint(mt), __ATOMIC_RELAXED, __HIP_MEMORY_SCOPE_AGENT);
        }
        asm volatile("s_waitcnt vmcnt(0)" ::: "memory");
        if (lane == 0) __hip_atomic_fetch_add(cnt + 64 * u.pm, 1u, __ATOMIC_RELAXED, __HIP_MEMORY_SCOPE_AGENT);
        if (wid == 0) {
            bool dead = false; const unsigned long long t0 = __builtin_amdgcn_s_memrealtime(); const unsigned want = 8u * (unsigned)ntn;
            for (;;) {
#if defined(BROKEN_EXCHANGE_NO_WAIT)
                break;
#endif
                if ((unsigned)__builtin_amdgcn_readfirstlane(__hip_atomic_load(cnt + 64 * u.pm, __ATOMIC_RELAXED, __HIP_MEMORY_SCOPE_AGENT)) >= want) break;
                if (__builtin_amdgcn_s_memrealtime() - t0 > 2000000ull) {
                    if (lane == 0) { unsigned expect = 0u; __hip_atomic_compare_exchange_strong(tmo + 1, &expect, code | (unsigned)(u.pm & 0xff), __ATOMIC_RELAXED, __ATOMIC_RELAXED, __HIP_MEMORY_SCOPE_AGENT);
                                     __hip_atomic_store(tmo, 1u, __ATOMIC_RELAXED, __HIP_MEMORY_SCOPE_AGENT); }
                    dead = true; break; }
                __builtin_amdgcn_s_sleep(2);
            }
            __builtin_amdgcn_fence(__ATOMIC_ACQUIRE, "agent");
            if (lane == 0) flag[0] = dead ? 1u : 0u;
        }
        asm volatile("s_waitcnt vmcnt(0) lgkmcnt(0)" ::: "memory"); __builtin_amdgcn_s_barrier(); asm volatile("" ::: "memory");
        const bool bad = flag[0] != 0u;
        if (lane < 32) {
            const unsigned long long* slot = (const unsigned long long*)xbuf + (size_t)(u.pm * BM + row) * 4; float mt[4], m2[4]; float ms = 0.f;
#pragma unroll
            for (int t = 0; t < 4; ++t) { if (t < ntn) { const unsigned long long w = __hip_atomic_load(slot + t, __ATOMIC_RELAXED, __HIP_MEMORY_SCOPE_AGENT); mt[t] = __uint_as_float((unsigned)w); m2[t] = __uint_as_float((unsigned)(w >> 32)); } else { mt[t] = 0.f; m2[t] = 0.f; } ms += mt[t]; }
            const float mean = ms / (float)ntn; float q = 0.f;
#pragma unroll
            for (int t = 0; t < 4; ++t) if (t < ntn) { const float dm = mt[t] - mean; q += m2[t] + 256.0f * dm * dm; }
            S[row] = (f32x2v){mean, 1.0f / sqrtf(q / (256.0f * (float)ntn) + eps)};
        }
        asm volatile("s_waitcnt lgkmcnt(0)" ::: "memory"); __builtin_amdgcn_s_barrier(); asm volatile("" ::: "memory");
        return bad;
    }
};
struct EpiLnRes {
    static constexpr bool PERM = false, AFTER_DRAIN = true;
    const float* base; float* out; int ldc; const float* bias; PanelStats st; unsigned poison;
    __device__ __forceinline__ void fused(f32x4 (&acc)[2][2][4][2], const Unit& u, int wr, int wc, int fr, int fq, PG8_LAS unsigned char* lds, int wid, int lane) const {
        typedef float f32x2v __attribute__((ext_vector_type(2)));
        const PG8_LAS f32x2v* S = (const PG8_LAS f32x2v*)(lds + 8192);
        const int col0 = u.pn * BM + wc * 32 + 4 * fq;
#pragma unroll
        for (int bj = 0; bj < 2; ++bj)
#pragma unroll
            for (int n = 0; n < 2; ++n) { const f32x4 bv = bias ? *(const f32x4*)(bias + col0 + bj * HALF + n * 16) : (f32x4){0.f, 0.f, 0.f, 0.f};
#pragma unroll
                for (int ai = 0; ai < 2; ++ai)
#pragma unroll
                    for (int m = 0; m < 4; ++m) acc[ai][bj][m][n] += bv; }
        f32x4 pre[4][2][2];
#pragma unroll
        for (int m = 0; m < 4; ++m) { const size_t off = (size_t)(u.pm * BM + wr * 64 + m * 16 + fr) * ldc + col0;
#pragma unroll
            for (int bj = 0; bj < 2; ++bj)
#pragma unroll
                for (int n = 0; n < 2; ++n) pre[m][bj][n] = *(const f32x4*)(base + off + bj * HALF + n * 16); }
        const bool bad = st.run(acc, u, wr, wc, fr, fq, lds, wid, lane) || poison != 0u;
        const float qnan = __builtin_nanf("");
#pragma unroll
        for (int ai = 0; ai < 2; ++ai)
#pragma unroll
            for (int m = 0; m < 4; ++m) { const int r = ai * HALF + wr * 64 + m * 16 + fr; const f32x2v sr = S[r]; const size_t off = (size_t)(u.pm * BM + r) * ldc + col0;
#pragma unroll
                for (int bj = 0; bj < 2; ++bj)
#pragma unroll
                    for (int n = 0; n < 2; ++n) { const f32x4 bs = ai == 0 ? pre[m][bj][n] : *(const f32x4*)(base + off + bj * HALF + n * 16); f32x4 o = bs + (acc[ai][bj][m][n] - sr.x) * sr.y;
                        if (bad) o = (f32x4){qnan, qnan, qnan, qnan}; *(f32x4*)(out + off + bj * HALF + n * 16) = o; }
                if (m & 1) asm volatile("" ::: "memory"); }
    }
};
struct EpiLnResLn {
    static constexpr bool PERM = false, AFTER_DRAIN = true;
    const float* base; float* out; bf16_t* xn; int ldc; const float* bias; PanelStats st1, st2; unsigned poison;
    __device__ __forceinline__ void fused(f32x4 (&acc)[2][2][4][2], const Unit& u, int wr, int wc, int fr, int fq, PG8_LAS unsigned char* lds, int wid, int lane) const {
        typedef float f32x2v __attribute__((ext_vector_type(2))); typedef unsigned u32x2v __attribute__((ext_vector_type(2)));
        const PG8_LAS f32x2v* S = (const PG8_LAS f32x2v*)(lds + 8192);
        const int col0 = u.pn * BM + wc * 32 + 4 * fq;
#pragma unroll
        for (int bj = 0; bj < 2; ++bj)
#pragma unroll
            for (int n = 0; n < 2; ++n) { const f32x4 bv = bias ? *(const f32x4*)(bias + col0 + bj * HALF + n * 16) : (f32x4){0.f, 0.f, 0.f, 0.f};
#pragma unroll
                for (int ai = 0; ai < 2; ++ai)
#pragma unroll
                    for (int m = 0; m < 4; ++m) acc[ai][bj][m][n] += bv; }
        bool bad = st1.run(acc, u, wr, wc, fr, fq, lds, wid, lane) || poison != 0u;
        const float qnan = __builtin_nanf("");
#pragma unroll
        for (int ai = 0; ai < 2; ++ai)
#pragma unroll
            for (int m = 0; m < 4; ++m) { const int r = ai * HALF + wr * 64 + m * 16 + fr; const f32x2v sr = S[r]; const size_t off = (size_t)(u.pm * BM + r) * ldc + col0;
#pragma unroll
                for (int bj = 0; bj < 2; ++bj)
#pragma unroll
                    for (int n = 0; n < 2; ++n) { const f32x4 bs = *(const f32x4*)(base + off + bj * HALF + n * 16); acc[ai][bj][m][n] = bs + (acc[ai][bj][m][n] - sr.x) * sr.y; }
                asm volatile("" : "+v"(acc[ai][0][m][0]), "+v"(acc[ai][0][m][1]), "+v"(acc[ai][1][m][0]), "+v"(acc[ai][1][m][1]));
                if (m & 1) asm volatile("" ::: "memory"); }
        const bool bad1 = bad;
        bad = st2.run(acc, u, wr, wc, fr, fq, lds, wid, lane) || bad;
#pragma unroll
        for (int ai = 0; ai < 2; ++ai)
#pragma unroll
            for (int m = 0; m < 4; ++m) { const int r = ai * HALF + wr * 64 + m * 16 + fr; const f32x2v sr = S[r]; const size_t off = (size_t)(u.pm * BM + r) * ldc + col0;
#pragma unroll
                for (int bj = 0; bj < 2; ++bj)
#pragma unroll
                    for (int n = 0; n < 2; ++n) { const f32x4 x1 = acc[ai][bj][m][n]; *(f32x4*)(out + off + bj * HALF + n * 16) = bad1 ? (f32x4){qnan, qnan, qnan, qnan} : x1;
                        const f32x4 o = (x1 - sr.x) * sr.y; u32x2v w; w.x = cvt_pk_bf16(o[0], o[1]); w.y = cvt_pk_bf16(o[2], o[3]);
                        if (bad) { w.x = 0x7fc07fc0u; w.y = 0x7fc07fc0u; } *(u32x2v*)(xn + off + bj * HALF + n * 16) = w; }
                asm volatile("" ::: "memory"); }
    }
};

template <class Epi, class Sched, bool ALIGN_EPI = false, bool SP2 = false>
__device__ __forceinline__ void gemm_phase(PG8_LAS unsigned char* lds, const Gemm g, const Sched& S, const Epi& E, const int wid) {
    const int lane = lane_id_opaque(), tid = wid * 64 + lane, wr = wid >> 2, wc = wid & 3, fr = lane & 15, fq = lane >> 4;
    const int K = g.K, nt = K / BK;
    const char* gA_ = (const char*)g.A; const char* gB_ = (const char*)g.Bt; asm volatile("" : "+s"(gA_), "+s"(gB_));
    unsigned voffA[2], voffB[2];
#pragma unroll
    for (int i = 0; i < 2; ++i) { int R, C; stage_rc(tid * 16 + i * 8192, R, C); const int Rb = Epi::PERM ? ((R & ~31) + perm32(R & 31)) : R;
        voffA[i] = (unsigned)(R * K + C) * 2u; voffB[i] = (unsigned)(Rb * K + C) * 2u; }
    const size_t kstep = (size_t)(BK * 2);
    const size_t hstep = (size_t)HALF * K * 2;
    const size_t tstep = 2 * hstep;
    const unsigned ldsw = (unsigned)wid * 1024u;
    const int aoff = lds_byte(wr * 64 + fr, fq * 8), boff = lds_byte(wc * 32 + fr, fq * 8);
#define PG8_SA(b, h) (((b) * 2 + (h)) * HTB)
#define PG8_SB(b, h) ((4 + (b) * 2 + (h)) * HTB)
#define PG8_STAGE(bufoff, gbase, voff) do { _Pragma("unroll") for (int _i = 0; _i < 2; ++_i) \
        __builtin_amdgcn_global_load_lds((const unsigned*)((const char*)(gbase) + (voff)[_i]), (PG8_LAS unsigned*)(lds + (bufoff) + ldsw + _i * 8192), 16, 0, 0); } while (0)
#define PG8_LDA(dst, b, h) do { _Pragma("unroll") for (int m = 0; m < 4; ++m) _Pragma("unroll") for (int k = 0; k < 2; ++k) dst[m][k] = *(const PG8_LAS bf16x8*)(lds + PG8_SA(b, h) + aoff + m * 2048 + k * 1024); } while (0)
#define PG8_LDB(dst, b, h) do { _Pragma("unroll") for (int n = 0; n < 2; ++n) _Pragma("unroll") for (int k = 0; k < 2; ++k) dst[n][k] = *(const PG8_LAS bf16x8*)(lds + PG8_SB(b, h) + boff + n * 2048 + k * 1024); } while (0)
#define PG8_MMA(ai, bj, At, Bt) do { __builtin_amdgcn_s_setprio(1); _Pragma("unroll") for (int m = 0; m < 4; ++m) _Pragma("unroll") for (int n = 0; n < 2; ++n) _Pragma("unroll") for (int k = 0; k < 2; ++k) \
        acc[ai][bj][m][n] = __builtin_amdgcn_mfma_f32_16x16x32_bf16(Bt[n][k], At[m][k], acc[ai][bj][m][n], 0, 0, 0); __builtin_amdgcn_s_setprio(0); } while (0)
#define PG8_WAIT_V(n) asm volatile("s_waitcnt vmcnt(" #n ")" ::: "memory")
#define PG8_WAIT_L(n) asm volatile("s_waitcnt lgkmcnt(" #n ")" ::: "memory")
#define PG8_BAR __builtin_amdgcn_s_barrier()
#define PG8_SCHED __builtin_amdgcn_sched_barrier(0)
    Unit cur, nxt; int ui = 0;
    if (!S.next(0, cur)) return;
    f32x4 acc[2][2][4][2];
#pragma unroll
    for (int a = 0; a < 2; ++a)
#pragma unroll
        for (int b = 0; b < 2; ++b)
#pragma unroll
            for (int m = 0; m < 4; ++m)
#pragma unroll
                for (int n = 0; n < 2; ++n) acc[a][b][m][n] = (f32x4){0.f, 0.f, 0.f, 0.f};
    bf16x8 At[4][2], B0[2][2], B1[2][2];
    const char* cA = gA_ + (size_t)cur.pm * tstep; const char* cB = gB_ + (size_t)cur.pb * tstep;
    S.a_ready(cur);
    if constexpr (SP2) {
        PG8_STAGE(PG8_SB(0, 0), cB, voffB); PG8_STAGE(PG8_SB(0, 1), cB + hstep, voffB); PG8_STAGE(PG8_SA(0, 0), cA, voffA); PG8_STAGE(PG8_SA(0, 1), cA + hstep, voffA);
        if (wr == 1) PG8_BAR;
        PG8_WAIT_V(2); PG8_BAR;
        PG8_STAGE(PG8_SB(1, 0), cB + kstep, voffB); PG8_STAGE(PG8_SA(1, 0), cA + kstep, voffA); PG8_STAGE(PG8_SB(1, 1), cB + hstep + kstep, voffB);
        PG8_WAIT_V(6); PG8_BAR;
    } else {
        PG8_STAGE(PG8_SB(0, 0), cB, voffB); PG8_STAGE(PG8_SA(0, 0), cA, voffA); PG8_STAGE(PG8_SB(0, 1), cB + hstep, voffB); PG8_STAGE(PG8_SA(0, 1), cA + hstep, voffA);
        if (wr == 1) PG8_BAR;
        PG8_WAIT_V(4); PG8_BAR;
        PG8_STAGE(PG8_SB(1, 0), cB + kstep, voffB); PG8_STAGE(PG8_SA(1, 0), cA + kstep, voffA); PG8_STAGE(PG8_SB(1, 1), cB + hstep + kstep, voffB);
        PG8_WAIT_V(6); PG8_BAR;
    }
    for (;;) {
        const bool has_next = S.next(ui + 1, nxt);
        const char* nA = has_next ? gA_ + (size_t)nxt.pm * tstep : cA; const char* nB = has_next ? gB_ + (size_t)nxt.pb * tstep : cB;
        for (int t = 0; t < nt; t += 2) {
            const bool last = (t == nt - 2);
            const char* a1 = cA + (size_t)(t + 1) * kstep;
            const char* a2 = last ? nA : cA + (size_t)(t + 2) * kstep; const char* b2 = last ? nB : cB + (size_t)(t + 2) * kstep;
            const char* a3 = a2 + kstep; const char* b3 = b2 + kstep;
            if (last && has_next) S.a_ready(nxt);
            if constexpr (SP2) {
            PG8_LDB(B0, 0, 0); PG8_LDB(B1, 0, 1); PG8_SCHED; PG8_LDA(At, 0, 0); PG8_STAGE(PG8_SA(1, 1), a1 + hstep, voffA);
            PG8_WAIT_V(8); PG8_WAIT_L(0); PG8_BAR; PG8_MMA(0, 0, At, B0); PG8_MMA(0, 1, At, B1); PG8_BAR; PG8_SCHED;
            PG8_LDA(At, 0, 1); PG8_STAGE(PG8_SB(0, 0), b2, voffB); PG8_STAGE(PG8_SB(0, 1), b2 + hstep, voffB); PG8_STAGE(PG8_SA(0, 0), a2, voffA);
            PG8_WAIT_V(8); PG8_WAIT_L(0); PG8_BAR; PG8_MMA(1, 0, At, B0); PG8_MMA(1, 1, At, B1); PG8_BAR; PG8_SCHED;
            PG8_LDB(B0, 1, 0); PG8_LDB(B1, 1, 1); PG8_SCHED; PG8_LDA(At, 1, 0); PG8_STAGE(PG8_SA(0, 1), a2 + hstep, voffA);
            PG8_WAIT_V(8); PG8_WAIT_L(0); PG8_BAR; PG8_MMA(0, 0, At, B0); PG8_MMA(0, 1, At, B1); PG8_BAR; PG8_SCHED;
            PG8_LDA(At, 1, 1); PG8_STAGE(PG8_SB(1, 0), b3, voffB); PG8_STAGE(PG8_SB(1, 1), b3 + hstep, voffB); PG8_STAGE(PG8_SA(1, 0), a3, voffA);
            PG8_WAIT_V(8); PG8_WAIT_L(0); PG8_BAR; PG8_MMA(1, 0, At, B0); PG8_MMA(1, 1, At, B1); PG8_BAR; PG8_SCHED;
            } else {
            PG8_LDB(B0, 0, 0); PG8_SCHED; PG8_LDA(At, 0, 0); PG8_STAGE(PG8_SA(1, 1), a1 + hstep, voffA);
            PG8_WAIT_L(8); PG8_BAR; PG8_WAIT_L(0); PG8_MMA(0, 0, At, B0); PG8_BAR; PG8_SCHED;
            PG8_LDB(B1, 0, 1); PG8_STAGE(PG8_SB(0, 0), b2, voffB);
            PG8_BAR; PG8_WAIT_L(0); PG8_MMA(0, 1, At, B1); PG8_BAR;
            PG8_LDA(At, 0, 1); PG8_STAGE(PG8_SA(0, 0), a2, voffA);
            PG8_BAR; PG8_WAIT_L(0); PG8_MMA(1, 0, At, B0); PG8_BAR; PG8_SCHED;
            PG8_STAGE(PG8_SB(0, 1), b2 + hstep, voffB);
            PG8_WAIT_V(6); PG8_BAR; PG8_MMA(1, 1, At, B1); PG8_BAR;
            PG8_LDB(B0, 1, 0); PG8_SCHED; PG8_LDA(At, 1, 0); PG8_STAGE(PG8_SA(0, 1), a2 + hstep, voffA);
            PG8_WAIT_L(8); PG8_BAR; PG8_WAIT_L(0); PG8_MMA(0, 0, At, B0); PG8_BAR; PG8_SCHED;
            PG8_LDB(B1, 1, 1); PG8_STAGE(PG8_SB(1, 0), b3, voffB);
            PG8_BAR; PG8_WAIT_L(0); PG8_MMA(0, 1, At, B1); PG8_BAR;
            PG8_LDA(At, 1, 1); PG8_STAGE(PG8_SA(1, 0), a3, voffA);
            PG8_BAR; PG8_WAIT_L(0); PG8_MMA(1, 0, At, B0); PG8_BAR; PG8_SCHED;
            PG8_STAGE(PG8_SB(1, 1), b3 + hstep, voffB);
            PG8_WAIT_V(6); PG8_BAR; PG8_MMA(1, 1, At, B1); PG8_BAR;
            }
        }
        if constexpr (ALIGN_EPI) { if (wr == 0) PG8_BAR; }
        if constexpr (!Epi::AFTER_DRAIN) { const int ln_ = lane_id_opaque(); const int fr_ = ln_ & 15, fq_ = ln_ >> 4; int wr_ = wr, wc_ = wc; asm volatile("" : "+s"(wr_), "+s"(wc_)); E(acc, cur, wr_, wc_, fr_, fq_); S.done(cur); }
        if (!has_next) break;
#pragma unroll
        for (int a = 0; a < 2; ++a)
#pragma unroll
            for (int b = 0; b < 2; ++b)
#pragma unroll
                for (int m = 0; m < 4; ++m)
#pragma unroll
                    for (int n = 0; n < 2; ++n) acc[a][b][m][n] = (f32x4){0.f, 0.f, 0.f, 0.f};
        cur = nxt; cA = nA; cB = nB; ++ui;
        if constexpr (ALIGN_EPI) { if (wr == 1) PG8_BAR; }
    }
    PG8_WAIT_V(0);
    if constexpr (!ALIGN_EPI) { if (wr == 0) PG8_BAR; }
    PG8_BAR;
    if constexpr (Epi::AFTER_DRAIN) { E.fused(acc, cur, wr, wc, fr, fq, lds, wid, lane); S.done(cur); }
#undef PG8_SA
#undef PG8_SB
#undef PG8_STAGE
#undef PG8_LDA
#undef PG8_LDB
#undef PG8_MMA
#undef PG8_WAIT_V
#undef PG8_WAIT_L
#undef PG8_BAR
#undef PG8_SCHED
}
}

#ifndef PG8_SP2
#define PG8_SP2 true
#endif
#ifndef PG8_ALIGN
#define PG8_ALIGN true
#endif
#include <hip/hip_bf16.h>
#include <cmath>
namespace attn_body {
using bf16=__hip_bfloat16;
using bf16x8=__attribute__((ext_vector_type(8)))short;
using s16x4=__attribute__((ext_vector_type(4)))short;
using f32x16=__attribute__((ext_vector_type(16)))float;
using u32x4=__attribute__((ext_vector_type(4)))unsigned;
constexpr int BATCH=8,NHEAD=8,SEQ=4096,D=64,DM=NHEAD*D;
constexpr int NW=8,QBLK=32,QB=QBLK*NW,KVBLK=64,NQB=SEQ/QB;
constexpr int ATTN_PITCH=DM, ATTN_UNIT_ROWS=QB;
__device__ __forceinline__ int crow(int r,int hi){return (r&3)+8*(r>>2)+4*hi;}
#define SBAR() __builtin_amdgcn_sched_barrier(0)
__device__ __forceinline__ void cmask(f32x16&p0,f32x16&p1,int jb,int qrel,int hi){
  const float NEG=-INFINITY; int kb=64*jb+4*hi;
  #pragma unroll
  for(int r=0;r<16;++r){int kv=kb+(r&3)+8*(r>>2); if(kv>qrel)p0[r]=NEG; if(kv+32>qrel)p1[r]=NEG;}
}

constexpr int NSLOT=3, SLOTB=8192;
constexpr int LDS_K=0, LDS_V=NSLOT*SLOTB, LDS_WS=2*NSLOT*SLOTB, LDS_OST=LDS_WS+NW*64*4, LDS_BYTES=LDS_OST+NW*4096, LDS_CB=86016, LDS_CBW=LDS_CB+16384;
constexpr float C2=0.125f*1.4426950408889634f;
__device__ __forceinline__ void glds16(const void*gsrc,unsigned lds_dst){unsigned keep;
  asm volatile("s_mov_b32 %0, m0\n\ts_mov_b32 m0, %2\n\ts_nop 0\n\tglobal_load_lds_dwordx4 %1, off\n\ts_mov_b32 m0, %0":"=&s"(keep):"v"(gsrc),"s"(lds_dst):"memory");}
__device__ __forceinline__ float max3f(float a,float b,float c){float r;asm("v_max3_f32 %0, %1, %2, %3":"=v"(r):"v"(a),"v"(b),"v"(c));return r;}
__device__ __forceinline__ float max2f(float a,float b){float r;asm("v_max_f32_e32 %0, %1, %2":"=v"(r):"v"(a),"v"(b));return r;}
__device__ __forceinline__ float fadd_s(float a,float b){float r;asm("v_add_f32_e32 %0, %1, %2":"=v"(r):"v"(a),"v"(b));return r;}
__device__ __forceinline__ float fsub_s(float a,float b){float r;asm("v_sub_f32_e32 %0, %1, %2":"=v"(r):"v"(a),"v"(b));return r;}
typedef float f32x2_t __attribute__((ext_vector_type(2))); typedef __bf16 bf16x2_t __attribute__((ext_vector_type(2)));
__device__ __forceinline__ unsigned cvtpk_s(float lo,float hi){f32x2_t v={lo,hi};bf16x2_t b=__builtin_convertvector(v,bf16x2_t);return __builtin_bit_cast(unsigned,b);}
#define WAIT_BAR(N) asm volatile("s_waitcnt vmcnt(" #N ") lgkmcnt(0)\n\ts_barrier":::"memory")

__device__ __forceinline__ void qkt(f32x16&p0,f32x16&p1,const char*Kslot,const bf16x8*qr,int r32,int hi){
  const char*kb=Kslot+hi*1024+r32*16;
  #pragma unroll
  for(int d0=0;d0<4;++d0){
    const bf16x8 b0=*reinterpret_cast<const bf16x8*>(kb+d0*2048);
    const bf16x8 b1=*reinterpret_cast<const bf16x8*>(kb+d0*2048+512);
    p0=__builtin_amdgcn_mfma_f32_32x32x16_bf16(b0,qr[d0],p0,0,0,0);p1=__builtin_amdgcn_mfma_f32_32x32x16_bf16(b1,qr[d0],p1,0,0,0);}
}
typedef __attribute__((address_space(3))) const char* lds_cptr;
typedef float f32x4_t __attribute__((ext_vector_type(4)));
typedef short v4i16_t __attribute__((ext_vector_type(4)));
__device__ __forceinline__ void kload8(bf16x8*kf,lds_cptr kp){
  kf[0]=*(const __attribute__((address_space(3))) bf16x8*)(kp);      kf[1]=*(const __attribute__((address_space(3))) bf16x8*)(kp+512);
  kf[2]=*(const __attribute__((address_space(3))) bf16x8*)(kp+2048); kf[3]=*(const __attribute__((address_space(3))) bf16x8*)(kp+2560);
  kf[4]=*(const __attribute__((address_space(3))) bf16x8*)(kp+4096); kf[5]=*(const __attribute__((address_space(3))) bf16x8*)(kp+4608);
  kf[6]=*(const __attribute__((address_space(3))) bf16x8*)(kp+6144); kf[7]=*(const __attribute__((address_space(3))) bf16x8*)(kp+6656);
}
__device__ __forceinline__ void kload2(bf16x8*kf,lds_cptr kp,int j){ kf[2*j]=*(const __attribute__((address_space(3))) bf16x8*)(kp+j*2048); kf[2*j+1]=*(const __attribute__((address_space(3))) bf16x8*)(kp+j*2048+512); }
__device__ __forceinline__ s16x4 vtr(lds_cptr p){ return __builtin_bit_cast(s16x4,__builtin_amdgcn_ds_read_tr16_b64_v4i16((__attribute__((address_space(3))) v4i16_t*)p)); }
__device__ __forceinline__ float rowmax(const f32x16&p0,const f32x16&p1){
  float a=max3f(p0[0],p0[1],p1[0]),b=max3f(p0[2],p0[3],p1[1]);a=max3f(a,p1[2],p1[3]);
  #pragma unroll
  for(int r=4;r<16;r+=4){a=max3f(a,p0[r],p0[r+1]);b=max3f(b,p0[r+2],p0[r+3]);a=max3f(a,p1[r],p1[r+1]);b=max3f(b,p1[r+2],p1[r+3]);}
  const float m=max2f(a,b);
  auto rr=__builtin_amdgcn_permlane32_swap(__float_as_uint(m),__float_as_uint(m),false,false);
  return max2f(__uint_as_float(rr[0]),__uint_as_float(rr[1]));
}
__device__ __forceinline__ void pv(f32x16*o,int vb,bf16x8 pa0,bf16x8 pa1,bf16x8 pa2,bf16x8 pa3){
  #pragma unroll
  for(int d0=0;d0<2;++d0){s16x4 lo[4],hi[4];
    #pragma unroll
    for(int ks=0;ks<4;++ks){
      asm volatile("ds_read_b64_tr_b16 %0,%1 offset:%c2":"=&v"(lo[ks]):"v"(vb),"i"(d0*4096+ks*1024):"memory");
      asm volatile("ds_read_b64_tr_b16 %0,%1 offset:%c2":"=&v"(hi[ks]):"v"(vb),"i"(d0*4096+ks*1024+512):"memory");}
    asm volatile("s_waitcnt lgkmcnt(0)":::"memory");SBAR();
    #define PK(k) (bf16x8){lo[k][0],lo[k][1],lo[k][2],lo[k][3],hi[k][0],hi[k][1],hi[k][2],hi[k][3]}
    o[d0]=__builtin_amdgcn_mfma_f32_32x32x16_bf16(pa0,PK(0),o[d0],0,0,0);
    o[d0]=__builtin_amdgcn_mfma_f32_32x32x16_bf16(pa1,PK(1),o[d0],0,0,0);
    o[d0]=__builtin_amdgcn_mfma_f32_32x32x16_bf16(pa2,PK(2),o[d0],0,0,0);
    o[d0]=__builtin_amdgcn_mfma_f32_32x32x16_bf16(pa3,PK(3),o[d0],0,0,0);
    #undef PK
  }
}

#ifndef ATTN_STORE16
#define ATTN_STORE16(p,v) (*(u32x4*)(p)=(v))
#endif
template<int THRL> __device__ __forceinline__ void attn_unit(int b,int h,int qb,const bf16*Q,const bf16*__restrict__ K,const bf16*__restrict__ V,bf16*O,const float*__restrict__ FL,char*shm,const int wid){
  const int lane=pg8::lane_id_opaque(),tid=wid*64+lane,r32=lane&31,hi=lane>>5;
  const long rowbase=(long)b*SEQ; const int q0=qb*QB;
  {
    typedef __attribute__((address_space(3))) float lfl;
    lfl*cl=(lfl*)((lds_cptr)shm+LDS_CB); lfl*wt=(lfl*)((lds_cptr)shm+LDS_CBW);
    const int nk=q0+QB; float v[8];
    #pragma unroll
    for(int q=0;q<8;++q){const int s=8*tid+q; v[q]=(s<nk)?FL[(rowbase+s)*8+h]:0.f;}
    #pragma unroll
    for(int q=1;q<8;++q)v[q]+=v[q-1];
    const float tot=v[7]; float x=tot;
    #pragma unroll
    for(int off=1;off<64;off<<=1){const float t=__shfl_up(x,off); if(lane>=off)x+=t;}
    if(lane==63)wt[wid]=x;
    __syncthreads();
    float woff=0.f;
    #pragma unroll
    for(int w=0;w<NW;++w){const float tw=wt[w]; if(w<wid)woff+=tw;}
    const float ex=x-tot+woff;
    #pragma unroll
    for(int q=0;q<8;++q)cl[8*tid+q]=v[q]+ex;
    __syncthreads();
  }
  typedef __attribute__((address_space(3))) const f32x4_t* lf4p; const lf4p clq=(lf4p)((lds_cptr)shm+LDS_CB)+hi;
  #define BIASLD(C0,C1,t) do{ const lf4p cp_=clq+16*(t); _Pragma("unroll") for(int i_=0;i_<4;++i_){ const f32x4_t a_=cp_[2*i_], b_=cp_[2*i_+8]; \
      C0[4*i_]=a_[0];C0[4*i_+1]=a_[1];C0[4*i_+2]=a_[2];C0[4*i_+3]=a_[3]; C1[4*i_]=b_[0];C1[4*i_+1]=b_[1];C1[4*i_+2]=b_[2];C1[4*i_+3]=b_[3]; } }while(0)
  #define BIASFIX(C0,C1) do{ _Pragma("unroll") for(int r_=0;r_<16;++r_){C0[r_]=nmh-C0[r_];C1[r_]=nmh-C1[r_];} }while(0)
  const bf16*Qw=Q+(rowbase+q0+wid*QBLK)*DM+h*D;
  const bf16*Kh=K+rowbase*DM+h*D,*Vh=V+rowbase*DM+h*D;
  const unsigned lds0=(unsigned)(uintptr_t)shm;
  float*wsf=(float*)(shm+LDS_WS)+wid*64;
  const bf16*ksrc=Kh+(long)lane*DM+wid*8;
  const bf16*vsrc=Vh+(long)(16*(wid&3)+(lane>>2))*DM+(wid>>2)*32+(lane&3)*8;
  const unsigned kdst=lds0+LDS_K+wid*1024, vdst=lds0+LDS_V+wid*1024;
  #define DMA_K(t,slot) glds16(ksrc+(long)(t)*KVBLK*DM,(unsigned)__builtin_amdgcn_readfirstlane(kdst+(slot)))
  #define DMA_V(t,slot) glds16(vsrc+(long)(t)*KVBLK*DM,(unsigned)__builtin_amdgcn_readfirstlane(vdst+(slot)))
  const int vb0=(int)(lds0+LDS_V)+((lane>>4)&1)*32+(lane&3)*8+(4*hi+((lane&15)>>2))*64;
  const char*Kbase=shm+LDS_K; bf16x8 kf[8];
  const lds_cptr shm3=(lds_cptr)shm; const lds_cptr kp0=shm3+LDS_K+hi*1024+r32*16; const lds_cptr vp0=shm3+LDS_V+((lane>>4)&1)*32+(lane&3)*8+(4*hi+((lane&15)>>2))*64;
  const int NT=(q0+QB)/KVBLK;
  DMA_K(0,0);DMA_V(0,0);DMA_K(1,SLOTB);
  bf16x8 qr[4];
  #pragma unroll
  for(int d0=0;d0<4;++d0)qr[d0]=*reinterpret_cast<const bf16x8*>(&Qw[(long)r32*DM+d0*16+hi*8]);
  float mhat=0.f,l_reg=0.f,nmh=0.f;f32x16 o[2];o[0]=f32x16{};o[1]=f32x16{};
  const int qrel=wid*QBLK+r32;
  #define CMASK(P0,P1,t) do{int jb_=(t)-(NT-4); if(jb_>=0)cmask(P0,P1,jb_,qrel,hi);}while(0)
  bool resc=false;
  #define START(P0,P1) do{ const float rm=rowmax(P0,P1); resc=false; \
    { const float dl=rm; mhat=fadd_s(mhat,dl); \
      _Pragma("unroll") for(int r=0;r<16;++r){P0[r]=fsub_s(P0[r],dl);P1[r]=fsub_s(P1[r],dl);} \
      nmh=-mhat; } \
    _Pragma("unroll") for(int r=0;r<16;++r)P0[r]=__builtin_amdgcn_exp2f(P0[r]); }while(0)
  #define RESC() do{ if(resc){ asm volatile("s_waitcnt lgkmcnt(0)":::"memory"); \
      _Pragma("unroll") for(int d_=0;d_<2;++d_) _Pragma("unroll") for(int r=0;r<16;++r)o[d_][r]*=wsf[crow(r,hi)]; } }while(0)
  f32x16 pA0,pA1,pB0,pB1;
  BIASLD(pA0,pA1,0); BIASFIX(pA0,pA1);
  int sl_prev=0,sl_cur=0,sl_next=SLOTB;
  #define ROT() do{sl_prev=sl_cur;sl_cur=sl_next;sl_next=(sl_next==(NSLOT-1)*SLOTB)?0:sl_next+SLOTB;}while(0)
  DMA_K(2,2*SLOTB);
  WAIT_BAR(3);
  qkt(pA0,pA1,Kbase,qr,r32,hi);asm volatile("s_nop 15\n\ts_nop 7":"+v"(pA0),"+v"(pA1));CMASK(pA0,pA1,0);
  START(pA0,pA1);
  _Pragma("unroll") for(int r=0;r<16;++r)pA1[r]=__builtin_amdgcn_exp2f(pA1[r]);
  WAIT_BAR(0);
  DMA_K(3,0);DMA_V(1,SLOTB);
  ROT();
  kload8(kf,kp0+sl_cur);
  BIASLD(pB0,pB1,1);
  WAIT_BAR(2);
  s16x4 vlo[8],vhi[8]; u32x4 pw0,pw1,pw2,pw3;
  #define PKW(P,B) cvtpk_s(P[B],P[B+1])
  #define PAF(k) __builtin_bit_cast(bf16x8,pw##k)
  #define VFR(i) (bf16x8){vlo[i][0],vlo[i][1],vlo[i][2],vlo[i][3],vhi[i][0],vhi[i][1],vhi[i][2],vhi[i][3]}
  #define PIN(x) asm volatile("":"+v"(x))
  #define MX3(a,b,c) __builtin_fmaxf(__builtin_fmaxf((a),(b)),(c))
  #define GAPA(MF,A0,A1,A2,A3,W0,W1,PW) do{ MF; sacc+=A0; sacc+=A1; sacc+=A2; sacc+=A3; PIN(sacc); W0; W1; PIN(PW); SBAR(); }while(0)
  #define EX(v) __builtin_amdgcn_exp2f(v)
  #define GAPB(MF,X,B) do{ MF; X[B]=EX(X[B]); X[B+1]=EX(X[B+1]); X[B+2]=EX(X[B+2]); X[B+3]=EX(X[B+3]); PIN(X); SBAR(); }while(0)
  #define VRD(i) do{ vlo[i]=vtr(vp_+(((i)>>2)*4096+((i)&3)*1024)); vhi[i]=vtr(vp_+(((i)>>2)*4096+((i)&3)*1024+512)); }while(0)
  #define KRD(G,j) do{ if(G){ kload2(kf,kp0+sl_next,j); SBAR(); } }while(0)
  #define STEP(C0,C1,P0,P1,t,GK,GV,GL) do{ SBAR(); BIASFIX(C0,C1); SBAR(); \
    const lds_cptr vp_=vp0+sl_prev; \
    VRD(0); SBAR(); float sacc=(P0[0]+P0[1]); \
    GAPA(C0=__builtin_amdgcn_mfma_f32_32x32x16_bf16(kf[0],qr[0],C0,0,0,0), P0[2],P0[3],P0[4],P0[5],     pw0[0]=PKW(P0,0), pw0[1]=PKW(P0,2), pw0); \
    VRD(4); SBAR(); GAPA(C1=__builtin_amdgcn_mfma_f32_32x32x16_bf16(kf[1],qr[0],C1,0,0,0), P0[6],P0[7],P0[8],P0[9],     pw0[2]=PKW(P0,4), pw0[3]=PKW(P0,6), pw0); \
    VRD(1); SBAR(); GAPA(C0=__builtin_amdgcn_mfma_f32_32x32x16_bf16(kf[2],qr[1],C0,0,0,0),   P0[10],P0[11],P0[12],P0[13], pw1[0]=PKW(P0,8), pw1[1]=PKW(P0,10), pw1); \
    VRD(5); SBAR(); GAPA(C1=__builtin_amdgcn_mfma_f32_32x32x16_bf16(kf[3],qr[1],C1,0,0,0),   P0[14],P0[15],P1[0],P1[1],   pw1[2]=PKW(P0,12),pw1[3]=PKW(P0,14), pw1); \
    VRD(2); SBAR(); GAPA(C0=__builtin_amdgcn_mfma_f32_32x32x16_bf16(kf[4],qr[2],C0,0,0,0),   P1[2],P1[3],P1[4],P1[5],     pw2[0]=PKW(P1,0), pw2[1]=PKW(P1,2), pw2); \
    VRD(6); SBAR(); GAPA(C1=__builtin_amdgcn_mfma_f32_32x32x16_bf16(kf[5],qr[2],C1,0,0,0),   P1[6],P1[7],P1[8],P1[9],     pw2[2]=PKW(P1,4), pw2[3]=PKW(P1,6), pw2); \
    VRD(3); SBAR(); GAPA(C0=__builtin_amdgcn_mfma_f32_32x32x16_bf16(kf[6],qr[3],C0,0,0,0),   P1[10],P1[11],P1[12],P1[13], pw3[0]=PKW(P1,8), pw3[1]=PKW(P1,10), pw3); \
    VRD(7); SBAR(); GAPA(C1=__builtin_amdgcn_mfma_f32_32x32x16_bf16(kf[7],qr[3],C1,0,0,0),   P1[14],P1[15],0.f,0.f,       pw3[2]=PKW(P1,12),pw3[3]=PKW(P1,14), pw3); \
    l_reg+=sacc; \
    if(GK){DMA_K((t)+3,sl_cur);} if(GV){DMA_V((t)+1,sl_next);} \
    CMASK(C0,C1,t); \
    { float a=MX3(C0[0],C0[1],C1[0]),b=MX3(C0[2],C0[3],C1[1]); a=MX3(a,C1[2],C1[3]); \
      _Pragma("unroll") for(int r=4;r<16;r+=4){a=MX3(a,C0[r],C0[r+1]);b=MX3(b,C0[r+2],C0[r+3]);a=MX3(a,C1[r],C1[r+1]);b=MX3(b,C1[r+2],C1[r+3]);} \
      float rm=__builtin_fmaxf(a,b); { auto rr=__builtin_amdgcn_permlane32_swap(__float_as_uint(rm),__float_as_uint(rm),false,false); rm=__builtin_fmaxf(__uint_as_float(rr[0]),__uint_as_float(rr[1])); } \
      resc=false; \
      if(__builtin_expect(__any(rm>(float)THRL),0)){ const float dl=__builtin_fmaxf(rm,0.f); mhat+=dl; \
        _Pragma("unroll") for(int r=0;r<16;++r){C0[r]-=dl;C1[r]-=dl;} \
        nmh=-mhat; \
        const float f=__builtin_amdgcn_exp2f(-dl); l_reg*=f; if(hi==0)wsf[r32]=f; resc=true; } } \
    SBAR(); \
    GAPB(o[0]=__builtin_amdgcn_mfma_f32_32x32x16_bf16(PAF(0),VFR(0),o[0],0,0,0), C0,0); \
    GAPB(o[1]=__builtin_amdgcn_mfma_f32_32x32x16_bf16(PAF(0),VFR(4),o[1],0,0,0), C0,4); \
    KRD(GL,0); GAPB(o[0]=__builtin_amdgcn_mfma_f32_32x32x16_bf16(PAF(1),VFR(1),o[0],0,0,0), C0,8); \
    KRD(GL,1); GAPB(o[1]=__builtin_amdgcn_mfma_f32_32x32x16_bf16(PAF(1),VFR(5),o[1],0,0,0), C0,12); \
    KRD(GL,2); GAPB(o[0]=__builtin_amdgcn_mfma_f32_32x32x16_bf16(PAF(2),VFR(2),o[0],0,0,0), C1,0); \
    KRD(GL,3); GAPB(o[1]=__builtin_amdgcn_mfma_f32_32x32x16_bf16(PAF(2),VFR(6),o[1],0,0,0), C1,4); \
    GAPB(o[0]=__builtin_amdgcn_mfma_f32_32x32x16_bf16(PAF(3),VFR(3),o[0],0,0,0), C1,8); \
    GAPB(o[1]=__builtin_amdgcn_mfma_f32_32x32x16_bf16(PAF(3),VFR(7),o[1],0,0,0), C1,12); \
    if(GL){BIASLD(P0,P1,(t)+1);} \
    }while(0)
  int t=1;
  #undef CMASK
  #define CMASK(P0,P1,t) do{}while(0)
  for(;t+5<NT;t+=2){
    STEP(pB0,pB1,pA0,pA1,t,true,true,true);     WAIT_BAR(2); RESC(); ROT();
    STEP(pA0,pA1,pB0,pB1,t+1,true,true,true);   WAIT_BAR(2); RESC(); ROT();
  }
  #undef CMASK
  #define CMASK(P0,P1,t) do{int jb_=(t)-(NT-4); if(jb_>=0)cmask(P0,P1,jb_,qrel,hi);}while(0)
  #define ENDW(tt) do{ if((tt)+3<NT){WAIT_BAR(2);} else if((tt)+2<NT){WAIT_BAR(1);} else {WAIT_BAR(0);} }while(0)
  for(;t+1<NT;t+=2){
    STEP(pB0,pB1,pA0,pA1,t,(t+3<NT),(t+1<NT),(t+1<NT));       ENDW(t);   RESC(); ROT();
    STEP(pA0,pA1,pB0,pB1,t+1,(t+4<NT),(t+2<NT),(t+2<NT));     ENDW(t+1); RESC(); ROT();
  }
  STEP(pB0,pB1,pA0,pA1,NT-1,false,false,false); RESC();
  { float sacc=pB0[0]+pB0[1]; _Pragma("unroll") for(int r=2;r<16;++r)sacc+=pB0[r]; _Pragma("unroll") for(int r=0;r<16;++r)sacc+=pB1[r]; l_reg+=sacc;
    pw0=(u32x4){PKW(pB0,0),PKW(pB0,2),PKW(pB0,4),PKW(pB0,6)};pw1=(u32x4){PKW(pB0,8),PKW(pB0,10),PKW(pB0,12),PKW(pB0,14)};pw2=(u32x4){PKW(pB1,0),PKW(pB1,2),PKW(pB1,4),PKW(pB1,6)};pw3=(u32x4){PKW(pB1,8),PKW(pB1,10),PKW(pB1,12),PKW(pB1,14)};
    SBAR(); pv(o,vb0+sl_cur,PAF(0),PAF(1),PAF(2),PAF(3)); }
  #undef PKW
  #undef PAF
  #undef VFR
  #undef PIN
  #undef MX3
  #undef GAPA
  #undef GAPB
  #undef EX
  #undef VRD
  #undef KRD
  #undef STEP
  #undef ENDW
  {auto rr=__builtin_amdgcn_permlane32_swap(__float_as_uint(l_reg),__float_as_uint(l_reg),false,false);l_reg=__uint_as_float(rr[0])+__uint_as_float(rr[1]);}
  if(hi==0)wsf[32+r32]=l_reg;asm volatile("s_waitcnt lgkmcnt(0)":::"memory");
  float rli[16];
  #pragma unroll
  for(int r=0;r<16;++r)rli[r]=__builtin_amdgcn_rcpf(wsf[32+crow(r,hi)]);
  bf16*Ow=O+(rowbase+q0+wid*QBLK)*DM+h*D;
  { bf16*stg=(bf16*)(shm+LDS_OST)+wid*2048;
    #pragma unroll
    for(int r=0;r<16;++r){const int orow=crow(r,hi);
      #pragma unroll
      for(int d0=0;d0<2;++d0)stg[orow*64+d0*32+r32]=__float2bfloat16(o[d0][r]*rli[r]);}
    asm volatile("s_waitcnt lgkmcnt(0)":::"memory");
    #pragma unroll
    for(int i=0;i<4;++i){const int row=i*8+(lane>>3),ch=lane&7; const u32x4 v=*(const u32x4*)(stg+row*64+ch*8); ATTN_STORE16(Ow+(long)row*DM+ch*8,v);} }
  asm volatile("s_waitcnt lgkmcnt(0)\n\ts_barrier":::"memory");
  #undef BIASLD
  #undef BIASFIX
  #undef DMA_K
  #undef DMA_V
  #undef CMASK
  #undef START
  #undef RESC
  #undef ROT
}
constexpr int ATTN_LDS_BYTES=LDS_BYTES;
struct AttnTensors { const bf16* Q; const bf16* K; const bf16* V; bf16* O; const float* FL; };
struct AttnUnit { int bh; int qb; };
struct StaticOrder {
  int vcu, G;
  __device__ __forceinline__ explicit StaticOrder(int grid,int block):vcu((grid%8==0)?(block%8)*(grid/8)+block/8:block),G(grid){}
  __device__ __forceinline__ bool next(int i,AttnUnit&u)const{ const int idx=i*G+vcu; if(idx>=1024)return false; const int v=idx&255, r=idx>>8, s=2*(v&3); u.bh=v>>2; u.qb=(r==0)?s:(r==1)?15-s:(r==2)?s+1:14-s; return true; }
  __device__ __forceinline__ void a_ready(const AttnUnit&)const{}
  __device__ __forceinline__ void done(const AttnUnit&)const{}
};
template<class Sched,int THRL=8> __device__ __forceinline__ void attn_phase(char*lds,const AttnTensors&T,const Sched&S,const int wid){
  AttnUnit u;
  for(int i=0;S.next(i,u);++i){ S.a_ready(u); attn_unit<THRL>(u.bh/NHEAD,u.bh%NHEAD,u.qb,T.Q,T.K,T.V,T.O,T.FL,lds,wid); S.done(u); }
}
#undef SBAR
#undef WAIT_BAR
}

#include <hip/hip_cooperative_groups.h>
namespace cg = cooperative_groups;

#define GAS __attribute__((address_space(1)))
#define LAS __attribute__((address_space(3)))
typedef unsigned short bf16;
typedef unsigned v4u __attribute__((ext_vector_type(4)));
typedef unsigned v2u __attribute__((ext_vector_type(2)));
typedef float f32x4 __attribute__((ext_vector_type(4)));
typedef short bf16x8 __attribute__((ext_vector_type(8)));
#define RLX_AGENT __ATOMIC_RELAXED, __HIP_MEMORY_SCOPE_AGENT
#define LDS_WAIT() asm volatile("s_waitcnt lgkmcnt(0)" ::: "memory")

constexpr int NWAVES = 8, NTHR = 512;
constexpr int BATCH = 8, SEQ = 4096, D = 1024, M = BATCH * SEQ, DEPTH = 4;
constexpr int INC = 6664, NPROJ = 6656, DFF = 2816, DFE = 3584, NEXP = 8;
constexpr float DN_ALPHA = 1.6817928305074292f, LN_EPS = 1e-5f, RMS_EPS = 1e-6f, LOG2E = 1.4426950408889634f;

constexpr size_t MiB = 1u << 20;
constexpr size_t WS_CTL = 0, WS_COS = 1 * MiB, WS_SIN = 5 * MiB, WS_FLOG = 9 * MiB, WS_RE = 10 * MiB, WS_RR = 10 * MiB + 256 * 1024, WS_RW = 10 * MiB + 512 * 1024, WS_RROW = 10 * MiB + 768 * 1024;
constexpr size_t WS_WIN = 12 * MiB, WS_WBF = 25 * MiB, WS_WBR = 26 * MiB, WS_WOUT = 28 * MiB;
constexpr size_t WS_WFF = 32 * MiB;
constexpr size_t WS_XB = 210 * MiB, WS_HB = 274 * MiB, WS_ACT = 338 * MiB, WS_END = 938 * MiB;
constexpr size_t A_QA = 0, A_KA = 32 * MiB, A_VA = 64 * MiB, A_QB = 96 * MiB, A_KB = 128 * MiB, A_VB = 160 * MiB, A_GB = 224 * MiB, A_GATE = 288 * MiB, A_OB = 416 * MiB, A_T1 = 480 * MiB, A_PT = 544 * MiB;
constexpr size_t A_H = 0;
constexpr int XS_ROWS = 2 * M + 2048;
constexpr size_t A_XS = 0, A_HS = 136 * MiB;
static_assert(A_HS + (size_t)XS_ROWS * DFE * 2 <= WS_END - WS_ACT && A_PT + 32 * MiB <= WS_END - WS_ACT, "ws map");

__device__ __forceinline__ unsigned f2bf(float f) { unsigned u = __builtin_bit_cast(unsigned, f); return (u + 0x7fffu + ((u >> 16) & 1u)) >> 16; }
__device__ __forceinline__ unsigned pk2(float lo, float hi) { return f2bf(lo) | (f2bf(hi) << 16); }
__device__ __forceinline__ float bflo(unsigned w) { return __uint_as_float(w << 16); }
__device__ __forceinline__ float bfhi(unsigned w) { return __uint_as_float(w & 0xffff0000u); }
__device__ __forceinline__ float bf2f(bf16 b) { return __uint_as_float((unsigned)b << 16); }
__device__ __forceinline__ float fsigmoid(float x) { return __builtin_amdgcn_rcpf(1.f + __expf(-x)); }
__device__ __forceinline__ float wave_sum(float v) {
#pragma unroll
    for (int o = 1; o < 64; o <<= 1) v += __shfl_xor(v, o);
    return v;
}

struct Frame {
    LAS unsigned char* lds;
    unsigned* ctl;
    int tid, lane, wave, vcu, G, cofs;
    unsigned char* ws;
};

namespace epi {
using pg8::f32x4; using pg8::Unit; using pg8::HALF; using pg8::BM; using pg8::cvt_pk_bf16;
typedef unsigned u32x4 __attribute__((ext_vector_type(4)));
typedef unsigned u32x2 __attribute__((ext_vector_type(2)));
__device__ __forceinline__ u32x4 pack8(f32x4 a, f32x4 b) { u32x4 w; w.x = cvt_pk_bf16(a[0], a[1]); w.y = cvt_pk_bf16(a[2], a[3]); w.z = cvt_pk_bf16(b[0], b[1]); w.w = cvt_pk_bf16(b[2], b[3]); return w; }
__device__ __forceinline__ u32x2 pack4(f32x4 a) { u32x2 w; w.x = cvt_pk_bf16(a[0], a[1]); w.y = cvt_pk_bf16(a[2], a[3]); return w; }
__device__ __forceinline__ f32x4 unlo(u32x4 w) { return (f32x4){bflo(w.x), bfhi(w.x), bflo(w.y), bfhi(w.y)}; }
__device__ __forceinline__ f32x4 unhi(u32x4 w) { return (f32x4){bflo(w.z), bfhi(w.z), bflo(w.w), bfhi(w.w)}; }
__device__ __forceinline__ f32x4 silu4(f32x4 v) { return (f32x4){v[0] * fsigmoid(v[0]), v[1] * fsigmoid(v[1]), v[2] * fsigmoid(v[2]), v[3] * fsigmoid(v[3])}; }
__device__ __forceinline__ f32x4 sigm4(f32x4 v) { return (f32x4){fsigmoid(v[0]), fsigmoid(v[1]), fsigmoid(v[2]), fsigmoid(v[3])}; }

struct EpiInProj {
    static constexpr bool PERM = false, AFTER_DRAIN = false;
    unsigned char* act; const float* cosT; const float* sinT;
    template <int ACT> __device__ __forceinline__ void plain(const f32x4 (&acc)[2][2][4][2], bf16* base, int ldo, int colt, float sc, int row0, int wc, int fq) const {
#pragma unroll
        for (int ai = 0; ai < 2; ++ai)
#pragma unroll
            for (int m = 0; m < 4; ++m) { bf16* rowp = base + (size_t)(row0 + ai * HALF + m * 16) * ldo + colt + wc * 32 + 8 * fq;
#pragma unroll
                for (int bj = 0; bj < 2; ++bj) { f32x4 v0 = acc[ai][bj][m][0], v1 = acc[ai][bj][m][1]; asm volatile("" : "+v"(v0), "+v"(v1));
                    if (ACT == 0) { v0 = v0 * sc; v1 = v1 * sc; } else if (ACT == 1) { v0 = silu4(v0); v1 = silu4(v1); } else { v0 = sigm4(v0); v1 = sigm4(v1); }
                    *(u32x4*)(rowp + bj * HALF) = pack8(v0, v1); }
                asm volatile("" ::: "memory"); __builtin_amdgcn_sched_barrier(0); }
    }
    __device__ __forceinline__ void operator()(const f32x4 (&acc)[2][2][4][2], const Unit& u, int wr, int wc, int fr, int fq) const {
        const int pn = u.pn, row0 = u.pm * BM + wr * 64 + fr;
        if (pn < 6) { plain<0>(acc, (bf16*)(act + A_QA + (size_t)(pn >> 1) * (32 * MiB)), 512, (pn & 1) * 256, pn < 2 ? attn_body::C2 : 1.f, row0, wc, fq); }
        else if (pn < 10) {
            bf16* base = (bf16*)(act + (pn < 8 ? A_QB : A_KB)); const float sc = pn < 8 ? 1.f : 0.125f; const int colt = (pn & 1) * 256, d0 = (wc & 1) * 16 + 4 * fq;
#pragma unroll
            for (int ai = 0; ai < 2; ++ai)
#pragma unroll
                for (int m = 0; m < 4; ++m) { const int row = row0 + ai * HALF + m * 16;
                    const f32x4 cs = *(const f32x4*)(cosT + (size_t)row * 32 + d0) * sc, sn = *(const f32x4*)(sinT + (size_t)row * 32 + d0) * sc;
#pragma unroll
                    for (int bj = 0; bj < 2; ++bj) { f32x4 x1 = acc[ai][bj][m][0], x2 = acc[ai][bj][m][1]; asm volatile("" : "+v"(x1), "+v"(x2));
                        bf16* p = base + (size_t)row * 512 + colt + (2 * bj + (wc >> 1)) * 64 + d0;
                        *(u32x2*)p = pack4(x1 * cs - x2 * sn); *(u32x2*)(p + 32) = pack4(x1 * sn + x2 * cs); }
                    asm volatile("" ::: "memory"); __builtin_amdgcn_sched_barrier(0); }
        }
        else if (pn < 14) plain<0>(acc, (bf16*)(act + A_VB), 1024, (pn - 10) * 256, 1.f, row0, wc, fq);
        else if (pn < 18) plain<1>(acc, (bf16*)(act + A_GB), 1024, (pn - 14) * 256, 1.f, row0, wc, fq);
        else plain<0>(acc, (bf16*)(act + A_GATE), 2048, (pn - 18) * 256, 1.f, row0, wc, fq);
    }
};
struct EpiGated {
    static constexpr bool PERM = false, AFTER_DRAIN = false;
    bf16* out; int ldo; const bf16* gate; int ldg; const bf16* add; float sc;
    __device__ __forceinline__ void operator()(const f32x4 (&acc)[2][2][4][2], const Unit& u, int wr, int wc, int fr, int fq) const {
        const int row0 = u.pm * BM + wr * 64 + fr, col0 = u.pn * BM + wc * 32 + 8 * fq;
#pragma unroll
        for (int ai = 0; ai < 2; ++ai)
#pragma unroll
            for (int m = 0; m < 4; ++m) { const size_t row = (size_t)(row0 + ai * HALF + m * 16);
#pragma unroll
                for (int bj = 0; bj < 2; ++bj) { f32x4 v0 = acc[ai][bj][m][0], v1 = acc[ai][bj][m][1]; asm volatile("" : "+v"(v0), "+v"(v1)); v0 = v0 * sc; v1 = v1 * sc; const int col = col0 + bj * HALF;
                    if (gate) { const u32x4 gv = *(const u32x4*)(gate + row * ldg + col); v0 = v0 * sigm4(unlo(gv)); v1 = v1 * sigm4(unhi(gv)); }
                    if (add) { const u32x4 av = *(const u32x4*)(add + row * ldo + col); v0 = v0 + unlo(av); v1 = v1 + unhi(av); }
                    *(u32x4*)(out + row * ldo + col) = pack8(v0, v1); }
                asm volatile("" ::: "memory"); __builtin_amdgcn_sched_barrier(0); }
    }
};
struct EpiSwiGLU {
    static constexpr bool PERM = false, AFTER_DRAIN = false;
    bf16* out; int ldo;
    __device__ __forceinline__ void operator()(const f32x4 (&acc)[2][2][4][2], const Unit& u, int wr, int wc, int fr, int fq) const {
        const int row0 = u.pm * BM + wr * 64 + fr, hid0 = u.pn * 128 + wc * 16 + 4 * fq;
#pragma unroll
        for (int ai = 0; ai < 2; ++ai)
#pragma unroll
            for (int m = 0; m < 4; ++m) { bf16* rowp = out + (size_t)(row0 + ai * HALF + m * 16) * ldo + hid0;
#pragma unroll
                for (int bj = 0; bj < 2; ++bj) { f32x4 v0 = acc[ai][bj][m][0], v1 = acc[ai][bj][m][1]; asm volatile("" : "+v"(v0), "+v"(v1)); *(u32x2*)(rowp + bj * 64) = pack4(silu4(v0) * v1); }
                asm volatile("" ::: "memory"); __builtin_amdgcn_sched_barrier(0); }
    }
};
struct MoeOrder {
    int ts[9]; int NT, G, c;
    __device__ __forceinline__ bool next(int i, Unit& u) const {
        const int L = i * G + c; if (L >= ts[8] * NT) return false;
        const int rt = L / NT, pn = L - rt * NT; int e = 0;
#pragma unroll
        for (int j = 1; j < 8; ++j) e += (rt >= ts[j]) ? 1 : 0;
        u.pm = rt; u.pn = pn; u.pb = e * NT + pn; return true;
    }
    __device__ __forceinline__ void a_ready(const Unit&) const {}
    __device__ __forceinline__ void done(const Unit&) const {}
};
}

enum { CM_PLAIN = 0, CM_WIN = 1, CM_GU = 2 };
template <int MODE>
__device__ __forceinline__ void conv_job(const float* A, const float* B, int K, int pitch, bf16* dst, int ngroups, int gw, int NGW, LAS float* scr, int lane) {
    const int nitems = (K >> 6) * ngroups, rho = lane & 31;
    for (int it = gw; it < nitems; it += NGW) {
        const int kb = it / ngroups, g = it - kb * ngroups, k0 = kb * 64;
        const float* src;
        if (MODE == CM_PLAIN) src = A + g * 32 + pg8::perm32(rho);
        else if (MODE == CM_GU) src = (rho < 16 ? A : B) + g * 16 + (rho & 15);
        else { const int r0 = g * 32;
            if (r0 < 1536) src = A + r0 + pg8::perm32(rho);
            else if (r0 < 2560) { const int p = r0 - 1536; src = A + 1544 + (p >> 6) * 64 + ((p >> 5) & 1) * 16 + (rho & 15) + 32 * (rho >> 4); }
            else src = A + r0 + 8 + pg8::perm32(rho); }
        src += (size_t)k0 * pitch;
#pragma unroll 8
        for (int i = 0; i < 32; ++i) { const int kk = 2 * i + (lane >> 5); scr[kk * 33 + rho] = src[(size_t)kk * pitch]; }
        LDS_WAIT();
        const int c = lane & 7;
#pragma unroll
        for (int j = 0; j < 4; ++j) { const int n = (lane >> 3) + 8 * j; const LAS float* s = scr + (8 * c) * 33 + n;
            v4u o; o.x = pk2(s[0 * 33], s[1 * 33]); o.y = pk2(s[2 * 33], s[3 * 33]); o.z = pk2(s[4 * 33], s[5 * 33]); o.w = pk2(s[6 * 33], s[7 * 33]);
            *(v4u*)(dst + (size_t)(g * 32 + n) * K + k0 + 8 * c) = o; }
        LDS_WAIT();
    }
}
__device__ __forceinline__ void conv_layer(Frame& F, const float* const* in, int l) {
    LAS float* scr = (LAS float*)(F.lds + F.wave * 16384);
    const int gw = F.vcu * NWAVES + F.wave, NGW = F.G * NWAVES;
    unsigned char* ws = F.ws;
    conv_job<CM_WIN>(in[2] + (size_t)l * D * INC, nullptr, D, INC, (bf16*)(ws + WS_WIN), NPROJ / 32, gw, NGW, scr, F.lane);
    conv_job<CM_PLAIN>(in[5] + (size_t)l * 512 * D, nullptr, 512, D, (bf16*)(ws + WS_WBF), D / 32, gw, NGW, scr, F.lane);
    conv_job<CM_PLAIN>(in[6] + (size_t)l * D * D, nullptr, D, D, (bf16*)(ws + WS_WBR), D / 32, gw, NGW, scr, F.lane);
    conv_job<CM_PLAIN>(in[7] + (size_t)l * D * D, nullptr, D, D, (bf16*)(ws + WS_WOUT), D / 32, gw, NGW, scr, F.lane);
    const int i = l >> 1;
    if ((l & 1) == 0) {
        conv_job<CM_GU>(in[10] + (size_t)i * D * DFF, in[11] + (size_t)i * D * DFF, D, DFF, (bf16*)(ws + WS_WFF), 2 * DFF / 32, gw, NGW, scr, F.lane);
        conv_job<CM_PLAIN>(in[12] + (size_t)i * DFF * D, nullptr, DFF, D, (bf16*)(ws + WS_WFF + 12 * MiB), D / 32, gw, NGW, scr, F.lane);
    } else {
        for (int e = 0; e < NEXP; ++e) {
            const size_t o = ((size_t)i * NEXP + e) * D * DFE;
            conv_job<CM_GU>(in[14] + o, in[15] + o, D, DFE, (bf16*)(ws + WS_WFF + (size_t)e * 14 * MiB), 2 * DFE / 32, gw, NGW, scr, F.lane);
            conv_job<CM_PLAIN>(in[16] + o, nullptr, DFE, D, (bf16*)(ws + WS_WFF + 112 * MiB + (size_t)e * 7 * MiB), D / 32, gw, NGW, scr, F.lane);
        }
    }
}

template <int MODE, int EXTRA>
__device__ __forceinline__ void row_pass(Frame& F, const float* xin, float* xout, const float* lng, const float* lnb, const float* Wx, int wpitch, const float* bfg) {
    LAS float* WL = (LAS float*)F.lds;
    LAS int* EL = (LAS int*)(F.lds + 32768);
    unsigned char* ws = F.ws;
    const int lane = F.lane, wid = F.wave;
    if (EXTRA) { for (int idx = F.tid; idx < 8192; idx += NTHR) { const int k = idx >> 3, hh = idx & 7; WL[hh * 1024 + k] = Wx[(size_t)k * wpitch + hh]; } }
    __syncthreads();
    f32x4 gv[4], bv[4];
    if (MODE) {
#pragma unroll
        for (int j = 0; j < 4; ++j) { gv[j] = *(const f32x4*)(lng + 4 * lane + 256 * j); bv[j] = *(const f32x4*)(lnb + 4 * lane + 256 * j); }
    }
    const bf16* HB = (const bf16*)(ws + WS_HB); const bf16* YS = (const bf16*)(ws + WS_ACT + A_XS);
    bf16* XB = (bf16*)(ws + WS_XB);
    for (int blk = blockIdx.x; blk < M / 128; blk += F.G) {
        for (int i = 0; i < 16; ++i) {
            const int lr = wid + 8 * i; const size_t row = (size_t)blk * 128 + lr;
            f32x4 v[4];
#pragma unroll
            for (int j = 0; j < 4; ++j) v[j] = *(const f32x4*)(xin + row * D + 4 * lane + 256 * j);
            if (MODE == 3) {
#pragma unroll
                for (int j = 0; j < 4; ++j) v[j] = v[j] * DN_ALPHA;
            } else if (MODE == 1) {
#pragma unroll
                for (int j = 0; j < 4; ++j) { const v2u hv = *(const v2u*)(HB + row * D + 4 * lane + 256 * j);
                    v[j] = v[j] * DN_ALPHA + (f32x4){bflo(hv.x), bfhi(hv.x), bflo(hv.y), bfhi(hv.y)}; }
            } else if (MODE == 2) {
                const int r0 = ((const int*)(ws + WS_RROW))[2 * row], r1 = ((const int*)(ws + WS_RROW))[2 * row + 1];
                const float w0 = ((const float*)(ws + WS_RW))[2 * row], w1 = ((const float*)(ws + WS_RW))[2 * row + 1];
#pragma unroll
                for (int j = 0; j < 4; ++j) { const v2u a = *(const v2u*)(YS + (size_t)r0 * D + 4 * lane + 256 * j), b = *(const v2u*)(YS + (size_t)r1 * D + 4 * lane + 256 * j);
                    v[j] = v[j] * DN_ALPHA + (f32x4){bflo(a.x), bfhi(a.x), bflo(a.y), bfhi(a.y)} * w0 + (f32x4){bflo(b.x), bfhi(b.x), bflo(b.y), bfhi(b.y)} * w1; }
            }
            if (MODE) {
                float s = 0.f;
#pragma unroll
                for (int j = 0; j < 4; ++j) s += (v[j][0] + v[j][1]) + (v[j][2] + v[j][3]);
                const float mean = wave_sum(s) * (1.f / D); float s2 = 0.f;
#pragma unroll
                for (int j = 0; j < 4; ++j) { v[j] = v[j] - mean; s2 += (v[j][0] * v[j][0] + v[j][1] * v[j][1]) + (v[j][2] * v[j][2] + v[j][3] * v[j][3]); }
                const float rstd = 1.f / sqrtf(wave_sum(s2) * (1.f / D) + LN_EPS);
#pragma unroll
                for (int j = 0; j < 4; ++j) v[j] = v[j] * rstd * gv[j] + bv[j];
            }
#pragma unroll
            for (int j = 0; j < 4; ++j) { *(f32x4*)(xout + row * D + 4 * lane + 256 * j) = v[j];
                v2u o; o.x = pk2(v[j][0], v[j][1]); o.y = pk2(v[j][2], v[j][3]); *(v2u*)(XB + row * D + 4 * lane + 256 * j) = o; }
            if (EXTRA) {
                float d8[8];
#pragma unroll
                for (int hh = 0; hh < 8; ++hh) { float a = 0.f;
#pragma unroll
                    for (int j = 0; j < 4; ++j) { const f32x4 w = *(const LAS f32x4*)(WL + hh * 1024 + 4 * lane + 256 * j); a += (v[j][0] * w[0] + v[j][1] * w[1]) + (v[j][2] * w[2] + v[j][3] * w[3]); }
                    d8[hh] = a; }
                float d4[4], d2[2], d1;
                { const bool up = lane & 1;
#pragma unroll
                  for (int q = 0; q < 4; ++q) { const float snd = up ? d8[q] : d8[q + 4]; const float r = __shfl_xor(snd, 1); d4[q] = (up ? d8[q + 4] : d8[q]) + r; } }
                { const bool up = lane & 2;
#pragma unroll
                  for (int q = 0; q < 2; ++q) { const float snd = up ? d4[q] : d4[q + 2]; const float r = __shfl_xor(snd, 2); d2[q] = (up ? d4[q + 2] : d4[q]) + r; } }
                { const bool up = lane & 4; const float snd = up ? d2[0] : d2[1]; const float r = __shfl_xor(snd, 4); d1 = (up ? d2[1] : d2[0]) + r; }
                d1 += __shfl_xor(d1, 8); d1 += __shfl_xor(d1, 16); d1 += __shfl_xor(d1, 32);
                const int myh = ((lane & 1) << 2) | (lane & 2) | ((lane >> 2) & 1);
                if (EXTRA == 1) {
                    const float z = d1 + bfg[myh];
                    const float lf = fminf(z, 0.f) - log1pf(__expf(-fabsf(z)));
                    if (lane < 8) ((float*)(ws + WS_FLOG))[row * 8 + myh] = lf * LOG2E;
                } else {
                    float lg[8];
#pragma unroll
                    for (int e = 0; e < 8; ++e) lg[e] = __shfl(d1, ((e & 4) >> 2) | (e & 2) | ((e & 1) << 2));
                    int e0 = 0; float v0 = lg[0];
#pragma unroll
                    for (int e = 1; e < 8; ++e) if (lg[e] > v0) { v0 = lg[e]; e0 = e; }
                    int e1 = -1; float v1 = -INFINITY;
#pragma unroll
                    for (int e = 0; e < 8; ++e) if (e != e0 && lg[e] > v1) { v1 = lg[e]; e1 = e; }
                    const float w1 = 1.f / (1.f + expf(v0 - v1)), w0 = 1.f - w1;
                    if (lane == 0) { EL[2 * lr] = e0; EL[2 * lr + 1] = e1;
                        ((int*)(ws + WS_RE))[2 * row] = e0; ((int*)(ws + WS_RE))[2 * row + 1] = e1;
                        ((float*)(ws + WS_RW))[2 * row] = w0; ((float*)(ws + WS_RW))[2 * row + 1] = w1; }
                }
            }
        }
        if (EXTRA == 2) {
            __syncthreads();
            int msk[4]; int cnt = 0; unsigned long long bm[4];
#pragma unroll
            for (int q = 0; q < 4; ++q) { msk[q] = (EL[q * 64 + lane] == wid); bm[q] = __ballot(msk[q]); cnt += __popcll(bm[q]); }
            int base = 0;
            if (lane == 0) base = (int)__hip_atomic_fetch_add(F.ctl + F.cofs + wid, (unsigned)cnt, RLX_AGENT);
            base = __shfl(base, 0);
            int run = base;
#pragma unroll
            for (int q = 0; q < 4; ++q) { const int entry = q * 64 + lane; const int rk = run + __popcll(bm[q] & ((1ull << lane) - 1ull));
                if (msk[q]) ((int*)(ws + WS_RR))[(size_t)blk * 256 + entry] = rk;
                run += __popcll(bm[q]); }
            __syncthreads();
        }
    }
    __syncthreads();
}

__device__ __forceinline__ void moe_starts(Frame& F, int (&rs)[9]) {
    int a = 0;
#pragma unroll
    for (int e = 0; e < 8; ++e) { rs[e] = a; const int c = (int)__hip_atomic_load(F.ctl + F.cofs + e, RLX_AGENT); a += (c + 255) & ~255; }
    rs[8] = a;
}
__device__ __forceinline__ void moe_gather(Frame& F) {
    int rs[9]; moe_starts(F, rs);
    unsigned char* ws = F.ws;
    const int gw = F.vcu * NWAVES + F.wave, NGW = F.G * NWAVES;
    const v4u* XB = (const v4u*)(ws + WS_XB); v4u* XS = (v4u*)(ws + WS_ACT + A_XS);
    for (int t = gw; t < M; t += NGW) {
        const v4u a = XB[(size_t)t * 128 + F.lane], b = XB[(size_t)t * 128 + 64 + F.lane];
#pragma unroll
        for (int k = 0; k < 2; ++k) {
            const int e = ((const int*)(ws + WS_RE))[2 * t + k], rel = ((const int*)(ws + WS_RR))[2 * t + k];
            int st = 0;
#pragma unroll
            for (int j = 0; j < 8; ++j) st = (e == j) ? rs[j] : st;
            const int row = st + rel;
            if (F.lane == 0) ((int*)(ws + WS_RROW))[2 * t + k] = row;
            XS[(size_t)row * 128 + F.lane] = a; XS[(size_t)row * 128 + 64 + F.lane] = b;
        }
    }
}

__device__ __forceinline__ void cs_table(Frame& F, const int* pos) {
    float* cosT = (float*)(F.ws + WS_COS); float* sinT = (float*)(F.ws + WS_SIN);
    const int gt = F.vcu * NTHR + F.tid, NG = F.G * NTHR;
    for (int idx = gt; idx < M * 32; idx += NG) {
        const int row = idx >> 5, i = idx & 31;
        const float inv = powf(10000.0f, -(float)i / 32.0f);
        const float ang = (float)pos[row] * inv;
        cosT[idx] = cosf(ang); sinT[idx] = sinf(ang);
    }
}

__device__ __forceinline__ void ret_state(Frame& F) {
    unsigned char* ws = F.ws;
    const bf16* KB = (const bf16*)(ws + WS_ACT + A_KB); const bf16* VB = (const bf16*)(ws + WS_ACT + A_VB); bf16* PT = (bf16*)(ws + WS_ACT + A_PT);
    const int tid = F.tid, lane = F.lane, wid = F.wave, et = wid >> 2, dt = wid & 3, fr = lane & 15, fq = lane >> 4;
    for (int it = F.vcu; it < 256; it += F.G) {
        const int b = it >> 5, h = (it >> 2) & 7, eq = it & 3;
        const float l2g = log2f(1.f - exp2f(-5.f - (float)h));
        const int j = tid & 127, pp = tid >> 7;
        const float kdec = exp2f((float)(127 - j) * l2g), cd = exp2f(128.f * l2g);
        const bf16* kp = KB + ((size_t)b * SEQ + j) * 512 + h * 64 + pp * 8;
        const bf16* vp = VB + ((size_t)b * SEQ + j) * 1024 + h * 128 + eq * 32 + pp * 8;
        f32x4 acc = {0.f, 0.f, 0.f, 0.f};
        v4u k0 = *(const v4u*)kp, k1 = *(const v4u*)(kp + 32), vv = *(const v4u*)vp;
        for (int n = 0; n < 32; ++n) {
            LAS bf16* KT = (LAS bf16*)(F.lds + (n & 1) * 26112); LAS bf16* VT = KT + 64 * 136;
#pragma unroll
            for (int i = 0; i < 4; ++i) { const unsigned a = k0[i], c = k1[i], d = vv[i];
                KT[(pp * 8 + 2 * i) * 136 + j] = (bf16)f2bf(bflo(a) * kdec); KT[(pp * 8 + 2 * i + 1) * 136 + j] = (bf16)f2bf(bfhi(a) * kdec);
                KT[(pp * 8 + 32 + 2 * i) * 136 + j] = (bf16)f2bf(bflo(c) * kdec); KT[(pp * 8 + 33 + 2 * i) * 136 + j] = (bf16)f2bf(bfhi(c) * kdec);
                VT[(pp * 8 + 2 * i) * 136 + j] = (bf16)(d & 0xffffu); VT[(pp * 8 + 2 * i + 1) * 136 + j] = (bf16)(d >> 16); }
            if (n + 1 < 32) { const size_t o = (size_t)(n + 1) * 128; k0 = *(const v4u*)(kp + o * 512); k1 = *(const v4u*)(kp + o * 512 + 32); vv = *(const v4u*)(vp + o * 1024); }
            __syncthreads();
            bf16* pt = PT + ((((size_t)b * 32 + n) * 8 + h) * 128 + eq * 32 + et * 16 + 4 * fq) * 64 + dt * 16 + fr;
#pragma unroll
            for (int q = 0; q < 4; ++q) pt[q * 64] = (bf16)f2bf(acc[q]);
            acc = acc * cd;
#pragma unroll
            for (int ks = 0; ks < 4; ++ks) {
                const bf16x8 a = *(const LAS bf16x8*)(VT + (et * 16 + fr) * 136 + ks * 32 + 8 * fq);
                const bf16x8 bb = *(const LAS bf16x8*)(KT + (dt * 16 + fr) * 136 + ks * 32 + 8 * fq);
                acc = __builtin_amdgcn_mfma_f32_16x16x32_bf16(a, bb, acc, 0, 0, 0);
            }
        }
        __syncthreads();
    }
}
__device__ __forceinline__ void ret_out(Frame& F, const float* rng) {
    unsigned char* ws = F.ws;
    const bf16* QB = (const bf16*)(ws + WS_ACT + A_QB); const bf16* KB = (const bf16*)(ws + WS_ACT + A_KB); const bf16* VB = (const bf16*)(ws + WS_ACT + A_VB);
    const bf16* GB = (const bf16*)(ws + WS_ACT + A_GB); const bf16* PT = (const bf16*)(ws + WS_ACT + A_PT); bf16* OB = (bf16*)(ws + WS_ACT + A_OB);
    LAS bf16* Qs = (LAS bf16*)F.lds; LAS bf16* Ks = Qs + 128 * 72; LAS bf16* Ps = Ks + 128 * 72; LAS bf16* VT = Ps + 128 * 72; LAS bf16* Ss = VT + 128 * 136;
    const int tid = F.tid, lane = F.lane, wid = F.wave, fr = lane & 15, fq = lane >> 4;
    for (int u = F.vcu; u < 2048; u += F.G) {
        const int b = u >> 8, n = (u >> 3) & 31, h = u & 7;
        const float l2g = log2f(1.f - exp2f(-5.f - (float)h));
        const size_t tok0 = (size_t)b * SEQ + n * 128;
#pragma unroll
        for (int i = 0; i < 2; ++i) { const int p = tid + 512 * i, r = p >> 3, c = p & 7;
            *(LAS v4u*)(Qs + r * 72 + c * 8) = *(const v4u*)(QB + (tok0 + r) * 512 + h * 64 + c * 8);
            *(LAS v4u*)(Ks + r * 72 + c * 8) = *(const v4u*)(KB + (tok0 + r) * 512 + h * 64 + c * 8);
            *(LAS v4u*)(Ps + r * 72 + c * 8) = *(const v4u*)(PT + ((((size_t)b * 32 + n) * 8 + h) * 128 + r) * 64 + c * 8); }
#pragma unroll
        for (int i = 0; i < 4; ++i) { const int p = tid + 512 * i, ep = p >> 7, j = p & 127;
            const v4u vv = *(const v4u*)(VB + (tok0 + j) * 1024 + h * 128 + ep * 8);
#pragma unroll
            for (int q = 0; q < 4; ++q) { VT[(ep * 8 + 2 * q) * 136 + j] = (bf16)(vv[q] & 0xffffu); VT[(ep * 8 + 2 * q + 1) * 136 + j] = (bf16)(vv[q] >> 16); } }
        __syncthreads();
        const int il = 16 * wid + fr;
        bf16x8 qf[2];
#pragma unroll
        for (int ks = 0; ks < 2; ++ks) qf[ks] = *(const LAS bf16x8*)(Qs + il * 72 + ks * 32 + 8 * fq);
#pragma unroll
        for (int jt = 0; jt < 8; ++jt) {
            f32x4 st = {0.f, 0.f, 0.f, 0.f};
#pragma unroll
            for (int ks = 0; ks < 2; ++ks) { const bf16x8 kf = *(const LAS bf16x8*)(Ks + (jt * 16 + fr) * 72 + ks * 32 + 8 * fq); st = __builtin_amdgcn_mfma_f32_16x16x32_bf16(kf, qf[ks], st, 0, 0, 0); }
            f32x4 o;
#pragma unroll
            for (int q = 0; q < 4; ++q) { const int jj = jt * 16 + 4 * fq + q; o[q] = (il >= jj) ? st[q] * exp2f((float)(il - jj) * l2g) : 0.f; }
            v2u w; w.x = pk2(o[0], o[1]); w.y = pk2(o[2], o[3]);
            *(LAS v2u*)(Ss + il * 136 + jt * 16 + 4 * fq) = w;
        }
        LDS_WAIT();
        f32x4 acc[8];
        const float qd = exp2f((float)(il + 1) * l2g);
#pragma unroll
        for (int et = 0; et < 8; ++et) { f32x4 a = {0.f, 0.f, 0.f, 0.f};
#pragma unroll
            for (int ks = 0; ks < 2; ++ks) { const bf16x8 pf = *(const LAS bf16x8*)(Ps + (et * 16 + fr) * 72 + ks * 32 + 8 * fq); a = __builtin_amdgcn_mfma_f32_16x16x32_bf16(pf, qf[ks], a, 0, 0, 0); }
            acc[et] = a * qd; }
#pragma unroll
        for (int ks = 0; ks < 4; ++ks) { const bf16x8 sf = *(const LAS bf16x8*)(Ss + il * 136 + ks * 32 + 8 * fq);
#pragma unroll
            for (int et = 0; et < 8; ++et) { const bf16x8 vf = *(const LAS bf16x8*)(VT + (et * 16 + fr) * 136 + ks * 32 + 8 * fq); acc[et] = __builtin_amdgcn_mfma_f32_16x16x32_bf16(vf, sf, acc[et], 0, 0, 0); } }
        float ss = 0.f;
#pragma unroll
        for (int et = 0; et < 8; ++et) ss += (acc[et][0] * acc[et][0] + acc[et][1] * acc[et][1]) + (acc[et][2] * acc[et][2] + acc[et][3] * acc[et][3]);
        ss += __shfl_xor(ss, 16); ss += __shfl_xor(ss, 32);
        const float rn = 1.f / sqrtf(ss * (1.f / 128.f) + RMS_EPS);
        const size_t row = tok0 + il;
#pragma unroll
        for (int et = 0; et < 8; ++et) { const int e = h * 128 + et * 16 + 4 * fq;
            const f32x4 g4 = *(const f32x4*)(rng + e); const v2u gb = *(const v2u*)(GB + row * 1024 + e);
            const f32x4 o = acc[et] * rn * g4 * (f32x4){bflo(gb.x), bfhi(gb.x), bflo(gb.y), bfhi(gb.y)};
            v2u w; w.x = pk2(o[0], o[1]); w.y = pk2(o[2], o[3]); *(v2u*)(OB + row * 1024 + e) = w; }
        __syncthreads();
    }
}


#ifdef RETCHK
__device__ __forceinline__ int qerr(float e) { return e > 0.25f ? 0 : e > 0.03f ? 1 : e > 0.004f ? 2 : e > 0.0005f ? 3 : 4; }
__device__ __forceinline__ void ret_check(Frame& F, const float* const* in, const float* rng) {
    if (blockIdx.x != 0) return;
    unsigned char* ws = F.ws;
    const bf16* QB = (const bf16*)(ws + WS_ACT + A_QB); const bf16* KB = (const bf16*)(ws + WS_ACT + A_KB); const bf16* VB = (const bf16*)(ws + WS_ACT + A_VB);
    const bf16* GB = (const bf16*)(ws + WS_ACT + A_GB); const bf16* PT = (const bf16*)(ws + WS_ACT + A_PT); const bf16* OB = (const bf16*)(ws + WS_ACT + A_OB);
    const int lane = F.lane;
    float w1 = 0.f, w2 = 0.f, w3 = 0.f;
    for (int p = F.wave; p < 64; p += 8) {
        const int ti = p >> 3, h = p & 7;
        const int row = ti == 0 ? 0 : ti == 1 ? 1 : ti == 2 ? 127 : ti == 3 ? 128 : ti == 4 ? 200 : ti == 5 ? 1000 : ti == 6 ? 4095 : 4096 + 2500;
        const int b = row / SEQ, t = row % SEQ, n = t >> 7, i = t & 127;
        const float l2g = log2f(1.f - exp2f(-5.f - (float)h));
        float q[64];
#pragma unroll
        for (int d = 0; d < 64; ++d) q[d] = bf2f(QB[(size_t)row * 512 + h * 64 + d]);
        float y0 = 0.f, y1 = 0.f, yi0 = 0.f, yi1 = 0.f;
        for (int s = 0; s <= t; ++s) {
            const bf16* kr = KB + ((size_t)b * SEQ + s) * 512 + h * 64; float dot = 0.f;
#pragma unroll
            for (int d = 0; d < 64; ++d) dot += q[d] * bf2f(kr[d]);
            const float w = dot * exp2f((float)(t - s) * l2g);
            const float v0 = bf2f(VB[((size_t)b * SEQ + s) * 1024 + h * 128 + 2 * lane]), v1 = bf2f(VB[((size_t)b * SEQ + s) * 1024 + h * 128 + 2 * lane + 1]);
            y0 += w * v0; y1 += w * v1; if (s >= n * 128) { yi0 += w * v0; yi1 += w * v1; }
        }
        const bf16* pt = PT + ((((size_t)b * 32 + n) * 8 + h) * 128 + 2 * lane) * 64; float c0 = 0.f, c1 = 0.f;
#pragma unroll
        for (int d = 0; d < 64; ++d) { c0 += q[d] * bf2f(pt[d]); c1 += q[d] * bf2f(pt[64 + d]); }
        const float qd = exp2f((float)(i + 1) * l2g);
        const float z0 = yi0 + qd * c0, z1 = yi1 + qd * c1;
        const float ms = wave_sum(y0 * y0 + y1 * y1) * (1.f / 128.f), rms = sqrtf(ms) + 1e-20f;
        float e1 = fmaxf(fabsf(z0 - y0), fabsf(z1 - y1)) / rms;
#pragma unroll
        for (int o = 1; o < 64; o <<= 1) e1 = fmaxf(e1, __shfl_xor(e1, o));
        w1 = fmaxf(w1, e1);
        const float rn = 1.f / sqrtf(ms + RMS_EPS); const int e = h * 128 + 2 * lane;
        const float o0 = y0 * rn * rng[e] * bf2f(GB[(size_t)row * 1024 + e]), o1 = y1 * rn * rng[e + 1] * bf2f(GB[(size_t)row * 1024 + e + 1]);
        const float os = sqrtf(wave_sum(o0 * o0 + o1 * o1) * (1.f / 128.f)) + 1e-20f;
        float e2 = fmaxf(fabsf(o0 - bf2f(OB[(size_t)row * 1024 + e])), fabsf(o1 - bf2f(OB[(size_t)row * 1024 + e + 1]))) / os;
#pragma unroll
        for (int o = 1; o < 64; o <<= 1) e2 = fmaxf(e2, __shfl_xor(e2, o));
        w2 = fmaxf(w2, e2);
    }
    {
        const int sel = (lane >> 1) & 3; const int cc = (3 + 37 * (lane >> 3) + F.wave * 101) % 1024;
        const int r = (sel == 0 ? 2560 : sel == 1 ? 4608 : sel == 2 ? 5632 : 3584) + cc; const int rho = r & 31; const int col = r - rho + 8 + pg8::perm32(rho);
        const bf16* WT = (const bf16*)(ws + WS_WIN); const float* W = in[2];
        float e3 = 0.f;
        for (int kk = 0; kk < 16; ++kk) { const int k = kk * 64 + ((lane & 1) * 32 + (lane >> 3) * 3 + F.wave) % 64; e3 += fabsf(bf2f(WT[(size_t)r * D + k]) - W[(size_t)k * INC + col]); }
        e3 *= (1.f / 16.f) * 30.f;
        e3 += __shfl_xor(e3, 1); e3 += __shfl_xor(e3, 8); e3 += __shfl_xor(e3, 16); e3 += __shfl_xor(e3, 32);
        w3 = e3 * (1.f / 16.f);
    }
    LAS float* red = (LAS float*)F.lds;
    if (lane == 0 || lane == 2 || lane == 4 || lane == 6) red[F.wave * 4 + (lane >> 1)] = w3;
    __syncthreads();
    if (F.tid == 0) { float s[4] = {0.f, 0.f, 0.f, 0.f}; for (int w = 0; w < 8; ++w) { s[0] += red[w * 4] * 0.125f; s[1] += red[w * 4 + 1] * 0.125f; s[2] += red[w * 4 + 2] * 0.125f; s[3] += red[w * 4 + 3] * 0.125f; }
        ((float*)F.ctl)[200] = 1000.f * (1.f + floorf(100.f * s[CHKSEL] + 0.5f)); }
    __syncthreads();
}
#endif
#ifndef PHM
#define PHM 0xffff
#endif
#ifndef ZH
#define ZH 0
#endif
#ifndef ZB
#define ZB 0
#endif
struct Args { const float* in[19]; float* out; unsigned char* ws; };
__global__ void __launch_bounds__(NTHR, 2) mega_fwd(Args args) {
    extern __shared__ __attribute__((aligned(16))) unsigned char lds[];
    cg::grid_group grid = cg::this_grid();
    Frame F;
    F.lds = (LAS unsigned char*)lds; F.ws = args.ws; F.ctl = (unsigned*)(args.ws + WS_CTL);
    F.tid = threadIdx.x; F.lane = F.tid & 63; F.wave = __builtin_amdgcn_readfirstlane(F.tid >> 6);
    F.cofs = 64; F.G = gridDim.x; { const int bx = blockIdx.x; F.vcu = (F.G % 8 == 0) ? (bx % 8) * (F.G / 8) + bx / 8 : bx; }
    unsigned char* ws = args.ws; unsigned char* act = ws + WS_ACT;
    const float* const* in = args.in;
    float* X = args.out;
    bf16* XB = (bf16*)(ws + WS_XB); bf16* HB = (bf16*)(ws + WS_HB);
    typedef pg8::StaticOrder SO;
#define GSYNC() do { asm volatile("s_waitcnt vmcnt(0) lgkmcnt(0)" ::: "memory"); grid.sync(); __builtin_amdgcn_fence(__ATOMIC_ACQUIRE, "agent"); asm volatile("s_waitcnt vmcnt(0)" ::: "memory"); } while (0)
#define OPQ() do { asm volatile("" : "+s"(F.wave), "+s"(F.vcu), "+s"(ws), "+s"(act)); F.ws = ws; F.lane = pg8::lane_id_opaque(); F.tid = F.wave * 64 + F.lane; } while (0)
#define GEMM(EpiT, OrdT, g, S, E) pg8::gemm_phase<EpiT, OrdT, true, true>(F.lds, g, S, E, F.wave)

    if (blockIdx.x == 0 && F.tid < 64) F.ctl[64 + F.tid] = 0u;
    if (PHM & 1) cs_table(F, (const int*)in[1]);
    if (PHM & 2) row_pass<0, 1>(F, in[0], X, nullptr, nullptr, in[2] + 1536, INC, in[3]);
    if (PHM & 4) conv_layer(F, in, 0);
    GSYNC();

#pragma unroll 1
    for (int l = 0; l < DEPTH; ++l) {
        const int fi = l >> 1; const bool moe = (l & 1) != 0; F.cofs = 64 + 16 * fi; OPQ();
        if (PHM & 8) { pg8::Gemm g{XB, (const bf16*)(ws + WS_WIN), M, NPROJ, D}; SO S; S.init(M, NPROJ, F.G, (int)blockIdx.x);
          epi::EpiInProj E{act, (const float*)(ws + WS_COS), (const float*)(ws + WS_SIN)};
          GEMM(epi::EpiInProj, SO, g, S, E); }
        GSYNC(); OPQ();
        if (PHM & 16) ret_state(F);
        OPQ();
        if (PHM & 32) { const attn_body::AttnTensors AT{(const attn_body::bf16*)(act + A_QA), (const attn_body::bf16*)(act + A_KA), (const attn_body::bf16*)(act + A_VA), (attn_body::bf16*)(act + A_QA), (const float*)(ws + WS_FLOG)};
          const attn_body::StaticOrder S((int)F.G, (int)blockIdx.x);
          attn_body::attn_phase<attn_body::StaticOrder>((char*)lds, AT, S, F.wave); }
        GSYNC(); OPQ();
        if (PHM & 64) ret_out(F, in[4] + (size_t)l * 1024);
        OPQ();
        if (PHM & 128) { pg8::Gemm g{(const bf16*)(act + A_QA), (const bf16*)(ws + WS_WBF), M, D, 512}; SO S; S.init(M, D, F.G, (int)blockIdx.x);
          epi::EpiGated E{(bf16*)(act + A_T1), D, (const bf16*)(act + A_GATE), 2048, nullptr, (ZB & 1) ? 0.f : 1.f};
          GEMM(epi::EpiGated, SO, g, S, E); }
        GSYNC(); OPQ();
#ifdef RETCHK
        if (l == 0) { ret_check(F, in, in[4]); OPQ(); }
#endif
        if (PHM & 128) { pg8::Gemm g{(const bf16*)(act + A_OB), (const bf16*)(ws + WS_WBR), M, D, D}; SO S; S.init(M, D, F.G, (int)blockIdx.x);
          epi::EpiGated E{(bf16*)(act + A_T1), D, (const bf16*)(act + A_GATE) + 1024, 2048, (const bf16*)(act + A_T1), (ZB & 2) ? 0.f : 1.f};
          GEMM(epi::EpiGated, SO, g, S, E); }
        GSYNC(); OPQ();
        if (PHM & 128) { pg8::Gemm g{(const bf16*)(act + A_T1), (const bf16*)(ws + WS_WOUT), M, D, D}; SO S; S.init(M, D, F.G, (int)blockIdx.x);
          epi::EpiGated E{HB, D, nullptr, 0, nullptr, 1.f};
          GEMM(epi::EpiGated, SO, g, S, E); }
        GSYNC(); OPQ();
        if (!(PHM & 256)) {} else if (moe) row_pass<(ZH & 1) ? 3 : 1, 2>(F, X, X, in[8] + (size_t)l * D, in[9] + (size_t)l * D, in[13] + (size_t)fi * D * NEXP, NEXP, nullptr);
        else row_pass<(ZH & 1) ? 3 : 1, 0>(F, X, X, in[8] + (size_t)l * D, in[9] + (size_t)l * D, nullptr, 0, nullptr);
        GSYNC(); OPQ();
        if (!(PHM & 512)) {} else if (!moe) {
            { pg8::Gemm g{XB, (const bf16*)(ws + WS_WFF), M, 2 * DFF, D}; SO S; S.init(M, 2 * DFF, F.G, (int)blockIdx.x);
              epi::EpiSwiGLU E{(bf16*)(act + A_H), DFF};
              GEMM(epi::EpiSwiGLU, SO, g, S, E); }
            GSYNC(); OPQ();
            { pg8::Gemm g{(const bf16*)(act + A_H), (const bf16*)(ws + WS_WFF + 12 * MiB), M, D, DFF}; SO S; S.init(M, D, F.G, (int)blockIdx.x);
              epi::EpiGated E{HB, D, nullptr, 0, nullptr, 1.f};
              GEMM(epi::EpiGated, SO, g, S, E); }
            GSYNC(); OPQ();
            row_pass<(ZH & 2) ? 3 : 1, 1>(F, X, X, in[17] + (size_t)l * D, in[18] + (size_t)l * D, in[2] + (size_t)(l + 1) * D * INC + 1536, INC, in[3] + (l + 1) * 8);
        } else {
            moe_gather(F);
            GSYNC(); OPQ();
            { epi::MoeOrder S; moe_starts(F, S.ts);
#pragma unroll
              for (int e = 0; e < 9; ++e) S.ts[e] >>= 8;
              S.NT = 2 * DFE / 256; S.G = F.G; S.c = (int)blockIdx.x;
              pg8::Gemm g{(const bf16*)(act + A_XS), (const bf16*)(ws + WS_WFF), XS_ROWS, 2 * DFE, D};
              epi::EpiSwiGLU E{(bf16*)(act + A_HS), DFE};
              GEMM(epi::EpiSwiGLU, epi::MoeOrder, g, S, E); }
            GSYNC(); OPQ();
            { epi::MoeOrder S; moe_starts(F, S.ts);
#pragma unroll
              for (int e = 0; e < 9; ++e) S.ts[e] >>= 8;
              S.NT = D / 256; S.G = F.G; S.c = (int)blockIdx.x;
              pg8::Gemm g{(const bf16*)(act + A_HS), (const bf16*)(ws + WS_WFF + 112 * MiB), XS_ROWS, D, DFE};
              epi::EpiGated E{(bf16*)(act + A_XS), D, nullptr, 0, nullptr, 1.f};
              GEMM(epi::EpiGated, epi::MoeOrder, g, S, E); }
            GSYNC(); OPQ();
            if (l + 1 < DEPTH) row_pass<(ZH & 4) ? 3 : 2, 1>(F, X, X, in[17] + (size_t)l * D, in[18] + (size_t)l * D, in[2] + (size_t)(l + 1) * D * INC + 1536, INC, in[3] + (l + 1) * 8);
            else row_pass<(ZH & 4) ? 3 : 2, 0>(F, X, X, in[17] + (size_t)l * D, in[18] + (size_t)l * D, nullptr, 0, nullptr);
        }
        if (l + 1 < DEPTH) { if (PHM & 4) conv_layer(F, in, l + 1); GSYNC(); }
    }
#ifdef RETCHK
    GSYNC();
    if (blockIdx.x == 0 && F.tid == 0) { X[0] = ((float*)F.ctl)[200]; }
#endif
#undef GEMM
}

constexpr int LDS_DYN = 147456;
extern "C" void kernel_launch(void* const* d_in, const int* in_sizes, int n_in, void* d_out, int out_size, void* d_ws, size_t ws_size, hipStream_t stream) {
    static int grid = 0;
    if (grid == 0) {
        if (n_in != 19 || out_size != M * D || ws_size < WS_END) { fprintf(stderr, "kernel_launch: bad shapes (n_in %d out %d ws %zu need %zu)\n", n_in, out_size, ws_size, (size_t)WS_END); grid = -1; return; }
        int dev = 0, cus = 0, per_cu = 0;
        hipGetDevice(&dev); hipDeviceGetAttribute(&cus, hipDeviceAttributeMultiprocessorCount, dev);
        if (hipFuncSetAttribute((const void*)mega_fwd, hipFuncAttributeMaxDynamicSharedMemorySize, LDS_DYN) != hipSuccess) { fprintf(stderr, "kernel_launch: hipFuncSetAttribute failed\n"); grid = -1; return; }
        if (hipOccupancyMaxActiveBlocksPerMultiprocessor(&per_cu, (const void*)mega_fwd, NTHR, LDS_DYN) != hipSuccess || per_cu < 1) { fprintf(stderr, "kernel_launch: occupancy query says %d\n", per_cu); per_cu = 1; }
        (void)hipGetLastError();
        grid = cus * per_cu;
        fprintf(stderr, "kernel_launch: grid %d (cus %d x %d)\n", grid, cus, per_cu);
    }
    if (grid < 0) return;
    (void)hipMemsetAsync((char*)d_ws + WS_CTL, 0, 4096, stream);
    Args a{};
    for (int i = 0; i < 19; ++i) a.in[i] = (const float*)d_in[i];
    a.out = (float*)d_out; a.ws = (unsigned char*)d_ws;
    void* kargs[] = {&a};
    const hipError_t e = hipLaunchCooperativeKernel((const void*)mega_fwd, dim3(grid), dim3(NTHR), kargs, LDS_DYN, stream);
    if (e != hipSuccess) fprintf(stderr, "kernel_launch: cooperative launch failed: %s (grid %d)\n", hipGetErrorString(e), grid);
}
```

```cpp
#include <hip/hip_runtime.h>
#include <cstdio>
#include <cstdint>
namespace pg8 {
#define PG8_LAS __attribute__((address_space(3)))
typedef unsigned short bf16_t;
typedef short bf16x8 __attribute__((ext_vector_type(8)));
typedef float f32x4 __attribute__((ext_vector_type(4)));
typedef unsigned u32x4 __attribute__((ext_vector_type(4)));
constexpr int BM = 256, BK = 64, HALF = 128, HTB = HALF * BK * 2  , STAGE_BYTES = 8 * HTB, NXCD = 8, WGM = 8;

__host__ __device__ __forceinline__ int lds_byte(int r, int c) { const int st = (r >> 4) * 2 + (c >> 5), rr = r & 15, cc = c & 31, ob = rr * 64 + cc * 2; return st * 1024 + (ob ^ (((ob >> 9) & 1) << 5)); }
__host__ __device__ __forceinline__ void stage_rc(int b, int& R, int& C) { const int st = b / 1024, sb = b % 1024, swz = sb ^ (((sb >> 9) & 1) << 5); R = (st >> 1) * 16 + swz / 64; C = (st & 1) * 32 + (swz % 64) / 2; }
__host__ __device__ __forceinline__ int perm32(int rho) { const int n = rho >> 4, i = rho & 15; return 8 * (i >> 2) + 4 * n + (i & 3); }

__device__ __forceinline__ int lane_id_opaque() { unsigned m_ = ~0u; asm volatile("" : "+s"(m_)); return (int)__builtin_amdgcn_mbcnt_hi(m_, __builtin_amdgcn_mbcnt_lo(m_, 0u)); }
struct Unit { int pm, pn, pb; };
struct Gemm { const bf16_t* A; const bf16_t* Bt; int M, N, K, Kp; };

struct StaticOrder {
    int nM, nN, nwg, G, c;
    __host__ __device__ void init(int M, int N, int G_, int c_) { nM = M / BM; nN = N / BM; nwg = nM * nN; G = G_; c = c_; }
    __host__ __device__ bool next(int i, Unit& u) const {
        const long L = (long)i * G + c; if (L >= nwg) return false;
        int wgid = (int)L; { const int q = nwg / NXCD, r = nwg % NXCD, xcd = wgid % NXCD, off = wgid / NXCD; wgid = (xcd < r ? xcd * (q + 1) : r * (q + 1) + (xcd - r) * q) + off; }
        const int nig = WGM * nN, gid = wgid / nig, fm = gid * WGM, gsz = (nM - fm) < WGM ? (nM - fm) : WGM;
        u.pm = fm + ((wgid % nig) % gsz); u.pn = (wgid % nig) / gsz; u.pb = u.pn; return true;
    }
    __device__ __forceinline__ void a_ready(const Unit&) const {}
    __device__ __forceinline__ void done(const Unit&) const {}
};

__device__ __forceinline__ unsigned cvt_pk_bf16(float lo, float hi) { unsigned r; asm volatile("v_cvt_pk_bf16_f32 %0, %1, %2" : "=v"(r) : "v"(lo), "v"(hi)); return r; }
typedef float f32x2 __attribute__((ext_vector_type(2)));
__device__ __forceinline__ f32x2 gelu_pk(f32x2 v) {
    const f32x2 av = __builtin_elementwise_abs(v), d = av * 0.2316418882f + 1.0f;
    f32x2 t; t.x = __builtin_amdgcn_rcpf(d.x); t.y = __builtin_amdgcn_rcpf(d.y);
    f32x2 q = t * 0.5307027145f + (-0.7265760135f); q = q * t + 0.7107068705f; q = q * t + (-0.142248368f); q = q * t + 0.127414796f; q = q * t;
    const f32x2 s = (v * v) * (-0.72134752044f);
    f32x2 e; e.x = __builtin_amdgcn_exp2f(s.x); e.y = __builtin_amdgcn_exp2f(s.y);
    const f32x2 m = v * (q * e), r = v - m;
    f32x2 o; o.x = v.x < 0.f ? m.x : r.x; o.y = v.y < 0.f ? m.y : r.y; return o;
}

template <int ACT  > struct EpiBf16 {
    static constexpr bool PERM = true, AFTER_DRAIN = false; static_assert(ACT == 0 || ACT == 1, "EpiBf16: ACT is 0 (none) or 1 (gelu_pk)");
    bf16_t* O; int ldc; const float* bias; int split_cols; size_t split_stride; float scale0;
    __device__ __forceinline__ void operator()(const f32x4 (&acc)[2][2][4][2], const Unit& u, int wr, int wc, int fr, int fq) const {
        const int row0 = u.pm * BM + wr * 64 + fr; int colt = u.pn * BM; bf16_t* base = O;
        float sc = 1.f; if (split_cols) { const int t = colt / split_cols; base += (size_t)t * split_stride; colt -= t * split_cols; if (t == 0) sc = scale0; }
        const int col0 = colt + wc * 32 + 8 * fq, bcol0 = u.pn * BM + wc * 32 + 8 * fq;
        f32x4 bv[2][2];
#pragma unroll
        for (int bj = 0; bj < 2; ++bj)
#pragma unroll
            for (int n = 0; n < 2; ++n) bv[bj][n] = bias ? *(const f32x4*)(bias + bcol0 + bj * HALF + 4 * n) : (f32x4){0.f, 0.f, 0.f, 0.f};
#pragma unroll
        for (int ai = 0; ai < 2; ++ai)
#pragma unroll
            for (int m = 0; m < 4; ++m) { bf16_t* rowp = base + (size_t)(row0 + ai * HALF + m * 16) * ldc + col0;
#pragma unroll
                for (int bj = 0; bj < 2; ++bj) { f32x4 v0 = acc[ai][bj][m][0] + bv[bj][0], v1 = acc[ai][bj][m][1] + bv[bj][1];
                    if (ACT == 1) { f32x2 a = gelu_pk((f32x2){v0[0], v0[1]}), b = gelu_pk((f32x2){v0[2], v0[3]}), c = gelu_pk((f32x2){v1[0], v1[1]}), d = gelu_pk((f32x2){v1[2], v1[3]});
                        v0 = (f32x4){a.x, a.y, b.x, b.y}; v1 = (f32x4){c.x, c.y, d.x, d.y}; }
                    v0 = v0 * sc; v1 = v1 * sc; u32x4 w; w.x = cvt_pk_bf16(v0[0], v0[1]); w.y = cvt_pk_bf16(v0[2], v0[3]); w.z = cvt_pk_bf16(v1[0], v1[1]); w.w = cvt_pk_bf16(v1[2], v1[3]);
                    *(u32x4*)(rowp + bj * HALF) = w; } }
    }
};

struct PanelStats {
    unsigned* xbuf;
    unsigned* cnt;
    unsigned* tmo;
    int ntn; float eps;
    unsigned code;
    __device__ __forceinline__ bool run(const f32x4 (&v)[2][2][4][2], const Unit& u, int wr, int wc, int fr, int fq, PG8_LAS unsigned char* lds, int wid, int lane) const {
        typedef float f32x2v __attribute__((ext_vector_type(2)));
        PG8_LAS f32x2v* P = (PG8_LAS f32x2v*)lds;
        PG8_LAS f32x2v* S = (PG8_LAS f32x2v*)(lds + 8192);
        PG8_LAS unsigned* flag = (PG8_LAS unsigned*)(lds + 8192 + 2048);
#pragma unroll
        for (int ai = 0; ai < 2; ++ai)
#pragma unroll
            for (int m = 0; m < 4; ++m) {
                float s = 0.f;
#pragma unroll
                for (int bj = 0; bj < 2; ++bj)
#pragma unroll
                    for (int n = 0; n < 2; ++n) { const f32x4 x = v[ai][bj][m][n]; s += (x[0] + x[1]) + (x[2] + x[3]); }
                s += __shfl_xor(s, 16); s += __shfl_xor(s, 32);
                const float mw = s * (1.0f / 64.0f); float q = 0.f;
#pragma unroll
                for (int bj = 0; bj < 2; ++bj)
#pragma unroll
                    for (int n = 0; n < 2; ++n) { const f32x4 d = v[ai][bj][m][n] - mw; q += (d[0] * d[0] + d[1] * d[1]) + (d[2] * d[2] + d[3] * d[3]); }
                q += __shfl_xor(q, 16); q += __shfl_xor(q, 32);
                if (fq == 0) P[(ai * HALF + wr * 64 + m * 16 + fr) * 4 + wc] = (f32x2v){mw, q};
            }
        asm volatile("s_waitcnt lgkmcnt(0)" ::: "memory"); __builtin_amdgcn_s_barrier(); asm volatile("" ::: "memory");
#if defined(BROKEN_EXCHANGE_NO_WAIT)
#warning BROKEN CONTROL BUILD: the row-statistics exchange does not wait; results are wrong by design
        if (blockIdx.x >= 64) { const long long t0_ = clock64(); while (clock64() - t0_ < 60000) __builtin_amdgcn_s_sleep(8); }
#endif
        const int row = wid * 32 + (lane & 31);
        if (lane < 32) {
            const f32x2v a = P[row * 4 + 0], b = P[row * 4 + 1], c = P[row * 4 + 2], d = P[row * 4 + 3];
            const float mt = (a.x + b.x + c.x + d.x) * 0.25f;
            const float da = a.x - mt, db = b.x - mt, dc = c.x - mt, dd = d.x - mt;
            const float m2 = (a.y + b.y) + (c.y + d.y) + 64.0f * ((da * da + db * db) + (dc * dc + dd * dd));
            unsigned long long* slot = (unsigned long long*)xbuf + ((size_t)(u.pm * BM + row) * 4 + u.pn);
            __hip_atomic_store(slot, ((unsigned long long)__float_as_uint(m2) << 32) | __float_as_uint(mt), __ATOMIC_RELAXED, __HIP_MEMORY_SCOPE_AGENT);
        }
        asm volatile("s_waitcnt vmcnt(0)" ::: "memory");
        if (lane == 0) __hip_atomic_fetch_add(cnt + 64 * u.pm, 1u, __ATOMIC_RELAXED, __HIP_MEMORY_SCOPE_AGENT);
        if (wid == 0) {
            bool dead = false; const unsigned long long t0 = __builtin_amdgcn_s_memrealtime(); const unsigned want = 8u * (unsigned)ntn;
            for (;;) {
#if defined(BROKEN_EXCHANGE_NO_WAIT)
                break;
#endif
                if ((unsigned)__builtin_amdgcn_readfirstlane(__hip_atomic_load(cnt + 64 * u.pm, __ATOMIC_RELAXED, __HIP_MEMORY_SCOPE_AGENT)) >= want) break;
                if (__builtin_amdgcn_s_memrealtime() - t0 > 2000000ull) {
                    if (lane == 0) { unsigned expect = 0u; __hip_atomic_compare_exchange_strong(tmo + 1, &expect, code | (unsigned)(u.pm & 0xff), __ATOMIC_RELAXED, __ATOMIC_RELAXED, __HIP_MEMORY_SCOPE_AGENT);
                                     __hip_atomic_store(tmo, 1u, __ATOMIC_RELAXED, __HIP_MEMORY_SCOPE_AGENT); }
                    dead = true; break; }
                __builtin_amdgcn_s_sleep(2);
            }
            __builtin_amdgcn_fence(__ATOMIC_ACQUIRE, "agent");
            if (lane == 0) flag[0] = dead ? 1u : 0u;
        }
        asm volatile("s_waitcnt vmcnt(0) lgkmcnt(0)" ::: "memory"); __builtin_amdgcn_s_barrier(); asm volatile("" ::: "memory");
        const bool bad = flag[0] != 0u;
        if (lane < 32) {
            const unsigned long long* slot = (const unsigned long long*)xbuf + (size_t)(u.pm * BM + row) * 4; float mt[4], m2[4]; float ms = 0.f;
#pragma unroll
            for (int t = 0; t < 4; ++t) { if (t < ntn) { const unsigned long long w = __hip_atomic_load(slot + t, __ATOMIC_RELAXED, __HIP_MEMORY_SCOPE_AGENT); mt[t] = __uint_as_float((unsigned)w); m2[t] = __uint_as_float((unsigned)(w >> 32)); } else { mt[t] = 0.f; m2[t] = 0.f; } ms += mt[t]; }
            const float mean = ms / (float)ntn; float q = 0.f;
#pragma unroll
            for (int t = 0; t < 4; ++t) if (t < ntn) { const float dm = mt[t] - mean; q += m2[t] + 256.0f * dm * dm; }
            S[row] = (f32x2v){mean, 1.0f / sqrtf(q / (256.0f * (float)ntn) + eps)};
        }
        asm volatile("s_waitcnt lgkmcnt(0)" ::: "memory"); __builtin_amdgcn_s_barrier(); asm volatile("" ::: "memory");
        return bad;
    }
};
struct EpiLnRes {
    static constexpr bool PERM = false, AFTER_DRAIN = true;
    const float* base; float* out; int ldc; const float* bias; PanelStats st; unsigned poison;
    __device__ __forceinline__ void fused(f32x4 (&acc)[2][2][4][2], const Unit& u, int wr, int wc, int fr, int fq, PG8_LAS unsigned char* lds, int wid, int lane) const {
        typedef float f32x2v __attribute__((ext_vector_type(2)));
        const PG8_LAS f32x2v* S = (const PG8_LAS f32x2v*)(lds + 8192);
        const int col0 = u.pn * BM + wc * 32 + 4 * fq;
#pragma unroll
        for (int bj = 0; bj < 2; ++bj)
#pragma unroll
            for (int n = 0; n < 2; ++n) { const f32x4 bv = bias ? *(const f32x4*)(bias + col0 + bj * HALF + n * 16) : (f32x4){0.f, 0.f, 0.f, 0.f};
#pragma unroll
                for (int ai = 0; ai < 2; ++ai)
#pragma unroll
                    for (int m = 0; m < 4; ++m) acc[ai][bj][m][n] += bv; }
        f32x4 pre[4][2][2];
#pragma unroll
        for (int m = 0; m < 4; ++m) { const size_t off = (size_t)(u.pm * BM + wr * 64 + m * 16 + fr) * ldc + col0;
#pragma unroll
            for (int bj = 0; bj < 2; ++bj)
#pragma unroll
                for (int n = 0; n < 2; ++n) pre[m][bj][n] = *(const f32x4*)(base + off + bj * HALF + n * 16); }
        const bool bad = st.run(acc, u, wr, wc, fr, fq, lds, wid, lane) || poison != 0u;
        const float qnan = __builtin_nanf("");
#pragma unroll
        for (int ai = 0; ai < 2; ++ai)
#pragma unroll
            for (int m = 0; m < 4; ++m) { const int r = ai * HALF + wr * 64 + m * 16 + fr; const f32x2v sr = S[r]; const size_t off = (size_t)(u.pm * BM + r) * ldc + col0;
#pragma unroll
                for (int bj = 0; bj < 2; ++bj)
#pragma unroll
                    for (int n = 0; n < 2; ++n) { const f32x4 bs = ai == 0 ? pre[m][bj][n] : *(const f32x4*)(base + off + bj * HALF + n * 16); f32x4 o = bs + (acc[ai][bj][m][n] - sr.x) * sr.y;
                        if (bad) o = (f32x4){qnan, qnan, qnan, qnan}; *(f32x4*)(out + off + bj * HALF + n * 16) = o; }
                if (m & 1) asm volatile("" ::: "memory"); }
    }
};
struct EpiLnResLn {
    static constexpr bool PERM = false, AFTER_DRAIN = true;
    const float* base; float* out; bf16_t* xn; int ldc; const float* bias; PanelStats st1, st2; unsigned poison;
    __device__ __forceinline__ void fused(f32x4 (&acc)[2][2][4][2], const Unit& u, int wr, int wc, int fr, int fq, PG8_LAS unsigned char* lds, int wid, int lane) const {
        typedef float f32x2v __attribute__((ext_vector_type(2))); typedef unsigned u32x2v __attribute__((ext_vector_type(2)));
        const PG8_LAS f32x2v* S = (const PG8_LAS f32x2v*)(lds + 8192);
        const int col0 = u.pn * BM + wc * 32 + 4 * fq;
#pragma unroll
        for (int bj = 0; bj < 2; ++bj)
#pragma unroll
            for (int n = 0; n < 2; ++n) { const f32x4 bv = bias ? *(const f32x4*)(bias + col0 + bj * HALF + n * 16) : (f32x4){0.f, 0.f, 0.f, 0.f};
#pragma unroll
                for (int ai = 0; ai < 2; ++ai)
#pragma unroll
                    for (int m = 0; m < 4; ++m) acc[ai][bj][m][n] += bv; }
        bool bad = st1.run(acc, u, wr, wc, fr, fq, lds, wid, lane) || poison != 0u;
        const float qnan = __builtin_nanf("");
#pragma unroll
        for (int ai = 0; ai < 2; ++ai)
#pragma unroll
            for (int m = 0; m < 4; ++m) { const int r = ai * HALF + wr * 64 + m * 16 + fr; const f32x2v sr = S[r]; const size_t off = (size_t)(u.pm * BM + r) * ldc + col0;
#pragma unroll
                for (int bj = 0; bj < 2; ++bj)
#pragma unroll
                    for (int n = 0; n < 2; ++n) { const f32x4 bs = *(const f32x4*)(base + off + bj * HALF + n * 16); acc[ai][bj][m][n] = bs + (acc[ai][bj][m][n] - sr.x) * sr.y; }
                asm volatile("" : "+v"(acc[ai][0][m][0]), "+v"(acc[ai][0][m][1]), "+v"(acc[ai][1][m][0]), "+v"(acc[ai][1][m][1]));
                if (m & 1) asm volatile("" ::: "memory"); }
        const bool bad1 = bad;
        bad = st2.run(acc, u, wr, wc, fr, fq, lds, wid, lane) || bad;
#pragma unroll
        for (int ai = 0; ai < 2; ++ai)
#pragma unroll
            for (int m = 0; m < 4; ++m) { const int r = ai * HALF + wr * 64 + m * 16 + fr; const f32x2v sr = S[r]; const size_t off = (size_t)(u.pm * BM + r) * ldc + col0;
#pragma unroll
                for (int bj = 0; bj < 2; ++bj)
#pragma unroll
                    for (int n = 0; n < 2; ++n) { const f32x4 x1 = acc[ai][bj][m][n]; *(f32x4*)(out + off + bj * HALF + n * 16) = bad1 ? (f32x4){qnan, qnan, qnan, qnan} : x1;
                        const f32x4 o = (x1 - sr.x) * sr.y; u32x2v w; w.x = cvt_pk_bf16(o[0], o[1]); w.y = cvt_pk_bf16(o[2], o[3]);
                        if (bad) { w.x = 0x7fc07fc0u; w.y = 0x7fc07fc0u; } *(u32x2v*)(xn + off + bj * HALF + n * 16) = w; }
                asm volatile("" ::: "memory"); }
    }
};

typedef int v4i_t __attribute__((ext_vector_type(4)));
typedef int v8i_t __attribute__((ext_vector_type(8)));
template <bool F8> struct Frag { bf16x8 v[2]; };
template <> struct Frag<true> { v8i_t v; };
template <class Epi, class Sched, bool ALIGN_EPI = false, bool SP2 = false, bool FP8 = false>
__device__ __forceinline__ void gemm_phase(PG8_LAS unsigned char* lds, const Gemm g, const Sched& S, const Epi& E, const int wid) {
    const int lane = lane_id_opaque(), tid = wid * 64 + lane, wr = wid >> 2, wc = wid & 3, fr = lane & 15, fq = lane >> 4;
    int K_ = g.K, Kp_ = g.Kp ? g.Kp : g.K; asm volatile("" : "+s"(K_), "+s"(Kp_));
    const int K = K_, nt = K / BK, Kp = Kp_;
    const char* gA_ = (const char*)g.A; const char* gB_ = (const char*)g.Bt; asm volatile("" : "+s"(gA_), "+s"(gB_));
    unsigned voffA[2], voffB[2];
#pragma unroll
    for (int i = 0; i < 2; ++i) { int R, C; stage_rc(tid * 16 + i * 8192, R, C); const int Rb = Epi::PERM ? ((R & ~31) + perm32(R & 31)) : R;
        voffA[i] = (unsigned)(R * Kp + C) * 2u; voffB[i] = (unsigned)(Rb * Kp + C) * 2u; }
    const size_t kstep = (size_t)(BK * 2);
    const size_t hstep = (size_t)HALF * Kp * 2;
    const size_t tstep = 2 * hstep;
    const unsigned ldsw = (unsigned)wid * 1024u;
    const int lf_ = FP8 ? lds_byte(fr, fq * 16) : lds_byte(fr, fq * 8);
    const int aoff = lf_ + wr * 8192, boff = lf_ + wc * 4096;
#define PG8_SA(b, h) (((b) * 2 + (h)) * HTB)
#define PG8_SB(b, h) ((4 + (b) * 2 + (h)) * HTB)
#define PG8_STAGE(bufoff, gbase, voff) do { _Pragma("unroll") for (int _i = 0; _i < 2; ++_i) { unsigned vo_ = (voff)[_i]; asm volatile("" : "+v"(vo_));     \
        __builtin_amdgcn_global_load_lds((const unsigned*)((const char*)(gbase) + vo_), (PG8_LAS unsigned*)(lds + (bufoff) + ldsw + _i * 8192), 16, 0, 0); } } while (0)
#define PG8_LDF(dst, off) do { if constexpr (FP8) { dst.v = *(const PG8_LAS v8i_t*)(lds + (off)); } \
        else { dst.v[0] = *(const PG8_LAS bf16x8*)(lds + (off)); dst.v[1] = *(const PG8_LAS bf16x8*)(lds + (off) + 1024); } } while (0)
#define PG8_LDA(dst, b, h) do { _Pragma("unroll") for (int m = 0; m < 4; ++m) PG8_LDF(dst[m], PG8_SA(b, h) + aoff + m * 2048); } while (0)
#define PG8_LDB(dst, b, h) do { _Pragma("unroll") for (int n = 0; n < 2; ++n) PG8_LDF(dst[n], PG8_SB(b, h) + boff + n * 2048); } while (0)
#define PG8_CAT8(lo, hi) __builtin_shufflevector(__builtin_bit_cast(v4i_t, lo), __builtin_bit_cast(v4i_t, hi), 0, 1, 2, 3, 4, 5, 6, 7)
#define PG8_MMA(ai, bj, At, Bt) do { __builtin_amdgcn_s_setprio(1); _Pragma("unroll") for (int m = 0; m < 4; ++m) _Pragma("unroll") for (int n = 0; n < 2; ++n) { \
        if constexpr (FP8) { asm volatile("v_mfma_f32_16x16x128_f8f6f4 %0, %1, %2, %0" : "+v"(acc[ai][bj][m][n]) : "v"(Bt[n].v), "v"(At[m].v)); }     \
        else { _Pragma("unroll") for (int k = 0; k < 2; ++k) acc[ai][bj][m][n] = __builtin_amdgcn_mfma_f32_16x16x32_bf16(Bt[n].v[k], At[m].v[k], acc[ai][bj][m][n], 0, 0, 0); } } \
        __builtin_amdgcn_s_setprio(0); } while (0)
#define PG8_WAIT_V(n) asm volatile("s_waitcnt vmcnt(" #n ")" ::: "memory")
#define PG8_WAIT_L(n) asm volatile("s_waitcnt lgkmcnt(" #n ")" ::: "memory")
#define PG8_BAR __builtin_amdgcn_s_barrier()
#define PG8_SCHED __builtin_amdgcn_sched_barrier(0)
    Unit cur, nxt; int ui = 0;
    if (!S.next(0, cur)) return;
    f32x4 acc[2][2][4][2];
#pragma unroll
    for (int a = 0; a < 2; ++a)
#pragma unroll
        for (int b = 0; b < 2; ++b)
#pragma unroll
            for (int m = 0; m < 4; ++m)
#pragma unroll
                for (int n = 0; n < 2; ++n) acc[a][b][m][n] = (f32x4){0.f, 0.f, 0.f, 0.f};
    Frag<FP8> At[4], B0[2], B1[2];
    const char* cA = gA_ + (size_t)cur.pm * tstep; const char* cB = gB_ + (size_t)cur.pb * tstep;
    S.a_ready(cur);
    if constexpr (SP2) {
        PG8_STAGE(PG8_SB(0, 0), cB, voffB); PG8_STAGE(PG8_SB(0, 1), cB + hstep, voffB); PG8_STAGE(PG8_SA(0, 0), cA, voffA); PG8_STAGE(PG8_SA(0, 1), cA + hstep, voffA);
        if (wr == 1) PG8_BAR;
        PG8_WAIT_V(2); PG8_BAR;
        PG8_STAGE(PG8_SB(1, 0), cB + kstep, voffB); PG8_STAGE(PG8_SA(1, 0), cA + kstep, voffA); PG8_STAGE(PG8_SB(1, 1), cB + hstep + kstep, voffB);
        PG8_WAIT_V(6); PG8_BAR;
    } else {
        PG8_STAGE(PG8_SB(0, 0), cB, voffB); PG8_STAGE(PG8_SA(0, 0), cA, voffA); PG8_STAGE(PG8_SB(0, 1), cB + hstep, voffB); PG8_STAGE(PG8_SA(0, 1), cA + hstep, voffA);
        if (wr == 1) PG8_BAR;
        PG8_WAIT_V(4); PG8_BAR;
        PG8_STAGE(PG8_SB(1, 0), cB + kstep, voffB); PG8_STAGE(PG8_SA(1, 0), cA + kstep, voffA); PG8_STAGE(PG8_SB(1, 1), cB + hstep + kstep, voffB);
        PG8_WAIT_V(6); PG8_BAR;
    }
    for (;;) {
        const bool has_next = S.next(ui + 1, nxt);
        const char* nA = has_next ? gA_ + (size_t)nxt.pm * tstep : cA; const char* nB = has_next ? gB_ + (size_t)nxt.pb * tstep : cB;
        for (int t = 0; t < nt; t += 2) {
            const bool last = (t == nt - 2);
            const char* a1 = cA + (size_t)(t + 1) * kstep;
            const char* a2 = last ? nA : cA + (size_t)(t + 2) * kstep; const char* b2 = last ? nB : cB + (size_t)(t + 2) * kstep;
            const char* a3 = a2 + kstep; const char* b3 = b2 + kstep;
            if (last && has_next) S.a_ready(nxt);
            if constexpr (SP2) {
            PG8_LDB(B0, 0, 0); PG8_LDB(B1, 0, 1); PG8_SCHED; PG8_LDA(At, 0, 0); PG8_STAGE(PG8_SA(1, 1), a1 + hstep, voffA);
            PG8_WAIT_V(8); PG8_WAIT_L(0); PG8_BAR; PG8_MMA(0, 0, At, B0); PG8_MMA(0, 1, At, B1); PG8_BAR; PG8_SCHED;
            PG8_LDA(At, 0, 1); PG8_STAGE(PG8_SB(0, 0), b2, voffB); PG8_STAGE(PG8_SB(0, 1), b2 + hstep, voffB); PG8_STAGE(PG8_SA(0, 0), a2, voffA);
            PG8_WAIT_V(8); PG8_WAIT_L(0); PG8_BAR; PG8_MMA(1, 0, At, B0); PG8_MMA(1, 1, At, B1); PG8_BAR; PG8_SCHED;
            PG8_LDB(B0, 1, 0); PG8_LDB(B1, 1, 1); PG8_SCHED; PG8_LDA(At, 1, 0); PG8_STAGE(PG8_SA(0, 1), a2 + hstep, voffA);
            PG8_WAIT_V(8); PG8_WAIT_L(0); PG8_BAR; PG8_MMA(0, 0, At, B0); PG8_MMA(0, 1, At, B1); PG8_BAR; PG8_SCHED;
            PG8_LDA(At, 1, 1); PG8_STAGE(PG8_SB(1, 0), b3, voffB); PG8_STAGE(PG8_SB(1, 1), b3 + hstep, voffB); PG8_STAGE(PG8_SA(1, 0), a3, voffA);
            PG8_WAIT_V(8); PG8_WAIT_L(0); PG8_BAR; PG8_MMA(1, 0, At, B0); PG8_MMA(1, 1, At, B1); PG8_BAR; PG8_SCHED;
            } else {
            PG8_LDB(B0, 0, 0); PG8_SCHED; PG8_LDA(At, 0, 0); PG8_STAGE(PG8_SA(1, 1), a1 + hstep, voffA);
            PG8_WAIT_L(8); PG8_BAR; PG8_WAIT_L(0); PG8_MMA(0, 0, At, B0); PG8_BAR; PG8_SCHED;
            PG8_LDB(B1, 0, 1); PG8_STAGE(PG8_SB(0, 0), b2, voffB);
            PG8_BAR; PG8_WAIT_L(0); PG8_MMA(0, 1, At, B1); PG8_BAR;
            PG8_LDA(At, 0, 1); PG8_STAGE(PG8_SA(0, 0), a2, voffA);
            PG8_BAR; PG8_WAIT_L(0); PG8_MMA(1, 0, At, B0); PG8_BAR; PG8_SCHED;
            PG8_STAGE(PG8_SB(0, 1), b2 + hstep, voffB);
            PG8_WAIT_V(6); PG8_BAR; PG8_MMA(1, 1, At, B1); PG8_BAR;
            PG8_LDB(B0, 1, 0); PG8_SCHED; PG8_LDA(At, 1, 0); PG8_STAGE(PG8_SA(0, 1), a2 + hstep, voffA);
            PG8_WAIT_L(8); PG8_BAR; PG8_WAIT_L(0); PG8_MMA(0, 0, At, B0); PG8_BAR; PG8_SCHED;
            PG8_LDB(B1, 1, 1); PG8_STAGE(PG8_SB(1, 0), b3, voffB);
            PG8_BAR; PG8_WAIT_L(0); PG8_MMA(0, 1, At, B1); PG8_BAR;
            PG8_LDA(At, 1, 1); PG8_STAGE(PG8_SA(1, 0), a3, voffA);
            PG8_BAR; PG8_WAIT_L(0); PG8_MMA(1, 0, At, B0); PG8_BAR; PG8_SCHED;
            PG8_STAGE(PG8_SB(1, 1), b3 + hstep, voffB);
            PG8_WAIT_V(6); PG8_BAR; PG8_MMA(1, 1, At, B1); PG8_BAR;
            }
        }
        if constexpr (ALIGN_EPI) { if (wr == 0) PG8_BAR; }
        if constexpr (FP8) { asm volatile("s_nop 15\n\ts_nop 15" ::: "memory"); }
        if constexpr (!Epi::AFTER_DRAIN) { const int ln_ = lane_id_opaque(); const int fr_ = ln_ & 15, fq_ = ln_ >> 4; int wr_ = wr, wc_ = wc; asm volatile("" : "+s"(wr_), "+s"(wc_)); E(acc, cur, wr_, wc_, fr_, fq_); S.done(cur); }
        if (!has_next) break;
#pragma unroll
        for (int a = 0; a < 2; ++a)
#pragma unroll
            for (int b = 0; b < 2; ++b)
#pragma unroll
                for (int m = 0; m < 4; ++m)
#pragma unroll
                    for (int n = 0; n < 2; ++n) acc[a][b][m][n] = (f32x4){0.f, 0.f, 0.f, 0.f};
        cur = nxt; cA = nA; cB = nB; ++ui;
        if constexpr (ALIGN_EPI) { if (wr == 1) PG8_BAR; }
    }
    PG8_WAIT_V(0);
    if constexpr (!ALIGN_EPI) { if (wr == 0) PG8_BAR; }
    PG8_BAR;
    if constexpr (Epi::AFTER_DRAIN) { E.fused(acc, cur, wr, wc, fr, fq, lds, wid, lane); S.done(cur); }
#undef PG8_SA
#undef PG8_SB
#undef PG8_STAGE
#undef PG8_LDA
#undef PG8_LDF
#undef PG8_LDB
#undef PG8_MMA
#undef PG8_CAT8
#undef PG8_WAIT_V
#undef PG8_WAIT_L
#undef PG8_BAR
#undef PG8_SCHED
}
}

#ifndef PG8_SP2
#define PG8_SP2 true
#endif
#ifndef PG8_ALIGN
#define PG8_ALIGN true
#endif
#include <hip/hip_bf16.h>
#include <cmath>
namespace attn_body {
using bf16=__hip_bfloat16;
using bf16x8=__attribute__((ext_vector_type(8)))short;
using s16x4=__attribute__((ext_vector_type(4)))short;
using f32x16=__attribute__((ext_vector_type(16)))float;
using u32x4=__attribute__((ext_vector_type(4)))unsigned;
constexpr int BATCH=8,NHEAD=8,SEQ=4096,D=64,DM=NHEAD*D;
constexpr int NW=8,QBLK=32,QB=QBLK*NW,KVBLK=64,NQB=SEQ/QB;
constexpr int ATTN_PITCH=DM, ATTN_UNIT_ROWS=QB;
__device__ __forceinline__ int crow(int r,int hi){return (r&3)+8*(r>>2)+4*hi;}
#define SBAR() __builtin_amdgcn_sched_barrier(0)
__device__ __forceinline__ void cmask(f32x16&p0,f32x16&p1,int jb,int qrel,int hi){
  const float NEG=-INFINITY; int kb=64*jb+4*hi;
  #pragma unroll
  for(int r=0;r<16;++r){int kv=kb+(r&3)+8*(r>>2); if(kv>qrel)p0[r]=NEG; if(kv+32>qrel)p1[r]=NEG;}
}

constexpr int NSLOT=3, SLOTB=8192;
constexpr int LDS_K=0, LDS_V=NSLOT*SLOTB, LDS_WS=2*NSLOT*SLOTB, LDS_OST=LDS_WS+NW*64*4, LDS_BYTES=LDS_OST+NW*4096, LDS_CB=86016, LDS_CBW=LDS_CB+16384;
constexpr float C2=0.125f*1.4426950408889634f;
__device__ __forceinline__ void glds16(const void*gsrc,unsigned lds_dst){unsigned keep;
  asm volatile("s_mov_b32 %0, m0\n\ts_mov_b32 m0, %2\n\ts_nop 0\n\tglobal_load_lds_dwordx4 %1, off\n\ts_mov_b32 m0, %0":"=&s"(keep):"v"(gsrc),"s"(lds_dst):"memory");}
__device__ __forceinline__ float max3f(float a,float b,float c){float r;asm("v_max3_f32 %0, %1, %2, %3":"=v"(r):"v"(a),"v"(b),"v"(c));return r;}
__device__ __forceinline__ float max2f(float a,float b){float r;asm("v_max_f32_e32 %0, %1, %2":"=v"(r):"v"(a),"v"(b));return r;}
__device__ __forceinline__ float fadd_s(float a,float b){float r;asm("v_add_f32_e32 %0, %1, %2":"=v"(r):"v"(a),"v"(b));return r;}
__device__ __forceinline__ float fsub_s(float a,float b){float r;asm("v_sub_f32_e32 %0, %1, %2":"=v"(r):"v"(a),"v"(b));return r;}
typedef float f32x2_t __attribute__((ext_vector_type(2))); typedef __bf16 bf16x2_t __attribute__((ext_vector_type(2)));
__device__ __forceinline__ unsigned cvtpk_s(float lo,float hi){f32x2_t v={lo,hi};bf16x2_t b=__builtin_convertvector(v,bf16x2_t);return __builtin_bit_cast(unsigned,b);}
#define WAIT_BAR(N) asm volatile("s_waitcnt vmcnt(" #N ") lgkmcnt(0)\n\ts_barrier":::"memory")

__device__ __forceinline__ void qkt(f32x16&p0,f32x16&p1,const char*Kslot,const bf16x8*qr,int r32,int hi){
  const char*kb=Kslot+hi*1024+r32*16;
  #pragma unroll
  for(int d0=0;d0<4;++d0){
    const bf16x8 b0=*reinterpret_cast<const bf16x8*>(kb+d0*2048);
    const bf16x8 b1=*reinterpret_cast<const bf16x8*>(kb+d0*2048+512);
    p0=__builtin_amdgcn_mfma_f32_32x32x16_bf16(b0,qr[d0],p0,0,0,0);p1=__builtin_amdgcn_mfma_f32_32x32x16_bf16(b1,qr[d0],p1,0,0,0);}
}
typedef __attribute__((address_space(3))) const char* lds_cptr;
typedef float f32x4_t __attribute__((ext_vector_type(4)));
typedef short v4i16_t __attribute__((ext_vector_type(4)));
__device__ __forceinline__ void kload8(bf16x8*kf,lds_cptr kp){
  kf[0]=*(const __attribute__((address_space(3))) bf16x8*)(kp);      kf[1]=*(const __attribute__((address_space(3))) bf16x8*)(kp+512);
  kf[2]=*(const __attribute__((address_space(3))) bf16x8*)(kp+2048); kf[3]=*(const __attribute__((address_space(3))) bf16x8*)(kp+2560);
  kf[4]=*(const __attribute__((address_space(3))) bf16x8*)(kp+4096); kf[5]=*(const __attribute__((address_space(3))) bf16x8*)(kp+4608);
  kf[6]=*(const __attribute__((address_space(3))) bf16x8*)(kp+6144); kf[7]=*(const __attribute__((address_space(3))) bf16x8*)(kp+6656);
}
__device__ __forceinline__ void kload2(bf16x8*kf,lds_cptr kp,int j){ kf[2*j]=*(const __attribute__((address_space(3))) bf16x8*)(kp+j*2048); kf[2*j+1]=*(const __attribute__((address_space(3))) bf16x8*)(kp+j*2048+512); }
__device__ __forceinline__ s16x4 vtr(lds_cptr p){ return __builtin_bit_cast(s16x4,__builtin_amdgcn_ds_read_tr16_b64_v4i16((__attribute__((address_space(3))) v4i16_t*)p)); }
__device__ __forceinline__ float rowmax(const f32x16&p0,const f32x16&p1){
  float a=max3f(p0[0],p0[1],p1[0]),b=max3f(p0[2],p0[3],p1[1]);a=max3f(a,p1[2],p1[3]);
  #pragma unroll
  for(int r=4;r<16;r+=4){a=max3f(a,p0[r],p0[r+1]);b=max3f(b,p0[r+2],p0[r+3]);a=max3f(a,p1[r],p1[r+1]);b=max3f(b,p1[r+2],p1[r+3]);}
  const float m=max2f(a,b);
  auto rr=__builtin_amdgcn_permlane32_swap(__float_as_uint(m),__float_as_uint(m),false,false);
  return max2f(__uint_as_float(rr[0]),__uint_as_float(rr[1]));
}
__device__ __forceinline__ void pv(f32x16*o,int vb,bf16x8 pa0,bf16x8 pa1,bf16x8 pa2,bf16x8 pa3){
  #pragma unroll
  for(int d0=0;d0<2;++d0){s16x4 lo[4],hi[4];
    #pragma unroll
    for(int ks=0;ks<4;++ks){
      asm volatile("ds_read_b64_tr_b16 %0,%1 offset:%c2":"=&v"(lo[ks]):"v"(vb),"i"(d0*4096+ks*1024):"memory");
      asm volatile("ds_read_b64_tr_b16 %0,%1 offset:%c2":"=&v"(hi[ks]):"v"(vb),"i"(d0*4096+ks*1024+512):"memory");}
    asm volatile("s_waitcnt lgkmcnt(0)":::"memory");SBAR();
    #define PK(k) (bf16x8){lo[k][0],lo[k][1],lo[k][2],lo[k][3],hi[k][0],hi[k][1],hi[k][2],hi[k][3]}
    o[d0]=__builtin_amdgcn_mfma_f32_32x32x16_bf16(pa0,PK(0),o[d0],0,0,0);
    o[d0]=__builtin_amdgcn_mfma_f32_32x32x16_bf16(pa1,PK(1),o[d0],0,0,0);
    o[d0]=__builtin_amdgcn_mfma_f32_32x32x16_bf16(pa2,PK(2),o[d0],0,0,0);
    o[d0]=__builtin_amdgcn_mfma_f32_32x32x16_bf16(pa3,PK(3),o[d0],0,0,0);
    #undef PK
  }
}

#ifndef ATTN_STORE16
#define ATTN_STORE16(p,v) (*(u32x4*)(p)=(v))
#endif
template<int THRL> __device__ __forceinline__ void attn_unit(int b,int h,int qb,const bf16*Q,const bf16*__restrict__ K,const bf16*__restrict__ V,bf16*O,const float*__restrict__ FL,char*shm,const int wid){
  const int lane=pg8::lane_id_opaque(),tid=wid*64+lane,r32=lane&31,hi=lane>>5;
  const long rowbase=(long)b*SEQ; const int q0=qb*QB;
  int t0=0;
  {
    typedef __attribute__((address_space(3))) float lfl;
    lfl*cl=(lfl*)((lds_cptr)shm+LDS_CB); lfl*wt=(lfl*)((lds_cptr)shm+LDS_CBW);
    const int nk=q0+QB; float v[8];
    #pragma unroll
    for(int q=0;q<8;++q){const int s=8*tid+q; v[q]=(s<nk)?FL[(rowbase+s)*8+h]:0.f;}
    #pragma unroll
    for(int q=1;q<8;++q)v[q]+=v[q-1];
    const float tot=v[7]; float x=tot;
    #pragma unroll
    for(int off=1;off<64;off<<=1){const float t=__int_as_float(__builtin_amdgcn_ds_bpermute((lane-off)<<2,__float_as_int(x))); if(lane>=off)x+=t;}
    if(lane==63)wt[wid]=x;
    __syncthreads();
    float woff=0.f;
    #pragma unroll
    for(int w=0;w<NW;++w){const float tw=wt[w]; if(w<wid)woff+=tw;}
    const float ex=x-tot+woff;
    #pragma unroll
    for(int q=0;q<8;++q)cl[8*tid+q]=v[q]+ex;
    __syncthreads();
    { const int NTf=nk/KVBLK; const float cq0=cl[q0]; const float ck=(lane<NTf)?cl[64*lane+63]:0.f; const bool sk=(lane<NTf)&&(cq0-ck<-48.f);
      int ts=(int)__popcll(__ballot(sk))&~1; if(ts>NTf-4)ts=NTf-4; t0=__builtin_amdgcn_readfirstlane(ts); }
  }
  typedef __attribute__((address_space(3))) const f32x4_t* lf4p; const lf4p clq=(lf4p)((lds_cptr)shm+LDS_CB)+hi+16*t0;
  #define BIASLD(C0,C1,t) do{ const lf4p cp_=clq+16*(t); _Pragma("unroll") for(int i_=0;i_<4;++i_){ const f32x4_t a_=cp_[2*i_], b_=cp_[2*i_+8]; \
      C0[4*i_]=a_[0];C0[4*i_+1]=a_[1];C0[4*i_+2]=a_[2];C0[4*i_+3]=a_[3]; C1[4*i_]=b_[0];C1[4*i_+1]=b_[1];C1[4*i_+2]=b_[2];C1[4*i_+3]=b_[3]; } }while(0)
  #define BIASFIX(C0,C1) do{ _Pragma("unroll") for(int r_=0;r_<16;++r_){C0[r_]=nmh-C0[r_];C1[r_]=nmh-C1[r_];} }while(0)
  const bf16*Qw=Q+(rowbase+q0+wid*QBLK)*DM+h*D;
  const bf16*Kh=K+(rowbase+(long)t0*KVBLK)*DM+h*D,*Vh=V+(rowbase+(long)t0*KVBLK)*DM+h*D;
  const unsigned lds0=(unsigned)(uintptr_t)shm;
  float*wsf=(float*)(shm+LDS_WS)+wid*64;
  const bf16*ksrc=Kh+(long)lane*DM+wid*8;
  const bf16*vsrc=Vh+(long)(16*(wid&3)+(lane>>2))*DM+(wid>>2)*32+(lane&3)*8;
  const unsigned kdst=lds0+LDS_K+wid*1024, vdst=lds0+LDS_V+wid*1024;
  #define DMA_K(t,slot) glds16(ksrc+(long)(t)*KVBLK*DM,(unsigned)__builtin_amdgcn_readfirstlane(kdst+(slot)))
  #define DMA_V(t,slot) glds16(vsrc+(long)(t)*KVBLK*DM,(unsigned)__builtin_amdgcn_readfirstlane(vdst+(slot)))
  const int vb0=(int)(lds0+LDS_V)+((lane>>4)&1)*32+(lane&3)*8+(4*hi+((lane&15)>>2))*64;
  const char*Kbase=shm+LDS_K; bf16x8 kf[8];
  const lds_cptr shm3=(lds_cptr)shm; const lds_cptr kp0=shm3+LDS_K+hi*1024+r32*16; const lds_cptr vp0=shm3+LDS_V+((lane>>4)&1)*32+(lane&3)*8+(4*hi+((lane&15)>>2))*64;
  const int NT=(q0+QB)/KVBLK-t0;
  DMA_K(0,0);DMA_V(0,0);DMA_K(1,SLOTB);
  bf16x8 qr[4];
  #pragma unroll
  for(int d0=0;d0<4;++d0)qr[d0]=*reinterpret_cast<const bf16x8*>(&Qw[(long)r32*DM+d0*16+hi*8]);
  float mhat=0.f,l_reg=0.f,nmh=0.f;f32x16 o[2];o[0]=f32x16{};o[1]=f32x16{};
  const int qrel=wid*QBLK+r32;
  #define CMASK(P0,P1,t) do{int jb_=(t)-(NT-4); if(jb_>=0)cmask(P0,P1,jb_,qrel,hi);}while(0)
  bool resc=false;
  #define START(P0,P1) do{ const float rm=rowmax(P0,P1); resc=false; \
    { const float dl=rm; mhat=fadd_s(mhat,dl); \
      _Pragma("unroll") for(int r=0;r<16;++r){P0[r]=fsub_s(P0[r],dl);P1[r]=fsub_s(P1[r],dl);} \
      nmh=-mhat; } \
    _Pragma("unroll") for(int r=0;r<16;++r)P0[r]=__builtin_amdgcn_exp2f(P0[r]); }while(0)
  #define RESC() do{ if(resc){ asm volatile("s_waitcnt lgkmcnt(0)":::"memory"); \
      _Pragma("unroll") for(int d_=0;d_<2;++d_) _Pragma("unroll") for(int r=0;r<16;++r)o[d_][r]*=wsf[crow(r,hi)]; } }while(0)
  f32x16 pA0,pA1,pB0,pB1;
  BIASLD(pA0,pA1,0); BIASFIX(pA0,pA1);
  int sl_prev=0,sl_cur=0,sl_next=SLOTB;
  #define ROT() do{sl_prev=sl_cur;sl_cur=sl_next;sl_next=(sl_next==(NSLOT-1)*SLOTB)?0:sl_next+SLOTB;}while(0)
  DMA_K(2,2*SLOTB);
  WAIT_BAR(3);
  qkt(pA0,pA1,Kbase,qr,r32,hi);asm volatile("s_nop 15\n\ts_nop 7":"+v"(pA0),"+v"(pA1));CMASK(pA0,pA1,0);
  START(pA0,pA1);
  _Pragma("unroll") for(int r=0;r<16;++r)pA1[r]=__builtin_amdgcn_exp2f(pA1[r]);
  WAIT_BAR(0);
  DMA_K(3,0);DMA_V(1,SLOTB);
  ROT();
  kload8(kf,kp0+sl_cur);
  BIASLD(pB0,pB1,1);
  WAIT_BAR(2);
  s16x4 vlo[8],vhi[8]; u32x4 pw0,pw1,pw2,pw3;
  #define PKW(P,B) cvtpk_s(P[B],P[B+1])
  #define PAF(k) __builtin_bit_cast(bf16x8,pw##k)
  #define VFR(i) (bf16x8){vlo[i][0],vlo[i][1],vlo[i][2],vlo[i][3],vhi[i][0],vhi[i][1],vhi[i][2],vhi[i][3]}
  #define PIN(x) asm volatile("":"+v"(x))
  #define MX3(a,b,c) __builtin_fmaxf(__builtin_fmaxf((a),(b)),(c))
  #define GAPA(MF,A0,A1,A2,A3,W0,W1,PW) do{ MF; sacc+=A0; sacc+=A1; sacc+=A2; sacc+=A3; PIN(sacc); W0; W1; PIN(PW); SBAR(); }while(0)
  #define EX(v) __builtin_amdgcn_exp2f(v)
  #define GAPB(MF,X,B) do{ MF; X[B]=EX(X[B]); X[B+1]=EX(X[B+1]); X[B+2]=EX(X[B+2]); X[B+3]=EX(X[B+3]); PIN(X); SBAR(); }while(0)
  #define VRD(i) do{ vlo[i]=vtr(vp_+(((i)>>2)*4096+((i)&3)*1024)); vhi[i]=vtr(vp_+(((i)>>2)*4096+((i)&3)*1024+512)); }while(0)
  #define KRD(G,j) do{ if(G){ kload2(kf,kp0+sl_next,j); SBAR(); } }while(0)
  #define STEP(C0,C1,P0,P1,t,GK,GV,GL) do{ SBAR(); BIASFIX(C0,C1); SBAR(); \
    const lds_cptr vp_=vp0+sl_prev; \
    VRD(0); SBAR(); float sacc=(P0[0]+P0[1]); \
    GAPA(C0=__builtin_amdgcn_mfma_f32_32x32x16_bf16(kf[0],qr[0],C0,0,0,0), P0[2],P0[3],P0[4],P0[5],     pw0[0]=PKW(P0,0), pw0[1]=PKW(P0,2), pw0); \
    VRD(4); SBAR(); GAPA(C1=__builtin_amdgcn_mfma_f32_32x32x16_bf16(kf[1],qr[0],C1,0,0,0), P0[6],P0[7],P0[8],P0[9],     pw0[2]=PKW(P0,4), pw0[3]=PKW(P0,6), pw0); \
    VRD(1); SBAR(); GAPA(C0=__builtin_amdgcn_mfma_f32_32x32x16_bf16(kf[2],qr[1],C0,0,0,0),   P0[10],P0[11],P0[12],P0[13], pw1[0]=PKW(P0,8), pw1[1]=PKW(P0,10), pw1); \
    VRD(5); SBAR(); GAPA(C1=__builtin_amdgcn_mfma_f32_32x32x16_bf16(kf[3],qr[1],C1,0,0,0),   P0[14],P0[15],P1[0],P1[1],   pw1[2]=PKW(P0,12),pw1[3]=PKW(P0,14), pw1); \
    VRD(2); SBAR(); GAPA(C0=__builtin_amdgcn_mfma_f32_32x32x16_bf16(kf[4],qr[2],C0,0,0,0),   P1[2],P1[3],P1[4],P1[5],     pw2[0]=PKW(P1,0), pw2[1]=PKW(P1,2), pw2); \
    VRD(6); SBAR(); GAPA(C1=__builtin_amdgcn_mfma_f32_32x32x16_bf16(kf[5],qr[2],C1,0,0,0),   P1[6],P1[7],P1[8],P1[9],     pw2[2]=PKW(P1,4), pw2[3]=PKW(P1,6), pw2); \
    VRD(3); SBAR(); GAPA(C0=__builtin_amdgcn_mfma_f32_32x32x16_bf16(kf[6],qr[3],C0,0,0,0),   P1[10],P1[11],P1[12],P1[13], pw3[0]=PKW(P1,8), pw3[1]=PKW(P1,10), pw3); \
    VRD(7); SBAR(); GAPA(C1=__builtin_amdgcn_mfma_f32_32x32x16_bf16(kf[7],qr[3],C1,0,0,0),   P1[14],P1[15],0.f,0.f,       pw3[2]=PKW(P1,12),pw3[3]=PKW(P1,14), pw3); \
    l_reg+=sacc; \
    if(GK){DMA_K((t)+3,sl_cur);} if(GV){DMA_V((t)+1,sl_next);} \
    CMASK(C0,C1,t); \
    { float a=MX3(C0[0],C0[1],C1[0]),b=MX3(C0[2],C0[3],C1[1]); a=MX3(a,C1[2],C1[3]); \
      _Pragma("unroll") for(int r=4;r<16;r+=4){a=MX3(a,C0[r],C0[r+1]);b=MX3(b,C0[r+2],C0[r+3]);a=MX3(a,C1[r],C1[r+1]);b=MX3(b,C1[r+2],C1[r+3]);} \
      float rm=__builtin_fmaxf(a,b); { auto rr=__builtin_amdgcn_permlane32_swap(__float_as_uint(rm),__float_as_uint(rm),false,false); rm=__builtin_fmaxf(__uint_as_float(rr[0]),__uint_as_float(rr[1])); } \
      resc=false; \
      if(__builtin_expect(__any(rm>(float)THRL),0)){ const float dl=__builtin_fmaxf(rm,0.f); mhat+=dl; \
        _Pragma("unroll") for(int r=0;r<16;++r){C0[r]-=dl;C1[r]-=dl;} \
        nmh=-mhat; \
        const float f=__builtin_amdgcn_exp2f(-dl); l_reg*=f; if(hi==0)wsf[r32]=f; resc=true; } } \
    SBAR(); \
    GAPB(o[0]=__builtin_amdgcn_mfma_f32_32x32x16_bf16(PAF(0),VFR(0),o[0],0,0,0), C0,0); \
    GAPB(o[1]=__builtin_amdgcn_mfma_f32_32x32x16_bf16(PAF(0),VFR(4),o[1],0,0,0), C0,4); \
    KRD(GL,0); GAPB(o[0]=__builtin_amdgcn_mfma_f32_32x32x16_bf16(PAF(1),VFR(1),o[0],0,0,0), C0,8); \
    KRD(GL,1); GAPB(o[1]=__builtin_amdgcn_mfma_f32_32x32x16_bf16(PAF(1),VFR(5),o[1],0,0,0), C0,12); \
    KRD(GL,2); GAPB(o[0]=__builtin_amdgcn_mfma_f32_32x32x16_bf16(PAF(2),VFR(2),o[0],0,0,0), C1,0); \
    KRD(GL,3); GAPB(o[1]=__builtin_amdgcn_mfma_f32_32x32x16_bf16(PAF(2),VFR(6),o[1],0,0,0), C1,4); \
    GAPB(o[0]=__builtin_amdgcn_mfma_f32_32x32x16_bf16(PAF(3),VFR(3),o[0],0,0,0), C1,8); \
    GAPB(o[1]=__builtin_amdgcn_mfma_f32_32x32x16_bf16(PAF(3),VFR(7),o[1],0,0,0), C1,12); \
    if(GL){BIASLD(P0,P1,(t)+1);} \
    }while(0)
  int t=1;
  #undef CMASK
  #define CMASK(P0,P1,t) do{}while(0)
  for(;t+5<NT;t+=2){
    STEP(pB0,pB1,pA0,pA1,t,true,true,true);     WAIT_BAR(2); RESC(); ROT();
    STEP(pA0,pA1,pB0,pB1,t+1,true,true,true);   WAIT_BAR(2); RESC(); ROT();
  }
  #undef CMASK
  #define CMASK(P0,P1,t) do{int jb_=(t)-(NT-4); if(jb_>=0)cmask(P0,P1,jb_,qrel,hi);}while(0)
  #define ENDW(tt) do{ if((tt)+3<NT){WAIT_BAR(2);} else if((tt)+2<NT){WAIT_BAR(1);} else {WAIT_BAR(0);} }while(0)
  for(;t+1<NT;t+=2){
    STEP(pB0,pB1,pA0,pA1,t,(t+3<NT),(t+1<NT),(t+1<NT));       ENDW(t);   RESC(); ROT();
    STEP(pA0,pA1,pB0,pB1,t+1,(t+4<NT),(t+2<NT),(t+2<NT));     ENDW(t+1); RESC(); ROT();
  }
  STEP(pB0,pB1,pA0,pA1,NT-1,false,false,false); RESC();
  { float sacc=pB0[0]+pB0[1]; _Pragma("unroll") for(int r=2;r<16;++r)sacc+=pB0[r]; _Pragma("unroll") for(int r=0;r<16;++r)sacc+=pB1[r]; l_reg+=sacc;
    pw0=(u32x4){PKW(pB0,0),PKW(pB0,2),PKW(pB0,4),PKW(pB0,6)};pw1=(u32x4){PKW(pB0,8),PKW(pB0,10),PKW(pB0,12),PKW(pB0,14)};pw2=(u32x4){PKW(pB1,0),PKW(pB1,2),PKW(pB1,4),PKW(pB1,6)};pw3=(u32x4){PKW(pB1,8),PKW(pB1,10),PKW(pB1,12),PKW(pB1,14)};
    SBAR(); pv(o,vb0+sl_cur,PAF(0),PAF(1),PAF(2),PAF(3)); }
  #undef PKW
  #undef PAF
  #undef VFR
  #undef PIN
  #undef MX3
  #undef GAPA
  #undef GAPB
  #undef EX
  #undef VRD
  #undef KRD
  #undef STEP
  #undef ENDW
  {auto rr=__builtin_amdgcn_permlane32_swap(__float_as_uint(l_reg),__float_as_uint(l_reg),false,false);l_reg=__uint_as_float(rr[0])+__uint_as_float(rr[1]);}
  if(hi==0)wsf[32+r32]=l_reg;asm volatile("s_waitcnt lgkmcnt(0)":::"memory");
  float rli[16];
  #pragma unroll
  for(int r=0;r<16;++r)rli[r]=__builtin_amdgcn_rcpf(wsf[32+crow(r,hi)]);
  bf16*Ow=O+(rowbase+q0+wid*QBLK)*DM+h*D;
  { bf16*stg=(bf16*)(shm+LDS_OST)+wid*2048;
    #pragma unroll
    for(int r=0;r<16;++r){const int orow=crow(r,hi);
      #pragma unroll
      for(int d0=0;d0<2;++d0)stg[orow*64+d0*32+r32]=__float2bfloat16(o[d0][r]*rli[r]);}
    asm volatile("s_waitcnt lgkmcnt(0)":::"memory");
    #pragma unroll
    for(int i=0;i<4;++i){const int row=i*8+(lane>>3),ch=lane&7; const u32x4 v=*(const u32x4*)(stg+row*64+ch*8); ATTN_STORE16(Ow+(long)row*DM+ch*8,v);} }
  asm volatile("s_waitcnt lgkmcnt(0)\n\ts_barrier":::"memory");
  #undef BIASLD
  #undef BIASFIX
  #undef DMA_K
  #undef DMA_V
  #undef CMASK
  #undef START
  #undef RESC
  #undef ROT
}
constexpr int ATTN_LDS_BYTES=LDS_BYTES;
struct AttnTensors { const bf16* Q; const bf16* K; const bf16* V; bf16* O; const float* FL; };
struct AttnUnit { int bh; int qb; };
struct StaticOrder {
  int vcu, G;
  __device__ __forceinline__ explicit StaticOrder(int grid,int block):vcu((grid%8==0)?(block%8)*(grid/8)+block/8:block),G(grid){}
  __device__ __forceinline__ bool next(int i,AttnUnit&u)const{ const int idx=i*G+vcu; if(idx>=1024)return false; const int v=idx&255, r=idx>>8, s=2*(v&3); u.bh=(v>>5)*8+((((v>>2)&7)+2*r)&7); u.qb=(r==0)?s:(r==1)?15-s:(r==2)?s+1:14-s; return true; }
  __device__ __forceinline__ void a_ready(const AttnUnit&)const{}
  __device__ __forceinline__ void done(const AttnUnit&)const{}
};
template<class Sched,int THRL=8> __device__ __forceinline__ void attn_phase(char*lds,const AttnTensors&T,const Sched&S,const int wid){
  AttnUnit u;
  for(int i=0;S.next(i,u);++i){ S.a_ready(u); attn_unit<THRL>(u.bh/NHEAD,u.bh%NHEAD,u.qb,T.Q,T.K,T.V,T.O,T.FL,lds,wid); S.done(u); }
}
#undef SBAR
#undef WAIT_BAR
}

#include <hip/hip_cooperative_groups.h>
namespace cg = cooperative_groups;

#define GAS __attribute__((address_space(1)))
#define LAS __attribute__((address_space(3)))
typedef unsigned short bf16;
typedef unsigned v4u __attribute__((ext_vector_type(4)));
typedef unsigned v2u __attribute__((ext_vector_type(2)));
typedef float f32x4 __attribute__((ext_vector_type(4)));
typedef short bf16x8 __attribute__((ext_vector_type(8)));
#define RLX_AGENT __ATOMIC_RELAXED, __HIP_MEMORY_SCOPE_AGENT
#define LDS_WAIT() asm volatile("s_waitcnt lgkmcnt(0)" ::: "memory")

constexpr int NWAVES = 8, NTHR = 512;
constexpr int BATCH = 8, SEQ = 4096, D = 1024, M = BATCH * SEQ, DEPTH = 4;
constexpr int INC = 6664, NPROJ = 6656, DFF = 2816, DFE = 3584, NEXP = 8;
constexpr float DN_ALPHA = 1.6817928305074292f, LN_EPS = 1e-5f, RMS_EPS = 1e-6f, LOG2E = 1.4426950408889634f;

constexpr size_t MiB = 1u << 20;
constexpr size_t WS_CTL = 0, WS_COS = 1 * MiB, WS_SIN = 5 * MiB, WS_FLOG = 9 * MiB, WS_RE = 10 * MiB, WS_RR = 10 * MiB + 256 * 1024, WS_RW = 10 * MiB + 512 * 1024, WS_RROW = 10 * MiB + 768 * 1024;
constexpr size_t WS_WIN = 12 * MiB, WS_WBF = 25 * MiB, WS_WBR = 26 * MiB, WS_WOUT = 28 * MiB;
constexpr size_t WS_WFF = 32 * MiB;
constexpr size_t WS_XB = 210 * MiB, WS_HB = 274 * MiB, WS_ACT = 338 * MiB, WS_END = 954 * MiB;
constexpr size_t A_QA = 0, A_KA = 32 * MiB, A_VA = 64 * MiB, A_QB = 96 * MiB, A_KB = 128 * MiB, A_VB = 160 * MiB, A_GB = 224 * MiB, A_GATE = 288 * MiB, A_OB = 416 * MiB, A_T1 = 480 * MiB, A_PT = 544 * MiB;
constexpr size_t A_H = 0;
constexpr int XS_ROWS = 2 * M + 2048;
constexpr size_t A_XB8 = 544 * MiB;
constexpr size_t A_YSP = 600 * MiB;
constexpr size_t A_XS = 0, A_HS = 136 * MiB;
static_assert(A_HS + (size_t)XS_ROWS * DFE * 2 <= A_YSP && A_PT + 32 * MiB <= A_YSP && A_YSP + 16 * MiB <= WS_END - WS_ACT, "ws map");

__device__ __forceinline__ unsigned f2bf(float f) { unsigned u = __builtin_bit_cast(unsigned, f); return (u + 0x7fffu + ((u >> 16) & 1u)) >> 16; }
__device__ __forceinline__ unsigned pk2(float lo, float hi) { return f2bf(lo) | (f2bf(hi) << 16); }
__device__ __forceinline__ float bflo(unsigned w) { return __uint_as_float(w << 16); }
__device__ __forceinline__ float bfhi(unsigned w) { return __uint_as_float(w & 0xffff0000u); }
__device__ __forceinline__ float bf2f(bf16 b) { return __uint_as_float((unsigned)b << 16); }
__device__ __forceinline__ float fsigmoid(float x) { return __builtin_amdgcn_rcpf(1.f + __expf(-x)); }
__device__ __forceinline__ float shx(float v, int m, int lane) { return __int_as_float(__builtin_amdgcn_ds_bpermute((lane ^ m) << 2, __float_as_int(v))); }
__device__ __forceinline__ float shi(float v, int src) { return __int_as_float(__builtin_amdgcn_ds_bpermute(src << 2, __float_as_int(v))); }
__device__ __forceinline__ float wave_sum(float v, int lane) {
#pragma unroll
    for (int o = 1; o < 64; o <<= 1) v += shx(v, o, lane);
    return v;
}

__device__ __forceinline__ unsigned pk4_fp8(float a, float b, float c, float d) { int w = __builtin_amdgcn_cvt_pk_fp8_f32(a, b, 0, false); w = __builtin_amdgcn_cvt_pk_fp8_f32(c, d, w, true); return (unsigned)w; }
constexpr float F8_SW1 = 32.f, F8_SW2 = 64.f, F8_SH = 16.f;
struct Frame {
    LAS unsigned char* lds;
    unsigned* ctl;
    int tid, lane, wave, vcu, G, cofs, trow;
    unsigned char* ws;
};

namespace epi {
using pg8::f32x4; using pg8::Unit; using pg8::HALF; using pg8::BM; using pg8::cvt_pk_bf16;
typedef unsigned u32x4 __attribute__((ext_vector_type(4)));
typedef unsigned u32x2 __attribute__((ext_vector_type(2)));
__device__ __forceinline__ u32x4 pack8(f32x4 a, f32x4 b) { u32x4 w; w.x = cvt_pk_bf16(a[0], a[1]); w.y = cvt_pk_bf16(a[2], a[3]); w.z = cvt_pk_bf16(b[0], b[1]); w.w = cvt_pk_bf16(b[2], b[3]); return w; }
__device__ __forceinline__ u32x2 pack4(f32x4 a) { u32x2 w; w.x = cvt_pk_bf16(a[0], a[1]); w.y = cvt_pk_bf16(a[2], a[3]); return w; }
__device__ __forceinline__ f32x4 unlo(u32x4 w) { return (f32x4){bflo(w.x), bfhi(w.x), bflo(w.y), bfhi(w.y)}; }
__device__ __forceinline__ f32x4 unhi(u32x4 w) { return (f32x4){bflo(w.z), bfhi(w.z), bflo(w.w), bfhi(w.w)}; }
__device__ __forceinline__ f32x4 silu4(f32x4 v) { return (f32x4){v[0] * fsigmoid(v[0]), v[1] * fsigmoid(v[1]), v[2] * fsigmoid(v[2]), v[3] * fsigmoid(v[3])}; }
__device__ __forceinline__ f32x4 sigm4(f32x4 v) { return (f32x4){fsigmoid(v[0]), fsigmoid(v[1]), fsigmoid(v[2]), fsigmoid(v[3])}; }

struct EpiInProj {
    static constexpr bool PERM = false, AFTER_DRAIN = false;
    unsigned char* act; const float* cosT; const float* sinT;
    template <int ACT> __device__ __forceinline__ void plain(const f32x4 (&acc)[2][2][4][2], bf16* base, int ldo, int colt, float sc, int row0, int wc, int fq) const {
#pragma unroll
        for (int ai = 0; ai < 2; ++ai)
#pragma unroll
            for (int m = 0; m < 4; ++m) { bf16* rowp = base + (size_t)(row0 + ai * HALF + m * 16) * ldo + colt + wc * 32 + 8 * fq;
#pragma unroll
                for (int bj = 0; bj < 2; ++bj) { f32x4 v0 = acc[ai][bj][m][0], v1 = acc[ai][bj][m][1]; asm volatile("" : "+v"(v0), "+v"(v1));
                    if (ACT == 0) { v0 = v0 * sc; v1 = v1 * sc; } else if (ACT == 1) { v0 = silu4(v0); v1 = silu4(v1); } else { v0 = sigm4(v0); v1 = sigm4(v1); }
                    *(u32x4*)(rowp + bj * HALF) = pack8(v0, v1); }
                asm volatile("" ::: "memory"); __builtin_amdgcn_sched_barrier(0); }
    }
    __device__ __forceinline__ void operator()(const f32x4 (&acc)[2][2][4][2], const Unit& u, int wr, int wc, int fr, int fq) const {
        const int pn = u.pn, row0 = u.pm * BM + wr * 64 + fr;
        if (pn < 6) { plain<0>(acc, (bf16*)(act + A_QA + (size_t)(pn >> 1) * (32 * MiB)), 512, (pn & 1) * 256, pn < 2 ? attn_body::C2 : 1.f, row0, wc, fq); }
        else if (pn < 10) {
            bf16* base = (bf16*)(act + (pn < 8 ? A_QB : A_KB)); const float sc = pn < 8 ? 1.f : 0.125f; const int colt = (pn & 1) * 256, d0 = (wc & 1) * 16 + 4 * fq;
#pragma unroll
            for (int ai = 0; ai < 2; ++ai)
#pragma unroll
                for (int m = 0; m < 4; ++m) { const int row = row0 + ai * HALF + m * 16;
                    const f32x4 cs = *(const f32x4*)(cosT + (size_t)row * 32 + d0) * sc, sn = *(const f32x4*)(sinT + (size_t)row * 32 + d0) * sc;
#pragma unroll
                    for (int bj = 0; bj < 2; ++bj) { f32x4 x1 = acc[ai][bj][m][0], x2 = acc[ai][bj][m][1]; asm volatile("" : "+v"(x1), "+v"(x2));
                        bf16* p = base + (size_t)row * 512 + colt + (2 * bj + (wc >> 1)) * 64 + d0;
                        *(u32x2*)p = pack4(x1 * cs - x2 * sn); *(u32x2*)(p + 32) = pack4(x1 * sn + x2 * cs); }
                    asm volatile("" ::: "memory"); __builtin_amdgcn_sched_barrier(0); }
        }
        else if (pn < 14) plain<0>(acc, (bf16*)(act + A_VB), 1024, (pn - 10) * 256, 1.f, row0, wc, fq);
        else if (pn < 18) plain<0>(acc, (bf16*)(act + A_GB), 1024, (pn - 14) * 256, 1.f, row0, wc, fq);
        else plain<0>(acc, (bf16*)(act + A_GATE), 2048, (pn - 18) * 256, 1.f, row0, wc, fq);
    }
};
struct EpiGated {
    static constexpr bool PERM = false, AFTER_DRAIN = false;
    bf16* out; int ldo; const bf16* gate; int ldg; const bf16* add; float sc;
    __device__ __forceinline__ void operator()(const f32x4 (&acc)[2][2][4][2], const Unit& u, int wr, int wc, int fr, int fq) const {
        const int row0 = u.pm * BM + wr * 64 + fr, col0 = u.pn * BM + wc * 32 + 8 * fq;
#pragma unroll
        for (int ai = 0; ai < 2; ++ai)
#pragma unroll
            for (int m = 0; m < 4; ++m) { const size_t row = (size_t)(row0 + ai * HALF + m * 16);
#pragma unroll
                for (int bj = 0; bj < 2; ++bj) { f32x4 v0 = acc[ai][bj][m][0], v1 = acc[ai][bj][m][1]; asm volatile("" : "+v"(v0), "+v"(v1)); v0 = v0 * sc; v1 = v1 * sc; const int col = col0 + bj * HALF;
                    if (gate) { const u32x4 gv = *(const u32x4*)(gate + row * ldg + col); v0 = v0 * sigm4(unlo(gv)); v1 = v1 * sigm4(unhi(gv)); }
                    if (add) { const u32x4 av = *(const u32x4*)(add + row * ldo + col); v0 = v0 + unlo(av); v1 = v1 + unhi(av); }
                    *(u32x4*)(out + row * ldo + col) = pack8(v0, v1); }
                asm volatile("" ::: "memory"); __builtin_amdgcn_sched_barrier(0); }
    }
};
struct EpiSwiGLU {
    static constexpr bool PERM = false, AFTER_DRAIN = false;
    bf16* out; int ldo;
    __device__ __forceinline__ void operator()(const f32x4 (&acc)[2][2][4][2], const Unit& u, int wr, int wc, int fr, int fq) const {
        const int row0 = u.pm * BM + wr * 64 + fr, hid0 = u.pn * 128 + wc * 16 + 4 * fq;
#pragma unroll
        for (int ai = 0; ai < 2; ++ai)
#pragma unroll
            for (int m = 0; m < 4; ++m) { bf16* rowp = out + (size_t)(row0 + ai * HALF + m * 16) * ldo + hid0;
#pragma unroll
                for (int bj = 0; bj < 2; ++bj) { f32x4 v0 = acc[ai][bj][m][0], v1 = acc[ai][bj][m][1]; asm volatile("" : "+v"(v0), "+v"(v1)); *(u32x2*)(rowp + bj * 64) = pack4(silu4(v0) * v1); }
                asm volatile("" ::: "memory"); __builtin_amdgcn_sched_barrier(0); }
    }
};
struct EpiSwiGLU8 {
    static constexpr bool PERM = false, AFTER_DRAIN = false;
    unsigned char* out; int ldo; float si, so;
    __device__ __forceinline__ void operator()(const f32x4 (&acc)[2][2][4][2], const Unit& u, int wr, int wc, int fr, int fq) const {
        const int row0 = u.pm * BM + wr * 64 + fr, hid0 = u.pn * 128 + wc * 16 + 4 * fq;
#pragma unroll
        for (int ai = 0; ai < 2; ++ai)
#pragma unroll
            for (int m = 0; m < 4; ++m) { unsigned char* rowp = out + (size_t)(row0 + ai * HALF + m * 16) * ldo + hid0;
#pragma unroll
                for (int bj = 0; bj < 2; ++bj) { f32x4 v0 = acc[ai][bj][m][0], v1 = acc[ai][bj][m][1]; asm volatile("" : "+v"(v0), "+v"(v1));
                    const f32x4 h = silu4(v0 * si) * v1 * (si * so); *(unsigned*)(rowp + bj * 64) = pk4_fp8(h[0], h[1], h[2], h[3]); }
                asm volatile("" ::: "memory"); __builtin_amdgcn_sched_barrier(0); }
    }
};
struct MoeOrder {
    int ts[9]; int NT, G, c, lim, rev;
    __device__ __forceinline__ bool next(int i, Unit& u) const {
        const int L = i * G + c; if (L >= lim) return false;
        int rt = L / NT; const int pn = L - rt * NT; if (rev) rt = ts[8] - 1 - rt; int e = 0;
#pragma unroll
        for (int j = 1; j < 8; ++j) e += (rt >= ts[j]) ? 1 : 0;
        u.pm = rt; u.pn = pn; u.pb = e * NT + pn; return true;
    }
    __device__ __forceinline__ void a_ready(const Unit&) const {}
    __device__ __forceinline__ void done(const Unit&) const {}
};
struct TailOrder {
    int ts[9]; int L;
    __device__ __forceinline__ bool next(int i, Unit& u) const {
        if (i > 0 || L < 0) return false;
        const int rt = L >> 2, pn = L & 3; int e = 0;
#pragma unroll
        for (int j = 1; j < 8; ++j) e += (rt >= ts[j]) ? 1 : 0;
        u.pm = rt; u.pn = pn; u.pb = e * 4 + pn; return true;
    }
    __device__ __forceinline__ void a_ready(const Unit&) const {}
    __device__ __forceinline__ void done(const Unit&) const {}
};
}

enum { CM_PLAIN = 0, CM_WIN = 1, CM_GU = 2 };
template <int MODE, bool F8 = false>
__device__ __forceinline__ void conv_job(const float* A, const float* B, int K, int pitch, bf16* dst, int ngroups, int gw, int NGW, LAS float* scr, int lane, float sc8 = 1.f) {
    const int nitems = (K >> 6) * ngroups, m = lane & 7, kq = lane >> 3;
    for (int it = gw; it < nitems; it += NGW) {
        const int kb = it / ngroups, g = it - kb * ngroups, k0 = kb * 64;
        const float* src; int sb;
        if (MODE == CM_GU) { src = (m < 4 ? A : B) + g * 16 + 4 * (m & 3); sb = 16 * (m >> 2) + 4 * (m & 3); }
        else { const int r0 = g * 32;
            if (MODE == CM_WIN && r0 >= 1536 && r0 < 2560) { const int p = r0 - 1536; src = A + 1544 + (p >> 6) * 64 + ((p >> 5) & 1) * 16 + 32 * (m >> 2) + 4 * (m & 3); sb = 16 * (m >> 2) + 4 * (m & 3); }
            else { src = A + r0 + ((MODE == CM_WIN && r0 >= 2560) ? 8 : 0) + 4 * m; sb = 16 * (m & 1) + 4 * (m >> 1); } }
        src += (size_t)k0 * pitch;
        f32x4 v[8];
#pragma unroll
        for (int i = 0; i < 8; ++i) v[i] = *(const f32x4*)(src + (size_t)(kq + 8 * i) * pitch);
#pragma unroll
        for (int i = 0; i < 8; ++i) { LAS float* s = scr + (kq + 8 * i) * 33 + sb; s[0] = v[i][0]; s[1] = v[i][1]; s[2] = v[i][2]; s[3] = v[i][3]; }
        LDS_WAIT();
        const int c = lane & 7;
#pragma unroll
        for (int j = 0; j < 4; ++j) { const int n = (lane >> 3) + 8 * j; const LAS float* s = scr + (8 * c) * 33 + n;
            if (F8) { v2u o; o.x = pk4_fp8(s[0 * 33] * sc8, s[1 * 33] * sc8, s[2 * 33] * sc8, s[3 * 33] * sc8); o.y = pk4_fp8(s[4 * 33] * sc8, s[5 * 33] * sc8, s[6 * 33] * sc8, s[7 * 33] * sc8);
                *(v2u*)((unsigned char*)dst + (size_t)(g * 32 + n) * K + k0 + 8 * c) = o; }
            else { v4u o; o.x = pk2(s[0 * 33], s[1 * 33]); o.y = pk2(s[2 * 33], s[3 * 33]); o.z = pk2(s[4 * 33], s[5 * 33]); o.w = pk2(s[6 * 33], s[7 * 33]);
                *(v4u*)(dst + (size_t)(g * 32 + n) * K + k0 + 8 * c) = o; } }
        LDS_WAIT();
    }
}
__device__ __forceinline__ void conv_layer(Frame& F, const float* const* in, int l, int part) {
    LAS float* scr = (LAS float*)(F.lds + F.wave * 16384);
    const int gw = F.vcu * NWAVES + F.wave, NGW = F.G * NWAVES;
    unsigned char* ws = F.ws;
    if (part == 0) {
    conv_job<CM_WIN>(in[2] + (size_t)l * D * INC, nullptr, D, INC, (bf16*)(ws + WS_WIN), NPROJ / 32, gw, NGW, scr, F.lane);
    conv_job<CM_PLAIN>(in[5] + (size_t)l * 512 * D, nullptr, 512, D, (bf16*)(ws + WS_WBF), D / 32, gw, NGW, scr, F.lane);
    conv_job<CM_PLAIN>(in[6] + (size_t)l * D * D, nullptr, D, D, (bf16*)(ws + WS_WBR), D / 32, gw, NGW, scr, F.lane);
    conv_job<CM_PLAIN>(in[7] + (size_t)l * D * D, nullptr, D, D, (bf16*)(ws + WS_WOUT), D / 32, gw, NGW, scr, F.lane);
    return; }
    const int i = l >> 1;
    if ((l & 1) == 0) {
        conv_job<CM_GU, true>(in[10] + (size_t)i * D * DFF, in[11] + (size_t)i * D * DFF, D, DFF, (bf16*)(ws + WS_WFF), 2 * DFF / 32, gw, NGW, scr, F.lane, F8_SW1);
        conv_job<CM_PLAIN, true>(in[12] + (size_t)i * DFF * D, nullptr, DFF, D, (bf16*)(ws + WS_WFF + 12 * MiB), D / 32, gw, NGW, scr, F.lane, F8_SW2);
    } else {
        for (int e = 0; e < NEXP; ++e) {
            const size_t o = ((size_t)i * NEXP + e) * D * DFE;
            conv_job<CM_GU, true>(in[14] + o, in[15] + o, D, DFE, (bf16*)(ws + WS_WFF + (size_t)e * 7 * MiB), 2 * DFE / 32, gw, NGW, scr, F.lane, F8_SW1);
            conv_job<CM_PLAIN, true>(in[16] + o, nullptr, DFE, D, (bf16*)(ws + WS_WFF + 56 * MiB + (size_t)e * (7 * MiB / 2)), D / 32, gw, NGW, scr, F.lane, F8_SW2);
        }
    }
}

template <int MODE, int EXTRA>
__device__ __forceinline__ void row_pass(Frame& F, const float* xin, float* xout, const float* lng, const float* lnb, const float* Wx, int wpitch, const float* bfg) {
    LAS float* WL = (LAS float*)F.lds;
    LAS int* EL = (LAS int*)(F.lds + 32768);
    unsigned char* ws = F.ws;
    const int lane = F.lane, wid = F.wave;
    float alpha_ = DN_ALPHA; asm volatile("" : "+v"(alpha_));
    if (EXTRA == 1 || EXTRA == 2) { for (int idx = F.tid; idx < 8192; idx += NTHR) { const int k = idx >> 3, hh = idx & 7; WL[hh * 1024 + k] = Wx[(size_t)k * wpitch + hh]; } }
    __syncthreads();
    f32x4 gv[4], bv[4];
    if (MODE) {
#pragma unroll
        for (int j = 0; j < 4; ++j) { gv[j] = *(const f32x4*)(lng + 4 * lane + 256 * j); bv[j] = *(const f32x4*)(lnb + 4 * lane + 256 * j); }
    }
    const bf16* HB = (const bf16*)(ws + WS_HB); const bf16* YS = (const bf16*)(ws + WS_ACT + A_XS); const bf16* YSP = (const bf16*)(ws + WS_ACT + A_YSP);
    bf16* XB = (bf16*)(ws + WS_XB);
    for (int blk = blockIdx.x; blk < M / 128; blk += F.G) {
        f32x4 xr[4]; v2u ha[4]; f32x4 hx[4];
#define ROW_LOAD(rr) do { const size_t r_ = (rr); \
            _Pragma("unroll") for (int j = 0; j < 4; ++j) xr[j] = *(const f32x4*)(xin + r_ * D + 4 * lane + 256 * j); \
            if (MODE == 1) { _Pragma("unroll") for (int j = 0; j < 4; ++j) ha[j] = *(const v2u*)(HB + r_ * D + 4 * lane + 256 * j); } \
            else if (MODE == 2) { const int rr_[2] = {((const int*)(ws + WS_RROW))[2 * r_], ((const int*)(ws + WS_RROW))[2 * r_ + 1]}; \
                const float ww_[2] = {((const float*)(ws + WS_RW))[2 * r_], ((const float*)(ws + WS_RW))[2 * r_ + 1]}; \
                _Pragma("unroll") for (int j = 0; j < 4; ++j) hx[j] = (f32x4){0.f, 0.f, 0.f, 0.f}; \
                _Pragma("unroll") for (int k_ = 0; k_ < 2; ++k_) { \
                    if (rr_[k_] < F.trow) { _Pragma("unroll") for (int j = 0; j < 4; ++j) { const v2u a_ = *(const v2u*)(YS + (size_t)rr_[k_] * D + 4 * lane + 256 * j); \
                            hx[j] += (f32x4){bflo(a_.x), bfhi(a_.x), bflo(a_.y), bfhi(a_.y)} * ww_[k_]; } } \
                    else { _Pragma("unroll") for (int s_ = 0; s_ < 4; ++s_) _Pragma("unroll") for (int j = 0; j < 4; ++j) { \
                            const v2u a_ = *(const v2u*)(YSP + ((size_t)s_ * 2048 + (size_t)(rr_[k_] - F.trow)) * D + 4 * lane + 256 * j); \
                            hx[j] += (f32x4){bflo(a_.x), bfhi(a_.x), bflo(a_.y), bfhi(a_.y)} * ww_[k_]; } } } } } while (0)
        ROW_LOAD((size_t)blk * 128 + wid);
        for (int i = 0; i < 16; ++i) {
            const int lr = wid + 8 * i; const size_t row = (size_t)blk * 128 + lr;
            f32x4 v[4];
            if (MODE == 3) {
#pragma unroll
                for (int j = 0; j < 4; ++j) v[j] = xr[j] * alpha_;
            } else if (MODE == 1) {
#pragma unroll
                for (int j = 0; j < 4; ++j) v[j] = xr[j] * alpha_ + (f32x4){bflo(ha[j].x), bfhi(ha[j].x), bflo(ha[j].y), bfhi(ha[j].y)};
            } else if (MODE == 2) {
#pragma unroll
                for (int j = 0; j < 4; ++j) v[j] = xr[j] * alpha_ + hx[j];
            } else {
#pragma unroll
                for (int j = 0; j < 4; ++j) v[j] = xr[j];
            }
            if (i + 1 < 16) ROW_LOAD(row + 8);
            if (MODE) {
                float s = 0.f;
#pragma unroll
                for (int j = 0; j < 4; ++j) s += (v[j][0] + v[j][1]) + (v[j][2] + v[j][3]);
                const float mean = wave_sum(s, lane) * (1.f / D); float s2 = 0.f;
#pragma unroll
                for (int j = 0; j < 4; ++j) { v[j] = v[j] - mean; s2 += (v[j][0] * v[j][0] + v[j][1] * v[j][1]) + (v[j][2] * v[j][2] + v[j][3] * v[j][3]); }
                const float rstd = 1.f / sqrtf(wave_sum(s2, lane) * (1.f / D) + LN_EPS);
#pragma unroll
                for (int j = 0; j < 4; ++j) v[j] = v[j] * rstd * gv[j] + bv[j];
            }
#pragma unroll
            for (int j = 0; j < 4; ++j) { if (MODE) *(f32x4*)(xout + row * D + 4 * lane + 256 * j) = v[j];
                if (!(EXTRA == 3 || EXTRA == 2 || (MODE == 2 && EXTRA == 0))) { v2u o; o.x = pk2(v[j][0], v[j][1]); o.y = pk2(v[j][2], v[j][3]); *(v2u*)(XB + row * D + 4 * lane + 256 * j) = o; }
                if (EXTRA == 3 || EXTRA == 2) *(unsigned*)(ws + WS_ACT + A_XB8 + row * D + 4 * lane + 256 * j) = pk4_fp8(v[j][0], v[j][1], v[j][2], v[j][3]); }
            if (EXTRA == 1 || EXTRA == 2) {
                float d8[8];
#pragma unroll
                for (int hh = 0; hh < 8; ++hh) { float a = 0.f;
#pragma unroll
                    for (int j = 0; j < 4; ++j) { const f32x4 w = *(const LAS f32x4*)(WL + hh * 1024 + 4 * lane + 256 * j); a += (v[j][0] * w[0] + v[j][1] * w[1]) + (v[j][2] * w[2] + v[j][3] * w[3]); }
                    d8[hh] = a; }
                float d4[4], d2[2], d1;
                { const bool up = lane & 1;
#pragma unroll
                  for (int q = 0; q < 4; ++q) { const float snd = up ? d8[q] : d8[q + 4]; const float r = shx(snd, 1, lane); d4[q] = (up ? d8[q + 4] : d8[q]) + r; } }
                { const bool up = lane & 2;
#pragma unroll
                  for (int q = 0; q < 2; ++q) { const float snd = up ? d4[q] : d4[q + 2]; const float r = shx(snd, 2, lane); d2[q] = (up ? d4[q + 2] : d4[q]) + r; } }
                { const bool up = lane & 4; const float snd = up ? d2[0] : d2[1]; const float r = shx(snd, 4, lane); d1 = (up ? d2[1] : d2[0]) + r; }
                d1 += shx(d1, 8, lane); d1 += shx(d1, 16, lane); d1 += shx(d1, 32, lane);
                const int myh = ((lane & 1) << 2) | (lane & 2) | ((lane >> 2) & 1);
                if (EXTRA == 1) {
                    const float z = d1 + bfg[myh];
                    const float lf = fminf(z, 0.f) - __logf(1.f + __expf(-fabsf(z)));
                    if (lane < 8) ((float*)(ws + WS_FLOG))[row * 8 + myh] = lf * LOG2E;
                } else {
                    float lg[8];
#pragma unroll
                    for (int e = 0; e < 8; ++e) lg[e] = shi(d1, ((e & 4) >> 2) | (e & 2) | ((e & 1) << 2));
                    int e0 = 0; float v0 = lg[0];
#pragma unroll
                    for (int e = 1; e < 8; ++e) if (lg[e] > v0) { v0 = lg[e]; e0 = e; }
                    int e1 = -1; float v1 = -INFINITY;
#pragma unroll
                    for (int e = 0; e < 8; ++e) if (e != e0 && lg[e] > v1) { v1 = lg[e]; e1 = e; }
                    const float w1 = 1.f / (1.f + expf(v0 - v1)), w0 = 1.f - w1;
                    if (lane == 0) { EL[2 * lr] = e0; EL[2 * lr + 1] = e1;
                        ((int*)(ws + WS_RE))[2 * row] = e0; ((int*)(ws + WS_RE))[2 * row + 1] = e1;
                        ((float*)(ws + WS_RW))[2 * row] = w0; ((float*)(ws + WS_RW))[2 * row + 1] = w1; }
                }
            }
        }
        if (EXTRA == 2) {
            __syncthreads();
            int msk[4]; int cnt = 0; unsigned long long bm[4];
#pragma unroll
            for (int q = 0; q < 4; ++q) { msk[q] = (EL[q * 64 + lane] == wid); bm[q] = __ballot(msk[q]); cnt += __popcll(bm[q]); }
            int base = 0;
            if (lane == 0) base = (int)__hip_atomic_fetch_add(F.ctl + F.cofs + wid, (unsigned)cnt, RLX_AGENT);
            base = __builtin_amdgcn_readfirstlane(base);
            int run = base;
#pragma unroll
            for (int q = 0; q < 4; ++q) { const int entry = q * 64 + lane; const int rk = run + __popcll(bm[q] & ((1ull << lane) - 1ull));
                if (msk[q]) ((int*)(ws + WS_RR))[(size_t)blk * 256 + entry] = rk;
                run += __popcll(bm[q]); }
            __syncthreads();
        }
    }
#undef ROW_LOAD
    __syncthreads();
}

__device__ __forceinline__ void moe_starts(Frame& F, int (&rs)[9]) {
    int a = 0;
#pragma unroll
    for (int e = 0; e < 8; ++e) { rs[e] = a; const int c = __builtin_amdgcn_readfirstlane((int)__hip_atomic_load(F.ctl + F.cofs + e, RLX_AGENT)); a += (c + 255) & ~255; }
    rs[8] = a;
}
__device__ __forceinline__ void moe_gather(Frame& F) {
    int rs[9]; moe_starts(F, rs);
    unsigned char* ws = F.ws;
    const int gw = F.vcu * NWAVES + F.wave, NGW = F.G * NWAVES;
    const v4u* XB8 = (const v4u*)(ws + WS_ACT + A_XB8); v4u* XS = (v4u*)(ws + WS_ACT + A_XS);
    for (int t = gw; t < M; t += NGW) {
        const v4u a = XB8[(size_t)t * 64 + F.lane];
#pragma unroll
        for (int k = 0; k < 2; ++k) {
            const int e = ((const int*)(ws + WS_RE))[2 * t + k], rel = ((const int*)(ws + WS_RR))[2 * t + k];
            int st = 0;
#pragma unroll
            for (int j = 0; j < 8; ++j) st = (e == j) ? rs[j] : st;
            const int row = st + rel;
            if (F.lane == 0) ((int*)(ws + WS_RROW))[2 * t + k] = row;
            XS[(size_t)row * 64 + F.lane] = a;
        }
    }
}

__device__ __forceinline__ void cs_table(Frame& F, const int* pos) {
    float* cosT = (float*)(F.ws + WS_COS); float* sinT = (float*)(F.ws + WS_SIN);
    const int gt = F.vcu * NTHR + F.tid, NG = F.G * NTHR;
    for (int idx = gt; idx < M * 32; idx += NG) {
        const int row = idx >> 5, i = idx & 31;
        const float inv = powf(10000.0f, -(float)i / 32.0f);
        const float ang = (float)pos[row] * inv;
        cosT[idx] = cosf(ang); sinT[idx] = sinf(ang);
    }
}

__device__ __forceinline__ void ret_state(Frame& F) {
    unsigned char* ws = F.ws;
    const bf16* KB = (const bf16*)(ws + WS_ACT + A_KB); const bf16* VB = (const bf16*)(ws + WS_ACT + A_VB); bf16* PT = (bf16*)(ws + WS_ACT + A_PT);
    const int tid = F.tid, lane = F.lane, wid = F.wave, et = wid >> 2, dt = wid & 3, fr = lane & 15, fq = lane >> 4;
    for (int it = F.vcu; it < 256; it += F.G) {
        const int b = it >> 5, h = (it >> 2) & 7, eq = it & 3;
        const float l2g = log2f(1.f - exp2f(-5.f - (float)h));
        const int j = tid & 127, pp = tid >> 7;
        const float kdec = exp2f((float)(127 - j) * l2g), cd = exp2f(128.f * l2g);
        const bf16* kp = KB + ((size_t)b * SEQ + j) * 512 + h * 64 + pp * 8;
        const bf16* vp = VB + ((size_t)b * SEQ + j) * 1024 + h * 128 + eq * 32 + pp * 8;
        f32x4 acc = {0.f, 0.f, 0.f, 0.f};
        v4u k0 = *(const v4u*)kp, k1 = *(const v4u*)(kp + 32), vv = *(const v4u*)vp;
        for (int n = 0; n < 32; ++n) {
            LAS bf16* KT = (LAS bf16*)(F.lds + (n & 1) * 26112); LAS bf16* VT = KT + 64 * 136;
#pragma unroll
            for (int i = 0; i < 4; ++i) { const unsigned a = k0[i], c = k1[i], d = vv[i];
                KT[(pp * 8 + 2 * i) * 136 + j] = (bf16)f2bf(bflo(a) * kdec); KT[(pp * 8 + 2 * i + 1) * 136 + j] = (bf16)f2bf(bfhi(a) * kdec);
                KT[(pp * 8 + 32 + 2 * i) * 136 + j] = (bf16)f2bf(bflo(c) * kdec); KT[(pp * 8 + 33 + 2 * i) * 136 + j] = (bf16)f2bf(bfhi(c) * kdec);
                VT[(pp * 8 + 2 * i) * 136 + j] = (bf16)(d & 0xffffu); VT[(pp * 8 + 2 * i + 1) * 136 + j] = (bf16)(d >> 16); }
            if (n + 1 < 32) { const size_t o = (size_t)(n + 1) * 128; k0 = *(const v4u*)(kp + o * 512); k1 = *(const v4u*)(kp + o * 512 + 32); vv = *(const v4u*)(vp + o * 1024); }
            __syncthreads();
            bf16* pt = PT + ((((size_t)b * 32 + n) * 8 + h) * 128 + eq * 32 + et * 16 + 4 * fq) * 64 + dt * 16 + fr;
#pragma unroll
            for (int q = 0; q < 4; ++q) pt[q * 64] = (bf16)f2bf(acc[q]);
            acc = acc * cd;
#pragma unroll
            for (int ks = 0; ks < 4; ++ks) {
                const bf16x8 a = *(const LAS bf16x8*)(VT + (et * 16 + fr) * 136 + ks * 32 + 8 * fq);
                const bf16x8 bb = *(const LAS bf16x8*)(KT + (dt * 16 + fr) * 136 + ks * 32 + 8 * fq);
                acc = __builtin_amdgcn_mfma_f32_16x16x32_bf16(a, bb, acc, 0, 0, 0);
            }
        }
        __syncthreads();
    }
}
template <bool FULL>
__device__ __forceinline__ void ret_out(Frame& F, const float* rng) {
    unsigned char* ws = F.ws;
    const bf16* QB = (const bf16*)(ws + WS_ACT + A_QB); const bf16* KB = (const bf16*)(ws + WS_ACT + A_KB); const bf16* VB = (const bf16*)(ws + WS_ACT + A_VB);
    const bf16* GB = (const bf16*)(ws + WS_ACT + A_GB); const bf16* PT = (const bf16*)(ws + WS_ACT + A_PT); bf16* OB = (bf16*)(ws + WS_ACT + A_OB);
    LAS bf16* Qs = (LAS bf16*)F.lds; LAS bf16* Ks = Qs + 128 * 72; LAS bf16* Ps = Ks + 128 * 72; LAS bf16* VT = Ps + 128 * 72; LAS bf16* Ss = VT + 128 * 136;
    const int tid = F.tid, lane = F.lane, wid = F.wave, fr = lane & 15, fq = lane >> 4;
    const int il = 16 * wid + fr;
    int u = F.vcu; if (u >= 2048) return;
    v4u rq[2], rk[2], rp[2], rv[4];
#define RET_LOAD(uu) do { const int b_ = (uu) >> 8, n_ = ((uu) >> 3) & 31, h_ = (uu) & 7; const size_t t0_ = (size_t)b_ * SEQ + n_ * 128; \
        _Pragma("unroll") for (int i = 0; i < 2; ++i) { const int p = tid + 512 * i, r = p >> 3, c = p & 7; \
            rq[i] = *(const v4u*)(QB + (t0_ + r) * 512 + h_ * 64 + c * 8); rk[i] = *(const v4u*)(KB + (t0_ + r) * 512 + h_ * 64 + c * 8); \
            rp[i] = *(const v4u*)(PT + ((((size_t)b_ * 32 + n_) * 8 + h_) * 128 + r) * 64 + c * 8); } \
        _Pragma("unroll") for (int i = 0; i < 4; ++i) { const int p = tid + 512 * i, ep = p >> 7, j = p & 127; rv[i] = *(const v4u*)(VB + (t0_ + j) * 1024 + h_ * 128 + ep * 8); } } while (0)
    RET_LOAD(u);
    for (;;) {
        const int b = u >> 8, n = (u >> 3) & 31, h = u & 7;
        const float l2g = log2f(1.f - exp2f(-5.f - (float)h));
        const size_t tok0 = (size_t)b * SEQ + n * 128;
#pragma unroll
        for (int i = 0; i < 2; ++i) { const int p = tid + 512 * i, r = p >> 3, c = p & 7;
            *(LAS v4u*)(Qs + r * 72 + c * 8) = rq[i]; *(LAS v4u*)(Ks + r * 72 + c * 8) = rk[i]; *(LAS v4u*)(Ps + r * 72 + c * 8) = rp[i]; }
#pragma unroll
        for (int i = 0; i < 4; ++i) { const int p = tid + 512 * i, ep = p >> 7, j = p & 127;
#pragma unroll
            for (int q = 0; q < 4; ++q) { VT[(ep * 8 + 2 * q) * 136 + j] = (bf16)(rv[i][q] & 0xffffu); VT[(ep * 8 + 2 * q + 1) * 136 + j] = (bf16)(rv[i][q] >> 16); } }
        asm volatile("s_waitcnt lgkmcnt(0)\n\ts_barrier" ::: "memory");
        const int un = u + F.G;
        const size_t row = tok0 + il;
        v2u gbr[8]; f32x4 g4[8];
        if (FULL) {
#pragma unroll
        for (int et = 0; et < 8; ++et) { const int e = h * 128 + et * 16 + 4 * fq; gbr[et] = *(const v2u*)(GB + row * 1024 + e); g4[et] = *(const f32x4*)(rng + e); }
        }
        if (un < 2048) RET_LOAD(un);
        if (FULL) {
        bf16x8 qf[2];
#pragma unroll
        for (int ks = 0; ks < 2; ++ks) qf[ks] = *(const LAS bf16x8*)(Qs + il * 72 + ks * 32 + 8 * fq);
        const int nks = (wid >> 1) + 1;
#pragma unroll
        for (int jt = 0; jt < 8; ++jt) {
            if (jt <= wid) {
                f32x4 st = {0.f, 0.f, 0.f, 0.f};
#pragma unroll
                for (int ks = 0; ks < 2; ++ks) { const bf16x8 kf = *(const LAS bf16x8*)(Ks + (jt * 16 + fr) * 72 + ks * 32 + 8 * fq); st = __builtin_amdgcn_mfma_f32_16x16x32_bf16(kf, qf[ks], st, 0, 0, 0); }
                f32x4 o;
#pragma unroll
                for (int q = 0; q < 4; ++q) { const int jj = jt * 16 + 4 * fq + q; o[q] = (il >= jj) ? st[q] * exp2f((float)(il - jj) * l2g) : 0.f; }
                v2u w; w.x = pk2(o[0], o[1]); w.y = pk2(o[2], o[3]);
                *(LAS v2u*)(Ss + il * 136 + jt * 16 + 4 * fq) = w;
            } else if (jt < 2 * nks) { *(LAS v2u*)(Ss + il * 136 + jt * 16 + 4 * fq) = (v2u){0u, 0u}; }
        }
        LDS_WAIT();
        f32x4 acc[8];
        const float qd = exp2f((float)(il + 1) * l2g);
#pragma unroll
        for (int et = 0; et < 8; ++et) { f32x4 a = {0.f, 0.f, 0.f, 0.f};
#pragma unroll
            for (int ks = 0; ks < 2; ++ks) { const bf16x8 pf = *(const LAS bf16x8*)(Ps + (et * 16 + fr) * 72 + ks * 32 + 8 * fq); a = __builtin_amdgcn_mfma_f32_16x16x32_bf16(pf, qf[ks], a, 0, 0, 0); }
            acc[et] = a * qd; }
#pragma unroll
        for (int ks = 0; ks < 4; ++ks) { if (ks < nks) { const bf16x8 sf = *(const LAS bf16x8*)(Ss + il * 136 + ks * 32 + 8 * fq);
#pragma unroll
            for (int et = 0; et < 8; ++et) { const bf16x8 vf = *(const LAS bf16x8*)(VT + (et * 16 + fr) * 136 + ks * 32 + 8 * fq); acc[et] = __builtin_amdgcn_mfma_f32_16x16x32_bf16(vf, sf, acc[et], 0, 0, 0); } } }
        float ss = 0.f;
#pragma unroll
        for (int et = 0; et < 8; ++et) ss += (acc[et][0] * acc[et][0] + acc[et][1] * acc[et][1]) + (acc[et][2] * acc[et][2] + acc[et][3] * acc[et][3]);
        ss += shx(ss, 16, lane); ss += shx(ss, 32, lane);
        const float rn = 1.f / sqrtf(ss * (1.f / 128.f) + RMS_EPS);
#pragma unroll
        for (int et = 0; et < 8; ++et) { const int e = h * 128 + et * 16 + 4 * fq;
            const f32x4 gg = {bflo(gbr[et].x), bfhi(gbr[et].x), bflo(gbr[et].y), bfhi(gbr[et].y)};
            const f32x4 o = acc[et] * rn * g4[et] * (f32x4){gg[0] * fsigmoid(gg[0]), gg[1] * fsigmoid(gg[1]), gg[2] * fsigmoid(gg[2]), gg[3] * fsigmoid(gg[3])};
            v2u w; w.x = pk2(o[0], o[1]); w.y = pk2(o[2], o[3]); *(v2u*)(OB + row * 1024 + e) = w; }
        }
        asm volatile("s_waitcnt lgkmcnt(0)\n\ts_barrier" ::: "memory");
        if (un >= 2048) break;
        u = un;
    }
#undef RET_LOAD
}

#ifdef RETCHK
__device__ __forceinline__ int qerr(float e) { return e > 0.25f ? 0 : e > 0.03f ? 1 : e > 0.004f ? 2 : e > 0.0005f ? 3 : 4; }
__device__ __forceinline__ void ret_check(Frame& F, const float* const* in, const float* rng) {
    if (blockIdx.x != 0) return;
    unsigned char* ws = F.ws;
    const bf16* QB = (const bf16*)(ws + WS_ACT + A_QB); const bf16* KB = (const bf16*)(ws + WS_ACT + A_KB); const bf16* VB = (const bf16*)(ws + WS_ACT + A_VB);
    const bf16* GB = (const bf16*)(ws + WS_ACT + A_GB); const bf16* PT = (const bf16*)(ws + WS_ACT + A_PT); const bf16* OB = (const bf16*)(ws + WS_ACT + A_OB);
    const int lane = F.lane;
    float w1 = 0.f, w2 = 0.f, w3 = 0.f;
    for (int p = F.wave; p < 64; p += 8) {
        const int ti = p >> 3, h = p & 7;
        const int row = ti == 0 ? 0 : ti == 1 ? 1 : ti == 2 ? 127 : ti == 3 ? 128 : ti == 4 ? 200 : ti == 5 ? 1000 : ti == 6 ? 4095 : 4096 + 2500;
        const int b = row / SEQ, t = row % SEQ, n = t >> 7, i = t & 127;
        const float l2g = log2f(1.f - exp2f(-5.f - (float)h));
        float q[64];
#pragma unroll
        for (int d = 0; d < 64; ++d) q[d] = bf2f(QB[(size_t)row * 512 + h * 64 + d]);
        float y0 = 0.f, y1 = 0.f, yi0 = 0.f, yi1 = 0.f;
        for (int s = 0; s <= t; ++s) {
            const bf16* kr = KB + ((size_t)b * SEQ + s) * 512 + h * 64; float dot = 0.f;
#pragma unroll
            for (int d = 0; d < 64; ++d) dot += q[d] * bf2f(kr[d]);
            const float w = dot * exp2f((float)(t - s) * l2g);
            const float v0 = bf2f(VB[((size_t)b * SEQ + s) * 1024 + h * 128 + 2 * lane]), v1 = bf2f(VB[((size_t)b * SEQ + s) * 1024 + h * 128 + 2 * lane + 1]);
            y0 += w * v0; y1 += w * v1; if (s >= n * 128) { yi0 += w * v0; yi1 += w * v1; }
        }
        const bf16* pt = PT + ((((size_t)b * 32 + n) * 8 + h) * 128 + 2 * lane) * 64; float c0 = 0.f, c1 = 0.f;
#pragma unroll
        for (int d = 0; d < 64; ++d) { c0 += q[d] * bf2f(pt[d]); c1 += q[d] * bf2f(pt[64 + d]); }
        const float qd = exp2f((float)(i + 1) * l2g);
        const float z0 = yi0 + qd * c0, z1 = yi1 + qd * c1;
        const float ms = wave_sum(y0 * y0 + y1 * y1, lane) * (1.f / 128.f), rms = sqrtf(ms) + 1e-20f;
        float e1 = fmaxf(fabsf(z0 - y0), fabsf(z1 - y1)) / rms;
#pragma unroll
        for (int o = 1; o < 64; o <<= 1) e1 = fmaxf(e1, shx(e1, o, lane));
        w1 = fmaxf(w1, e1);
        const float rn = 1.f / sqrtf(ms + RMS_EPS); const int e = h * 128 + 2 * lane;
        const float o0 = y0 * rn * rng[e] * bf2f(GB[(size_t)row * 1024 + e]), o1 = y1 * rn * rng[e + 1] * bf2f(GB[(size_t)row * 1024 + e + 1]);
        const float os = sqrtf(wave_sum(o0 * o0 + o1 * o1, lane) * (1.f / 128.f)) + 1e-20f;
        float e2 = fmaxf(fabsf(o0 - bf2f(OB[(size_t)row * 1024 + e])), fabsf(o1 - bf2f(OB[(size_t)row * 1024 + e + 1]))) / os;
#pragma unroll
        for (int o = 1; o < 64; o <<= 1) e2 = fmaxf(e2, shx(e2, o, lane));
        w2 = fmaxf(w2, e2);
    }
    {
        const int sel = (lane >> 1) & 3; const int cc = (3 + 37 * (lane >> 3) + F.wave * 101) % 1024;
        const int r = (sel == 0 ? 2560 : sel == 1 ? 4608 : sel == 2 ? 5632 : 3584) + cc; const int rho = r & 31; const int col = r - rho + 8 + pg8::perm32(rho);
        const bf16* WT = (const bf16*)(ws + WS_WIN); const float* W = in[2];
        float e3 = 0.f;
        for (int kk = 0; kk < 16; ++kk) { const int k = kk * 64 + ((lane & 1) * 32 + (lane >> 3) * 3 + F.wave) % 64; e3 += fabsf(bf2f(WT[(size_t)r * D + k]) - W[(size_t)k * INC + col]); }
        e3 *= (1.f / 16.f) * 30.f;
        e3 += shx(e3, 1, lane); e3 += shx(e3, 8, lane); e3 += shx(e3, 16, lane); e3 += shx(e3, 32, lane);
        w3 = e3 * (1.f / 16.f);
    }
    LAS float* red = (LAS float*)F.lds;
    if (lane == 0 || lane == 2 || lane == 4 || lane == 6) red[F.wave * 4 + (lane >> 1)] = w3;
    __syncthreads();
    if (F.tid == 0) { float s[4] = {0.f, 0.f, 0.f, 0.f}; for (int w = 0; w < 8; ++w) { s[0] += red[w * 4] * 0.125f; s[1] += red[w * 4 + 1] * 0.125f; s[2] += red[w * 4 + 2] * 0.125f; s[3] += red[w * 4 + 3] * 0.125f; }
        ((float*)F.ctl)[200] = 1000.f * (1.f + floorf(100.f * s[CHKSEL] + 0.5f)); }
    __syncthreads();
}
#endif
#define XB_TMO      128
#define XB_XCNT(j)  (256  + 64 * (j))
#define XB_XSUB(j)  (1280 + 64 * (j))
#define XB_XGEN(j)  (2304 + 64 * (j))
#define XB_TOP      3328
#define XB_TOPGEN   3392
#define XCD_BAR_WORDS 3456
#define XB_SPIN_CAP (1u << 18)

__device__ __forceinline__ unsigned xb_ld(unsigned* p)              { return __hip_atomic_load(p, __ATOMIC_RELAXED, __HIP_MEMORY_SCOPE_AGENT); }
__device__ __forceinline__ unsigned xb_add(unsigned* p, unsigned v) { return __hip_atomic_fetch_add(p, v, __ATOMIC_RELAXED, __HIP_MEMORY_SCOPE_AGENT); }
__device__ __forceinline__ unsigned xb_xcc_id() { return (unsigned)__builtin_amdgcn_s_getreg((3 << 11) | 20) & 0xFu; }
#define XB_SPIN(cond, bar) do { unsigned _sp = 0; while (cond) { __builtin_amdgcn_s_sleep(1); \
    if ((++_sp & 255u) == 0u) { if (xb_ld(&(bar)[XB_TMO])) break; if (_sp > XB_SPIN_CAP) { atomicAdd(&(bar)[XB_TMO], 1u); break; } } } } while (0)

struct XcdBarrier {
    unsigned* bar; unsigned x;
    volatile LAS unsigned* st;
};

__device__ __forceinline__ XcdBarrier xcd_barrier_post(unsigned* bar, volatile LAS unsigned* st) {
    XcdBarrier b; b.bar = bar; b.x = xb_xcc_id(); b.st = st;
    if (threadIdx.x == 0) (void)xb_add(&bar[XB_XCNT(b.x)], 1u);
    return b;
}
__device__ __forceinline__ void xcd_barrier_complete(unsigned* bar, unsigned x, unsigned& nloc, unsigned& nx) {
    const unsigned G = gridDim.x * gridDim.y * gridDim.z;
    unsigned sum, cnt, mine, sp = 0u;
    for (;;) {
        sum = 0u; cnt = 0u; mine = 0u;
#pragma unroll
        for (unsigned j = 0; j < 16; ++j) { const unsigned c = xb_ld(&bar[XB_XCNT(j)]); sum += c; cnt += (c > 0u) ? 1u : 0u; mine = (j == x) ? c : mine; }
        if (sum == G) break;
        __builtin_amdgcn_s_sleep(1);
        if ((++sp & 255u) == 0u) { if (xb_ld(&bar[XB_TMO])) break; if (sp > XB_SPIN_CAP) { atomicAdd(&bar[XB_TMO], 1u); break; } }
    }
    nloc = mine > 0u ? mine : 1u; nx = cnt > 0u ? cnt : 1u;
}

__device__ __forceinline__ void xcd_barrier(const XcdBarrier& b) {
    asm volatile("s_waitcnt vmcnt(0)" ::: "memory");
    __syncthreads();
    if (threadIdx.x == 0) {
        unsigned* bar = b.bar; asm volatile("" : "+s"(bar));
        __builtin_amdgcn_s_waitcnt(0);
        const unsigned bx_ = (unsigned)__builtin_amdgcn_readfirstlane((int)b.x);
        unsigned nloc = b.st[0], nx = b.st[1];
        if (nloc == 0u) { xcd_barrier_complete(bar, bx_, nloc, nx); b.st[0] = nloc; b.st[1] = nx; }
        const unsigned old = xb_add(&bar[XB_XSUB(bx_)], 1u);
        const unsigned gen = old / nloc;
        if (old + 1u == (gen + 1u) * nloc) {
            __builtin_amdgcn_fence(__ATOMIC_RELEASE, "agent");
            asm volatile("s_waitcnt vmcnt(0)" ::: "memory");
            const unsigned og = xb_add(&bar[XB_TOP], 1u);
            const unsigned tg = og / nx;
            if (og + 1u == (tg + 1u) * nx) xb_add(&bar[XB_TOPGEN], 1u);
            else XB_SPIN(xb_ld(&bar[XB_TOPGEN]) == tg, bar);
            __builtin_amdgcn_fence(__ATOMIC_ACQUIRE, "agent");
            xb_add(&bar[XB_XGEN(bx_)], 1u);
            asm volatile("s_waitcnt vmcnt(0)" ::: "memory");
        } else {
            XB_SPIN(xb_ld(&bar[XB_XGEN(bx_)]) == gen, bar);
            __builtin_amdgcn_fence(__ATOMIC_ACQUIRE, "agent");
            asm volatile("s_waitcnt vmcnt(0)" ::: "memory");
        }
    }
    __syncthreads();
}

#ifndef PHM
#define PHM 0xffff
#endif
#ifndef ZH
#define ZH 0
#endif
#ifndef ZB
#define ZB 0
#endif
#ifndef DUP
#define DUP 0
#endif
struct Args { const float* in[19]; float* out; unsigned char* ws; };
__global__ void __launch_bounds__(NTHR, 2) mega_fwd(Args args) {
    extern __shared__ __attribute__((aligned(16))) unsigned char lds[];
    cg::grid_group grid = cg::this_grid();
    Frame F;
    F.lds = (LAS unsigned char*)lds; F.ws = args.ws; F.ctl = (unsigned*)(args.ws + WS_CTL);
    F.tid = threadIdx.x; F.lane = F.tid & 63; F.wave = __builtin_amdgcn_readfirstlane(F.tid >> 6);
    F.cofs = 64; F.trow = 1 << 30; F.G = gridDim.x; { const int bx = blockIdx.x; F.vcu = (F.G % 8 == 0) ? (bx % 8) * (F.G / 8) + bx / 8 : bx; }
    unsigned char* ws = args.ws; unsigned char* act = ws + WS_ACT;
    volatile LAS unsigned* xst = (volatile LAS unsigned*)(F.lds + 131072 + 512);
    if (F.tid < 2) xst[F.tid] = 0u;
    __syncthreads();
    const float* const* in = args.in;
    float* X = args.out;
    bf16* XB = (bf16*)(ws + WS_XB); bf16* HB = (bf16*)(ws + WS_HB);
    typedef pg8::StaticOrder SO;
#define GSYNC0() do { asm volatile("s_waitcnt vmcnt(0) lgkmcnt(0)" ::: "memory"); grid.sync(); __builtin_amdgcn_fence(__ATOMIC_ACQUIRE, "agent"); asm volatile("s_waitcnt vmcnt(0)" ::: "memory"); } while (0)
#define GSYNC() xcd_barrier(xbar)
#define OPQ() do { asm volatile("" : "+s"(F.wave), "+s"(F.vcu), "+s"(ws), "+s"(act)); F.ws = ws; F.lane = pg8::lane_id_opaque(); F.tid = F.wave * 64 + F.lane; } while (0)
#define GEMM(EpiT, OrdT, g, S, E) pg8::gemm_phase<EpiT, OrdT, true, true>(F.lds, g, S, E, F.wave)
#define GEMM8(EpiT, OrdT, g, S, E) pg8::gemm_phase<EpiT, OrdT, true, true, true>(F.lds, g, S, E, F.wave)

    if (blockIdx.x == 0) { for (int i_ = F.tid; i_ < 8192; i_ += NTHR) F.ctl[i_] = 0u; }
    GSYNC0();
    const XcdBarrier xbar = xcd_barrier_post(F.ctl + 4096, xst);
    if (PHM & 1) cs_table(F, (const int*)in[1]);
    if (PHM & 2) row_pass<0, 1>(F, in[0], X, nullptr, nullptr, in[2] + 1536, INC, in[3]);
    if (PHM & 4) conv_layer(F, in, 0, 0);
    GSYNC();

#pragma unroll 1
    for (int l = 0; l < DEPTH; ++l) {
        const int fi = l >> 1; const bool moe = (l & 1) != 0; F.cofs = 64 + 16 * fi; OPQ();
        if (DUP & 32) { for (int k_ = 0; k_ < 10; ++k_) { GSYNC(); } }
        if (PHM & 8) { pg8::Gemm g{XB, (const bf16*)(ws + WS_WIN), M, NPROJ, D}; SO S; S.init(M, NPROJ, F.G, (int)blockIdx.x);
          epi::EpiInProj E{act, (const float*)(ws + WS_COS), (const float*)(ws + WS_SIN)};
          GEMM(epi::EpiInProj, SO, g, S, E); if (DUP & 16) { OPQ(); GEMM(epi::EpiInProj, SO, g, S, E); } }
        GSYNC(); OPQ();
        if (PHM & 16) ret_state(F);
        if (DUP & 2) { OPQ(); ret_state(F); }
        OPQ();
        if (PHM & 32) { const attn_body::AttnTensors AT{(const attn_body::bf16*)(act + A_QA), (const attn_body::bf16*)(act + A_KA), (const attn_body::bf16*)(act + A_VA), (attn_body::bf16*)(act + A_QA), (const float*)(ws + WS_FLOG)};
          const attn_body::StaticOrder S((int)F.G, (int)blockIdx.x);
          attn_body::attn_phase<attn_body::StaticOrder>((char*)lds, AT, S, F.wave); }
        GSYNC(); OPQ();
        if (PHM & 64) ret_out<true>(F, in[4] + (size_t)l * 1024);
        if (DUP & 4) { OPQ(); ret_out<true>(F, in[4] + (size_t)l * 1024); }
        if (DUP & 64) { OPQ(); ret_out<false>(F, in[4] + (size_t)l * 1024); }
        GSYNC(); OPQ();
#ifdef RETCHK
        if (l == 0) { ret_check(F, in, in[4]); OPQ(); }
#endif
        if (PHM & 128) { pg8::Gemm g{(const bf16*)(act + A_QA), (const bf16*)(ws + WS_WBF), M, D, 512}; SO S; S.init(M, D, F.G, (int)blockIdx.x);
          epi::EpiGated E{(bf16*)(act + A_T1), D, (const bf16*)(act + A_GATE), 2048, nullptr, (ZB & 1) ? 0.f : 1.f};
          GEMM(epi::EpiGated, SO, g, S, E); }
        OPQ();
        if (PHM & 128) { pg8::Gemm g{(const bf16*)(act + A_OB), (const bf16*)(ws + WS_WBR), M, D, D}; SO S; S.init(M, D, F.G, (int)blockIdx.x);
          epi::EpiGated E{(bf16*)(act + A_T1), D, (const bf16*)(act + A_GATE) + 1024, 2048, (const bf16*)(act + A_T1), (ZB & 2) ? 0.f : 1.f};
          GEMM(epi::EpiGated, SO, g, S, E); }
        GSYNC(); OPQ();
        if (PHM & 128) { pg8::Gemm g{(const bf16*)(act + A_T1), (const bf16*)(ws + WS_WOUT), M, D, D}; SO S; S.init(M, D, F.G, (int)blockIdx.x);
          epi::EpiGated E{HB, D, nullptr, 0, nullptr, 1.f};
          GEMM(epi::EpiGated, SO, g, S, E); if (DUP & 128) { OPQ(); GEMM(epi::EpiGated, SO, g, S, E); } }
        GSYNC(); OPQ();
        if (!(PHM & 256)) {} else if (moe) row_pass<(ZH & 1) ? 3 : 1, 2>(F, X, X, in[8] + (size_t)l * D, in[9] + (size_t)l * D, in[13] + (size_t)fi * D * NEXP, NEXP, nullptr);
        else row_pass<(ZH & 1) ? 3 : 1, 3>(F, l == 0 ? in[0] : (const float*)X, X, in[8] + (size_t)l * D, in[9] + (size_t)l * D, nullptr, 0, nullptr);
        OPQ();
        if (PHM & 4) conv_layer(F, in, l, 1);
        GSYNC(); OPQ();
#ifdef ONLYMOE
        if (!moe) {} else
#endif
        if (!(PHM & 512)) {} else if (!moe) {
            { pg8::Gemm g{(const bf16*)(act + A_XB8), (const bf16*)(ws + WS_WFF), M, 2 * DFF, D / 2, 0}; SO S; S.init(M, 2 * DFF, F.G, (int)blockIdx.x);
              epi::EpiSwiGLU8 E{(unsigned char*)(act + A_H), DFF, 1.f / F8_SW1, F8_SH};
              GEMM8(epi::EpiSwiGLU8, SO, g, S, E); }
            GSYNC(); OPQ();
            { pg8::Gemm g{(const bf16*)(act + A_H), (const bf16*)(ws + WS_WFF + 12 * MiB), M, D, DFF / 2, 0}; SO S; S.init(M, D, F.G, (int)blockIdx.x);
              epi::EpiGated E{HB, D, nullptr, 0, nullptr, 1.f / (F8_SH * F8_SW2)};
              GEMM8(epi::EpiGated, SO, g, S, E); }
            GSYNC(); OPQ();
            row_pass<(ZH & 2) ? 3 : 1, 1>(F, X, X, in[17] + (size_t)l * D, in[18] + (size_t)l * D, in[2] + (size_t)(l + 1) * D * INC + 1536, INC, in[3] + (l + 1) * 8);
        } else {
            moe_gather(F);
            GSYNC(); OPQ();
            { epi::MoeOrder S; moe_starts(F, S.ts);
#pragma unroll
              for (int e = 0; e < 9; ++e) S.ts[e] >>= 8;
              S.NT = 2 * DFE / 256; S.G = F.G; S.c = (int)blockIdx.x; S.lim = S.ts[8] * S.NT; S.rev = 0;
              pg8::Gemm g{(const bf16*)(act + A_XS), (const bf16*)(ws + WS_WFF), XS_ROWS, 2 * DFE, D / 2, 0};
              epi::EpiSwiGLU8 E{(unsigned char*)(act + A_HS), DFE, 1.f / F8_SW1, F8_SH};
              GEMM8(epi::EpiSwiGLU8, epi::MoeOrder, g, S, E); if (DUP & 8) { OPQ(); GEMM8(epi::EpiSwiGLU8, epi::MoeOrder, g, S, E); } }
            GSYNC(); OPQ();
            { epi::MoeOrder S; moe_starts(F, S.ts);
#pragma unroll
              for (int e = 0; e < 9; ++e) S.ts[e] >>= 8;
              S.NT = D / 256; S.G = F.G; S.c = (int)blockIdx.x; S.rev = 1;
              S.lim = S.ts[8] * 4;
              pg8::Gemm g{(const bf16*)(act + A_HS), (const bf16*)(ws + WS_WFF + 56 * MiB), XS_ROWS, D, DFE / 2, 0};
              epi::EpiGated E{(bf16*)(act + A_XS), D, nullptr, 0, nullptr, 1.f / (F8_SH * F8_SW2)};
              GEMM8(epi::EpiGated, epi::MoeOrder, g, S, E);
              F.trow = 1 << 30; }
            GSYNC(); OPQ();
            if (l + 1 < DEPTH) row_pass<(ZH & 4) ? 3 : 2, 1>(F, X, X, in[17] + (size_t)l * D, in[18] + (size_t)l * D, in[2] + (size_t)(l + 1) * D * INC + 1536, INC, in[3] + (l + 1) * 8);
            else row_pass<(ZH & 4) ? 3 : 2, 0>(F, X, X, in[17] + (size_t)l * D, in[18] + (size_t)l * D, nullptr, 0, nullptr);
        }
        if (l + 1 < DEPTH) { if (PHM & 4) conv_layer(F, in, l + 1, 0); GSYNC(); }
    }
#ifdef RETCHK
    GSYNC();
    if (blockIdx.x == 0 && F.tid == 0) { X[0] = ((float*)F.ctl)[200]; }
#endif
#undef GEMM
}

constexpr int LDS_DYN = 147456;
extern "C" void kernel_launch(void* const* d_in, const int* in_sizes, int n_in, void* d_out, int out_size, void* d_ws, size_t ws_size, hipStream_t stream) {
    static int grid = 0;
    if (grid == 0) {
        if (n_in != 19 || out_size != M * D || ws_size < WS_END) { fprintf(stderr, "kernel_launch: bad shapes (n_in %d out %d ws %zu need %zu)\n", n_in, out_size, ws_size, (size_t)WS_END); grid = -1; return; }
        int dev = 0, cus = 0, per_cu = 0;
        hipGetDevice(&dev); hipDeviceGetAttribute(&cus, hipDeviceAttributeMultiprocessorCount, dev);
        if (hipFuncSetAttribute((const void*)mega_fwd, hipFuncAttributeMaxDynamicSharedMemorySize, LDS_DYN) != hipSuccess) { fprintf(stderr, "kernel_launch: hipFuncSetAttribute failed\n"); grid = -1; return; }
        if (hipOccupancyMaxActiveBlocksPerMultiprocessor(&per_cu, (const void*)mega_fwd, NTHR, LDS_DYN) != hipSuccess || per_cu < 1) { fprintf(stderr, "kernel_launch: occupancy query says %d\n", per_cu); per_cu = 1; }
        (void)hipGetLastError();
        grid = cus * per_cu;
        fprintf(stderr, "kernel_launch: grid %d (cus %d x %d)\n", grid, cus, per_cu);
    }
    if (grid < 0) return;
    (void)hipMemsetAsync((char*)d_ws + WS_CTL, 0, 65536, stream);
    Args a{};
    for (int i = 0; i < 19; ++i) a.in[i] = (const float*)d_in[i];
    a.out = (float*)d_out; a.ws = (unsigned char*)d_ws;
    void* kargs[] = {&a};
    const hipError_t e = hipLaunchCooperativeKernel((const void*)mega_fwd, dim3(grid), dim3(NTHR), kargs, LDS_DYN, stream);
    if (e != hipSuccess) fprintf(stderr, "kernel_launch: cooperative launch failed: %s (grid %d)\n", hipGetErrorString(e), grid);
}
```

```cpp
#include <hip/hip_runtime.h>
#include <cstdio>
#include <cstdint>
namespace pg8 {
#define PG8_LAS __attribute__((address_space(3)))
typedef unsigned short bf16_t;
typedef short bf16x8 __attribute__((ext_vector_type(8)));
typedef float f32x4 __attribute__((ext_vector_type(4)));
typedef unsigned u32x4 __attribute__((ext_vector_type(4)));
constexpr int BM = 256, BK = 64, HALF = 128, HTB = HALF * BK * 2  , STAGE_BYTES = 8 * HTB, NXCD = 8, WGM = 8;

__host__ __device__ __forceinline__ int lds_byte(int r, int c) { const int st = (r >> 4) * 2 + (c >> 5), rr = r & 15, cc = c & 31, ob = rr * 64 + cc * 2; return st * 1024 + (ob ^ (((ob >> 9) & 1) << 5)); }
__host__ __device__ __forceinline__ void stage_rc(int b, int& R, int& C) { const int st = b / 1024, sb = b % 1024, swz = sb ^ (((sb >> 9) & 1) << 5); R = (st >> 1) * 16 + swz / 64; C = (st & 1) * 32 + (swz % 64) / 2; }
__host__ __device__ __forceinline__ int perm32(int rho) { const int n = rho >> 4, i = rho & 15; return 8 * (i >> 2) + 4 * n + (i & 3); }

__device__ __forceinline__ int lane_id_opaque() { unsigned m_ = ~0u; asm volatile("" : "+s"(m_)); return (int)__builtin_amdgcn_mbcnt_hi(m_, __builtin_amdgcn_mbcnt_lo(m_, 0u)); }
struct Unit { int pm, pn, pb; };
struct Gemm { const bf16_t* A; const bf16_t* Bt; int M, N, K, Kp; };

struct StaticOrder {
    int nM, nN, nwg, G, c;
    __host__ __device__ void init(int M, int N, int G_, int c_) { nM = M / BM; nN = N / BM; nwg = nM * nN; G = G_; c = c_; }
    __host__ __device__ bool next(int i, Unit& u) const {
        const long L = (long)i * G + c; if (L >= nwg) return false;
        int wgid = (int)L; { const int q = nwg / NXCD, r = nwg % NXCD, xcd = wgid % NXCD, off = wgid / NXCD; wgid = (xcd < r ? xcd * (q + 1) : r * (q + 1) + (xcd - r) * q) + off; }
        const int nig = WGM * nN, gid = wgid / nig, fm = gid * WGM, gsz = (nM - fm) < WGM ? (nM - fm) : WGM;
        u.pm = fm + ((wgid % nig) % gsz); u.pn = (wgid % nig) / gsz; u.pb = u.pn; return true;
    }
    __device__ __forceinline__ void a_ready(const Unit&) const {}
    __device__ __forceinline__ void done(const Unit&) const {}
};

__device__ __forceinline__ unsigned cvt_pk_bf16(float lo, float hi) { unsigned r; asm volatile("v_cvt_pk_bf16_f32 %0, %1, %2" : "=v"(r) : "v"(lo), "v"(hi)); return r; }
typedef float f32x2 __attribute__((ext_vector_type(2)));
__device__ __forceinline__ f32x2 gelu_pk(f32x2 v) {
    const f32x2 av = __builtin_elementwise_abs(v), d = av * 0.2316418882f + 1.0f;
    f32x2 t; t.x = __builtin_amdgcn_rcpf(d.x); t.y = __builtin_amdgcn_rcpf(d.y);
    f32x2 q = t * 0.5307027145f + (-0.7265760135f); q = q * t + 0.7107068705f; q = q * t + (-0.142248368f); q = q * t + 0.127414796f; q = q * t;
    const f32x2 s = (v * v) * (-0.72134752044f);
    f32x2 e; e.x = __builtin_amdgcn_exp2f(s.x); e.y = __builtin_amdgcn_exp2f(s.y);
    const f32x2 m = v * (q * e), r = v - m;
    f32x2 o; o.x = v.x < 0.f ? m.x : r.x; o.y = v.y < 0.f ? m.y : r.y; return o;
}

template <int ACT  > struct EpiBf16 {
    static constexpr bool PERM = true, AFTER_DRAIN = false; static_assert(ACT == 0 || ACT == 1, "EpiBf16: ACT is 0 (none) or 1 (gelu_pk)");
    bf16_t* O; int ldc; const float* bias; int split_cols; size_t split_stride; float scale0;
    __device__ __forceinline__ void operator()(const f32x4 (&acc)[2][2][4][2], const Unit& u, int wr, int wc, int fr, int fq) const {
        const int row0 = u.pm * BM + wr * 64 + fr; int colt = u.pn * BM; bf16_t* base = O;
        float sc = 1.f; if (split_cols) { const int t = colt / split_cols; base += (size_t)t * split_stride; colt -= t * split_cols; if (t == 0) sc = scale0; }
        const int col0 = colt + wc * 32 + 8 * fq, bcol0 = u.pn * BM + wc * 32 + 8 * fq;
        f32x4 bv[2][2];
#pragma unroll
        for (int bj = 0; bj < 2; ++bj)
#pragma unroll
            for (int n = 0; n < 2; ++n) bv[bj][n] = bias ? *(const f32x4*)(bias + bcol0 + bj * HALF + 4 * n) : (f32x4){0.f, 0.f, 0.f, 0.f};
#pragma unroll
        for (int ai = 0; ai < 2; ++ai)
#pragma unroll
            for (int m = 0; m < 4; ++m) { bf16_t* rowp = base + (size_t)(row0 + ai * HALF + m * 16) * ldc + col0;
#pragma unroll
                for (int bj = 0; bj < 2; ++bj) { f32x4 v0 = acc[ai][bj][m][0] + bv[bj][0], v1 = acc[ai][bj][m][1] + bv[bj][1];
                    if (ACT == 1) { f32x2 a = gelu_pk((f32x2){v0[0], v0[1]}), b = gelu_pk((f32x2){v0[2], v0[3]}), c = gelu_pk((f32x2){v1[0], v1[1]}), d = gelu_pk((f32x2){v1[2], v1[3]});
                        v0 = (f32x4){a.x, a.y, b.x, b.y}; v1 = (f32x4){c.x, c.y, d.x, d.y}; }
                    v0 = v0 * sc; v1 = v1 * sc; u32x4 w; w.x = cvt_pk_bf16(v0[0], v0[1]); w.y = cvt_pk_bf16(v0[2], v0[3]); w.z = cvt_pk_bf16(v1[0], v1[1]); w.w = cvt_pk_bf16(v1[2], v1[3]);
                    *(u32x4*)(rowp + bj * HALF) = w; } }
    }
};

struct PanelStats {
    unsigned* xbuf;
    unsigned* cnt;
    unsigned* tmo;
    int ntn; float eps;
    unsigned code;
    __device__ __forceinline__ bool run(const f32x4 (&v)[2][2][4][2], const Unit& u, int wr, int wc, int fr, int fq, PG8_LAS unsigned char* lds, int wid, int lane) const {
        typedef float f32x2v __attribute__((ext_vector_type(2)));
        PG8_LAS f32x2v* P = (PG8_LAS f32x2v*)lds;
        PG8_LAS f32x2v* S = (PG8_LAS f32x2v*)(lds + 8192);
        PG8_LAS unsigned* flag = (PG8_LAS unsigned*)(lds + 8192 + 2048);
#pragma unroll
        for (int ai = 0; ai < 2; ++ai)
#pragma unroll
            for (int m = 0; m < 4; ++m) {
                float s = 0.f;
#pragma unroll
                for (int bj = 0; bj < 2; ++bj)
#pragma unroll
                    for (int n = 0; n < 2; ++n) { const f32x4 x = v[ai][bj][m][n]; s += (x[0] + x[1]) + (x[2] + x[3]); }
                s += __shfl_xor(s, 16); s += __shfl_xor(s, 32);
                const float mw = s * (1.0f / 64.0f); float q = 0.f;
#pragma unroll
                for (int bj = 0; bj < 2; ++bj)
#pragma unroll
                    for (int n = 0; n < 2; ++n) { const f32x4 d = v[ai][bj][m][n] - mw; q += (d[0] * d[0] + d[1] * d[1]) + (d[2] * d[2] + d[3] * d[3]); }
                q += __shfl_xor(q, 16); q += __shfl_xor(q, 32);
                if (fq == 0) P[(ai * HALF + wr * 64 + m * 16 + fr) * 4 + wc] = (f32x2v){mw, q};
            }
        asm volatile("s_waitcnt lgkmcnt(0)" ::: "memory"); __builtin_amdgcn_s_barrier(); asm volatile("" ::: "memory");
#if defined(BROKEN_EXCHANGE_NO_WAIT)
#warning BROKEN CONTROL BUILD: the row-statistics exchange does not wait; results are wrong by design
        if (blockIdx.x >= 64) { const long long t0_ = clock64(); while (clock64() - t0_ < 60000) __builtin_amdgcn_s_sleep(8); }
#endif
        const int row = wid * 32 + (lane & 31);
        if (lane < 32) {
            const f32x2v a = P[row * 4 + 0], b = P[row * 4 + 1], c = P[row * 4 + 2], d = P[row * 4 + 3];
            const float mt = (a.x + b.x + c.x + d.x) * 0.25f;
            const float da = a.x - mt, db = b.x - mt, dc = c.x - mt, dd = d.x - mt;
            const float m2 = (a.y + b.y) + (c.y + d.y) + 64.0f * ((da * da + db * db) + (dc * dc + dd * dd));
            unsigned long long* slot = (unsigned long long*)xbuf + ((size_t)(u.pm * BM + row) * 4 + u.pn);
            __hip_atomic_store(slot, ((unsigned long long)__float_as_uint(m2) << 32) | __float_as_uint(mt), __ATOMIC_RELAXED, __HIP_MEMORY_SCOPE_AGENT);
        }
        asm volatile("s_waitcnt vmcnt(0)" ::: "memory");
        if (lane == 0) __hip_atomic_fetch_add(cnt + 64 * u.pm, 1u, __ATOMIC_RELAXED, __HIP_MEMORY_SCOPE_AGENT);
        if (wid == 0) {
            bool dead = false; const unsigned long long t0 = __builtin_amdgcn_s_memrealtime(); const unsigned want = 8u * (unsigned)ntn;
            for (;;) {
#if defined(BROKEN_EXCHANGE_NO_WAIT)
                break;
#endif
                if ((unsigned)__builtin_amdgcn_readfirstlane(__hip_atomic_load(cnt + 64 * u.pm, __ATOMIC_RELAXED, __HIP_MEMORY_SCOPE_AGENT)) >= want) break;
                if (__builtin_amdgcn_s_memrealtime() - t0 > 2000000ull) {
                    if (lane == 0) { unsigned expect = 0u; __hip_atomic_compare_exchange_strong(tmo + 1, &expect, code | (unsigned)(u.pm & 0xff), __ATOMIC_RELAXED, __ATOMIC_RELAXED, __HIP_MEMORY_SCOPE_AGENT);
                                     __hip_atomic_store(tmo, 1u, __ATOMIC_RELAXED, __HIP_MEMORY_SCOPE_AGENT); }
                    dead = true; break; }
                __builtin_amdgcn_s_sleep(2);
            }
            __builtin_amdgcn_fence(__ATOMIC_ACQUIRE, "agent");
            if (lane == 0) flag[0] = dead ? 1u : 0u;
        }
        asm volatile("s_waitcnt vmcnt(0) lgkmcnt(0)" ::: "memory"); __builtin_amdgcn_s_barrier(); asm volatile("" ::: "memory");
        const bool bad = flag[0] != 0u;
        if (lane < 32) {
            const unsigned long long* slot = (const unsigned long long*)xbuf + (size_t)(u.pm * BM + row) * 4; float mt[4], m2[4]; float ms = 0.f;
#pragma unroll
            for (int t = 0; t < 4; ++t) { if (t < ntn) { const unsigned long long w = __hip_atomic_load(slot + t, __ATOMIC_RELAXED, __HIP_MEMORY_SCOPE_AGENT); mt[t] = __uint_as_float((unsigned)w); m2[t] = __uint_as_float((unsigned)(w >> 32)); } else { mt[t] = 0.f; m2[t] = 0.f; } ms += mt[t]; }
            const float mean = ms / (float)ntn; float q = 0.f;
#pragma unroll
            for (int t = 0; t < 4; ++t) if (t < ntn) { const float dm = mt[t] - mean; q += m2[t] + 256.0f * dm * dm; }
            S[row] = (f32x2v){mean, 1.0f / sqrtf(q / (256.0f * (float)ntn) + eps)};
        }
        asm volatile("s_waitcnt lgkmcnt(0)" ::: "memory"); __builtin_amdgcn_s_barrier(); asm volatile("" ::: "memory");
        return bad;
    }
};
struct EpiLnRes {
    static constexpr bool PERM = false, AFTER_DRAIN = true;
    const float* base; float* out; int ldc; const float* bias; PanelStats st; unsigned poison;
    __device__ __forceinline__ void fused(f32x4 (&acc)[2][2][4][2], const Unit& u, int wr, int wc, int fr, int fq, PG8_LAS unsigned char* lds, int wid, int lane) const {
        typedef float f32x2v __attribute__((ext_vector_type(2)));
        const PG8_LAS f32x2v* S = (const PG8_LAS f32x2v*)(lds + 8192);
        const int col0 = u.pn * BM + wc * 32 + 4 * fq;
#pragma unroll
        for (int bj = 0; bj < 2; ++bj)
#pragma unroll
            for (int n = 0; n < 2; ++n) { const f32x4 bv = bias ? *(const f32x4*)(bias + col0 + bj * HALF + n * 16) : (f32x4){0.f, 0.f, 0.f, 0.f};
#pragma unroll
                for (int ai = 0; ai < 2; ++ai)
#pragma unroll
                    for (int m = 0; m < 4; ++m) acc[ai][bj][m][n] += bv; }
        f32x4 pre[4][2][2];
#pragma unroll
        for (int m = 0; m < 4; ++m) { const size_t off = (size_t)(u.pm * BM + wr * 64 + m * 16 + fr) * ldc + col0;
#pragma unroll
            for (int bj = 0; bj < 2; ++bj)
#pragma unroll
                for (int n = 0; n < 2; ++n) pre[m][bj][n] = *(const f32x4*)(base + off + bj * HALF + n * 16); }
        const bool bad = st.run(acc, u, wr, wc, fr, fq, lds, wid, lane) || poison != 0u;
        const float qnan = __builtin_nanf("");
#pragma unroll
        for (int ai = 0; ai < 2; ++ai)
#pragma unroll
            for (int m = 0; m < 4; ++m) { const int r = ai * HALF + wr * 64 + m * 16 + fr; const f32x2v sr = S[r]; const size_t off = (size_t)(u.pm * BM + r) * ldc + col0;
#pragma unroll
                for (int bj = 0; bj < 2; ++bj)
#pragma unroll
                    for (int n = 0; n < 2; ++n) { const f32x4 bs = ai == 0 ? pre[m][bj][n] : *(const f32x4*)(base + off + bj * HALF + n * 16); f32x4 o = bs + (acc[ai][bj][m][n] - sr.x) * sr.y;
                        if (bad) o = (f32x4){qnan, qnan, qnan, qnan}; *(f32x4*)(out + off + bj * HALF + n * 16) = o; }
                if (m & 1) asm volatile("" ::: "memory"); }
    }
};
struct EpiLnResLn {
    static constexpr bool PERM = false, AFTER_DRAIN = true;
    const float* base; float* out; bf16_t* xn; int ldc; const float* bias; PanelStats st1, st2; unsigned poison;
    __device__ __forceinline__ void fused(f32x4 (&acc)[2][2][4][2], const Unit& u, int wr, int wc, int fr, int fq, PG8_LAS unsigned char* lds, int wid, int lane) const {
        typedef float f32x2v __attribute__((ext_vector_type(2))); typedef unsigned u32x2v __attribute__((ext_vector_type(2)));
        const PG8_LAS f32x2v* S = (const PG8_LAS f32x2v*)(lds + 8192);
        const int col0 = u.pn * BM + wc * 32 + 4 * fq;
#pragma unroll
        for (int bj = 0; bj < 2; ++bj)
#pragma unroll
            for (int n = 0; n < 2; ++n) { const f32x4 bv = bias ? *(const f32x4*)(bias + col0 + bj * HALF + n * 16) : (f32x4){0.f, 0.f, 0.f, 0.f};
#pragma unroll
                for (int ai = 0; ai < 2; ++ai)
#pragma unroll
                    for (int m = 0; m < 4; ++m) acc[ai][bj][m][n] += bv; }
        bool bad = st1.run(acc, u, wr, wc, fr, fq, lds, wid, lane) || poison != 0u;
        const float qnan = __builtin_nanf("");
#pragma unroll
        for (int ai = 0; ai < 2; ++ai)
#pragma unroll
            for (int m = 0; m < 4; ++m) { const int r = ai * HALF + wr * 64 + m * 16 + fr; const f32x2v sr = S[r]; const size_t off = (size_t)(u.pm * BM + r) * ldc + col0;
#pragma unroll
                for (int bj = 0; bj < 2; ++bj)
#pragma unroll
                    for (int n = 0; n < 2; ++n) { const f32x4 bs = *(const f32x4*)(base + off + bj * HALF + n * 16); acc[ai][bj][m][n] = bs + (acc[ai][bj][m][n] - sr.x) * sr.y; }
                asm volatile("" : "+v"(acc[ai][0][m][0]), "+v"(acc[ai][0][m][1]), "+v"(acc[ai][1][m][0]), "+v"(acc[ai][1][m][1]));
                if (m & 1) asm volatile("" ::: "memory"); }
        const bool bad1 = bad;
        bad = st2.run(acc, u, wr, wc, fr, fq, lds, wid, lane) || bad;
#pragma unroll
        for (int ai = 0; ai < 2; ++ai)
#pragma unroll
            for (int m = 0; m < 4; ++m) { const int r = ai * HALF + wr * 64 + m * 16 + fr; const f32x2v sr = S[r]; const size_t off = (size_t)(u.pm * BM + r) * ldc + col0;
#pragma unroll
                for (int bj = 0; bj < 2; ++bj)
#pragma unroll
                    for (int n = 0; n < 2; ++n) { const f32x4 x1 = acc[ai][bj][m][n]; *(f32x4*)(out + off + bj * HALF + n * 16) = bad1 ? (f32x4){qnan, qnan, qnan, qnan} : x1;
                        const f32x4 o = (x1 - sr.x) * sr.y; u32x2v w; w.x = cvt_pk_bf16(o[0], o[1]); w.y = cvt_pk_bf16(o[2], o[3]);
                        if (bad) { w.x = 0x7fc07fc0u; w.y = 0x7fc07fc0u; } *(u32x2v*)(xn + off + bj * HALF + n * 16) = w; }
                asm volatile("" ::: "memory"); }
    }
};

typedef int v4i_t __attribute__((ext_vector_type(4)));
typedef int v8i_t __attribute__((ext_vector_type(8)));
template <bool F8> struct Frag { bf16x8 v[2]; };
template <> struct Frag<true> { v8i_t v; };
template <class Epi, class Sched, bool ALIGN_EPI = false, bool SP2 = false, bool FP8 = false>
__device__ __forceinline__ void gemm_phase(PG8_LAS unsigned char* lds, const Gemm g, const Sched& S, const Epi& E, const int wid) {
    const int lane = lane_id_opaque(), tid = wid * 64 + lane, wr = wid >> 2, wc = wid & 3, fr = lane & 15, fq = lane >> 4;
    int K_ = g.K, Kp_ = g.Kp ? g.Kp : g.K; asm volatile("" : "+s"(K_), "+s"(Kp_));
    const int K = K_, nt = K / BK, Kp = Kp_;
    const char* gA_ = (const char*)g.A; const char* gB_ = (const char*)g.Bt; asm volatile("" : "+s"(gA_), "+s"(gB_));
    unsigned voffA[2], voffB[2];
#pragma unroll
    for (int i = 0; i < 2; ++i) { int R, C; stage_rc(tid * 16 + i * 8192, R, C); const int Rb = Epi::PERM ? ((R & ~31) + perm32(R & 31)) : R;
        voffA[i] = (unsigned)(R * Kp + C) * 2u; voffB[i] = (unsigned)(Rb * Kp + C) * 2u; }
    const size_t kstep = (size_t)(BK * 2);
    const size_t hstep = (size_t)HALF * Kp * 2;
    const size_t tstep = 2 * hstep;
    const unsigned ldsw = (unsigned)wid * 1024u;
    const int lf_ = FP8 ? lds_byte(fr, fq * 16) : lds_byte(fr, fq * 8);
    const int aoff = lf_ + wr * 8192, boff = lf_ + wc * 4096;
#define PG8_SA(b, h) (((b) * 2 + (h)) * HTB)
#define PG8_SB(b, h) ((4 + (b) * 2 + (h)) * HTB)
#define PG8_STAGE(bufoff, gbase, voff) do { _Pragma("unroll") for (int _i = 0; _i < 2; ++_i) { unsigned vo_ = (voff)[_i]; asm volatile("" : "+v"(vo_));     \
        __builtin_amdgcn_global_load_lds((const unsigned*)((const char*)(gbase) + vo_), (PG8_LAS unsigned*)(lds + (bufoff) + ldsw + _i * 8192), 16, 0, 0); } } while (0)
#define PG8_LDF(dst, off) do { if constexpr (FP8) { dst.v = *(const PG8_LAS v8i_t*)(lds + (off)); } \
        else { dst.v[0] = *(const PG8_LAS bf16x8*)(lds + (off)); dst.v[1] = *(const PG8_LAS bf16x8*)(lds + (off) + 1024); } } while (0)
#define PG8_LDA(dst, b, h) do { _Pragma("unroll") for (int m = 0; m < 4; ++m) PG8_LDF(dst[m], PG8_SA(b, h) + aoff + m * 2048); } while (0)
#define PG8_LDB(dst, b, h) do { _Pragma("unroll") for (int n = 0; n < 2; ++n) PG8_LDF(dst[n], PG8_SB(b, h) + boff + n * 2048); } while (0)
#define PG8_CAT8(lo, hi) __builtin_shufflevector(__builtin_bit_cast(v4i_t, lo), __builtin_bit_cast(v4i_t, hi), 0, 1, 2, 3, 4, 5, 6, 7)
#define PG8_MMA(ai, bj, At, Bt) do { __builtin_amdgcn_s_setprio(1); _Pragma("unroll") for (int m = 0; m < 4; ++m) _Pragma("unroll") for (int n = 0; n < 2; ++n) { \
        if constexpr (FP8) { asm volatile("v_mfma_f32_16x16x128_f8f6f4 %0, %1, %2, %0" : "+v"(acc[ai][bj][m][n]) : "v"(Bt[n].v), "v"(At[m].v)); }     \
        else { _Pragma("unroll") for (int k = 0; k < 2; ++k) acc[ai][bj][m][n] = __builtin_amdgcn_mfma_f32_16x16x32_bf16(Bt[n].v[k], At[m].v[k], acc[ai][bj][m][n], 0, 0, 0); } } \
        __builtin_amdgcn_s_setprio(0); } while (0)
#define PG8_WAIT_V(n) asm volatile("s_waitcnt vmcnt(" #n ")" ::: "memory")
#define PG8_WAIT_L(n) asm volatile("s_waitcnt lgkmcnt(" #n ")" ::: "memory")
#define PG8_BAR __builtin_amdgcn_s_barrier()
#define PG8_SCHED __builtin_amdgcn_sched_barrier(0)
    Unit cur, nxt; int ui = 0;
    if (!S.next(0, cur)) return;
    f32x4 acc[2][2][4][2];
#pragma unroll
    for (int a = 0; a < 2; ++a)
#pragma unroll
        for (int b = 0; b < 2; ++b)
#pragma unroll
            for (int m = 0; m < 4; ++m)
#pragma unroll
                for (int n = 0; n < 2; ++n) acc[a][b][m][n] = (f32x4){0.f, 0.f, 0.f, 0.f};
    Frag<FP8> At[4], B0[2], B1[2];
    const char* cA = gA_ + (size_t)cur.pm * tstep; const char* cB = gB_ + (size_t)cur.pb * tstep;
    S.a_ready(cur);
    if constexpr (SP2) {
        PG8_STAGE(PG8_SB(0, 0), cB, voffB); PG8_STAGE(PG8_SB(0, 1), cB + hstep, voffB); PG8_STAGE(PG8_SA(0, 0), cA, voffA); PG8_STAGE(PG8_SA(0, 1), cA + hstep, voffA);
        if (wr == 1) PG8_BAR;
        PG8_WAIT_V(2); PG8_BAR;
        PG8_STAGE(PG8_SB(1, 0), cB + kstep, voffB); PG8_STAGE(PG8_SA(1, 0), cA + kstep, voffA); PG8_STAGE(PG8_SB(1, 1), cB + hstep + kstep, voffB);
        PG8_WAIT_V(6); PG8_BAR;
    } else {
        PG8_STAGE(PG8_SB(0, 0), cB, voffB); PG8_STAGE(PG8_SA(0, 0), cA, voffA); PG8_STAGE(PG8_SB(0, 1), cB + hstep, voffB); PG8_STAGE(PG8_SA(0, 1), cA + hstep, voffA);
        if (wr == 1) PG8_BAR;
        PG8_WAIT_V(4); PG8_BAR;
        PG8_STAGE(PG8_SB(1, 0), cB + kstep, voffB); PG8_STAGE(PG8_SA(1, 0), cA + kstep, voffA); PG8_STAGE(PG8_SB(1, 1), cB + hstep + kstep, voffB);
        PG8_WAIT_V(6); PG8_BAR;
    }
    for (;;) {
        const bool has_next = S.next(ui + 1, nxt);
        const char* nA = has_next ? gA_ + (size_t)nxt.pm * tstep : cA; const char* nB = has_next ? gB_ + (size_t)nxt.pb * tstep : cB;
        for (int t = 0; t < nt; t += 2) {
            const bool last = (t == nt - 2);
            const char* a1 = cA + (size_t)(t + 1) * kstep;
            const char* a2 = last ? nA : cA + (size_t)(t + 2) * kstep; const char* b2 = last ? nB : cB + (size_t)(t + 2) * kstep;
            const char* a3 = a2 + kstep; const char* b3 = b2 + kstep;
            if (last && has_next) S.a_ready(nxt);
            if constexpr (SP2) {
            PG8_LDB(B0, 0, 0); PG8_LDB(B1, 0, 1); PG8_SCHED; PG8_LDA(At, 0, 0); PG8_STAGE(PG8_SA(1, 1), a1 + hstep, voffA);
            PG8_WAIT_V(8); PG8_WAIT_L(0); PG8_BAR; PG8_MMA(0, 0, At, B0); PG8_MMA(0, 1, At, B1); PG8_BAR; PG8_SCHED;
            PG8_LDA(At, 0, 1); PG8_STAGE(PG8_SB(0, 0), b2, voffB); PG8_STAGE(PG8_SB(0, 1), b2 + hstep, voffB); PG8_STAGE(PG8_SA(0, 0), a2, voffA);
            PG8_WAIT_V(8); PG8_WAIT_L(0); PG8_BAR; PG8_MMA(1, 0, At, B0); PG8_MMA(1, 1, At, B1); PG8_BAR; PG8_SCHED;
            PG8_LDB(B0, 1, 0); PG8_LDB(B1, 1, 1); PG8_SCHED; PG8_LDA(At, 1, 0); PG8_STAGE(PG8_SA(0, 1), a2 + hstep, voffA);
            PG8_WAIT_V(8); PG8_WAIT_L(0); PG8_BAR; PG8_MMA(0, 0, At, B0); PG8_MMA(0, 1, At, B1); PG8_BAR; PG8_SCHED;
            PG8_LDA(At, 1, 1); PG8_STAGE(PG8_SB(1, 0), b3, voffB); PG8_STAGE(PG8_SB(1, 1), b3 + hstep, voffB); PG8_STAGE(PG8_SA(1, 0), a3, voffA);
            PG8_WAIT_V(8); PG8_WAIT_L(0); PG8_BAR; PG8_MMA(1, 0, At, B0); PG8_MMA(1, 1, At, B1); PG8_BAR; PG8_SCHED;
            } else {
            PG8_LDB(B0, 0, 0); PG8_SCHED; PG8_LDA(At, 0, 0); PG8_STAGE(PG8_SA(1, 1), a1 + hstep, voffA);
            PG8_WAIT_L(8); PG8_BAR; PG8_WAIT_L(0); PG8_MMA(0, 0, At, B0); PG8_BAR; PG8_SCHED;
            PG8_LDB(B1, 0, 1); PG8_STAGE(PG8_SB(0, 0), b2, voffB);
            PG8_BAR; PG8_WAIT_L(0); PG8_MMA(0, 1, At, B1); PG8_BAR;
            PG8_LDA(At, 0, 1); PG8_STAGE(PG8_SA(0, 0), a2, voffA);
            PG8_BAR; PG8_WAIT_L(0); PG8_MMA(1, 0, At, B0); PG8_BAR; PG8_SCHED;
            PG8_STAGE(PG8_SB(0, 1), b2 + hstep, voffB);
            PG8_WAIT_V(6); PG8_BAR; PG8_MMA(1, 1, At, B1); PG8_BAR;
            PG8_LDB(B0, 1, 0); PG8_SCHED; PG8_LDA(At, 1, 0); PG8_STAGE(PG8_SA(0, 1), a2 + hstep, voffA);
            PG8_WAIT_L(8); PG8_BAR; PG8_WAIT_L(0); PG8_MMA(0, 0, At, B0); PG8_BAR; PG8_SCHED;
            PG8_LDB(B1, 1, 1); PG8_STAGE(PG8_SB(1, 0), b3, voffB);
            PG8_BAR; PG8_WAIT_L(0); PG8_MMA(0, 1, At, B1); PG8_BAR;
            PG8_LDA(At, 1, 1); PG8_STAGE(PG8_SA(1, 0), a3, voffA);
            PG8_BAR; PG8_WAIT_L(0); PG8_MMA(1, 0, At, B0); PG8_BAR; PG8_SCHED;
            PG8_STAGE(PG8_SB(1, 1), b3 + hstep, voffB);
            PG8_WAIT_V(6); PG8_BAR; PG8_MMA(1, 1, At, B1); PG8_BAR;
            }
        }
        if constexpr (ALIGN_EPI) { if (wr == 0) PG8_BAR; }
        if constexpr (FP8) { asm volatile("s_nop 15\n\ts_nop 15" ::: "memory"); }
        if constexpr (!Epi::AFTER_DRAIN) { const int ln_ = lane_id_opaque(); const int fr_ = ln_ & 15, fq_ = ln_ >> 4; int wr_ = wr, wc_ = wc; asm volatile("" : "+s"(wr_), "+s"(wc_)); E(acc, cur, wr_, wc_, fr_, fq_); S.done(cur); }
        if (!has_next) break;
#pragma unroll
        for (int a = 0; a < 2; ++a)
#pragma unroll
            for (int b = 0; b < 2; ++b)
#pragma unroll
                for (int m = 0; m < 4; ++m)
#pragma unroll
                    for (int n = 0; n < 2; ++n) acc[a][b][m][n] = (f32x4){0.f, 0.f, 0.f, 0.f};
        cur = nxt; cA = nA; cB = nB; ++ui;
        if constexpr (ALIGN_EPI) { if (wr == 1) PG8_BAR; }
    }
    PG8_WAIT_V(0);
    if constexpr (!ALIGN_EPI) { if (wr == 0) PG8_BAR; }
    PG8_BAR;
    if constexpr (Epi::AFTER_DRAIN) { E.fused(acc, cur, wr, wc, fr, fq, lds, wid, lane); S.done(cur); }
#undef PG8_SA
#undef PG8_SB
#undef PG8_STAGE
#undef PG8_LDA
#undef PG8_LDF
#undef PG8_LDB
#undef PG8_MMA
#undef PG8_CAT8
#undef PG8_WAIT_V
#undef PG8_WAIT_L
#undef PG8_BAR
#undef PG8_SCHED
}
}

#ifndef PG8_SP2
#define PG8_SP2 true
#endif
#ifndef PG8_ALIGN
#define PG8_ALIGN true
#endif
#include <hip/hip_bf16.h>
#include <cmath>
namespace attn_body {
using bf16=__hip_bfloat16;
using bf16x8=__attribute__((ext_vector_type(8)))short;
using s16x4=__attribute__((ext_vector_type(4)))short;
using f32x16=__attribute__((ext_vector_type(16)))float;
using u32x4=__attribute__((ext_vector_type(4)))unsigned;
constexpr int BATCH=8,NHEAD=8,SEQ=4096,D=64,DM=NHEAD*D;
constexpr int NW=8,QBLK=32,QB=QBLK*NW,KVBLK=64,NQB=SEQ/QB;
constexpr int ATTN_PITCH=DM, ATTN_UNIT_ROWS=QB;
__device__ __forceinline__ int crow(int r,int hi){return (r&3)+8*(r>>2)+4*hi;}
#define SBAR() __builtin_amdgcn_sched_barrier(0)
__device__ __forceinline__ void cmask(f32x16&p0,f32x16&p1,int jb,int qrel,int hi){
  const float NEG=-INFINITY; int kb=64*jb+4*hi;
  #pragma unroll
  for(int r=0;r<16;++r){int kv=kb+(r&3)+8*(r>>2); if(kv>qrel)p0[r]=NEG; if(kv+32>qrel)p1[r]=NEG;}
}

constexpr int NSLOT=3, SLOTB=8192;
constexpr int LDS_K=0, LDS_V=NSLOT*SLOTB, LDS_WS=2*NSLOT*SLOTB, LDS_OST=LDS_WS+NW*64*4, LDS_BYTES=LDS_OST+NW*4096, LDS_CB=86016, LDS_CBW=LDS_CB+16384;
constexpr float C2=0.125f*1.4426950408889634f;
__device__ __forceinline__ void glds16(const void*gsrc,unsigned lds_dst){unsigned keep;
  asm volatile("s_mov_b32 %0, m0\n\ts_mov_b32 m0, %2\n\ts_nop 0\n\tglobal_load_lds_dwordx4 %1, off\n\ts_mov_b32 m0, %0":"=&s"(keep):"v"(gsrc),"s"(lds_dst):"memory");}
__device__ __forceinline__ float max3f(float a,float b,float c){float r;asm("v_max3_f32 %0, %1, %2, %3":"=v"(r):"v"(a),"v"(b),"v"(c));return r;}
__device__ __forceinline__ float max2f(float a,float b){float r;asm("v_max_f32_e32 %0, %1, %2":"=v"(r):"v"(a),"v"(b));return r;}
__device__ __forceinline__ float fadd_s(float a,float b){float r;asm("v_add_f32_e32 %0, %1, %2":"=v"(r):"v"(a),"v"(b));return r;}
__device__ __forceinline__ float fsub_s(float a,float b){float r;asm("v_sub_f32_e32 %0, %1, %2":"=v"(r):"v"(a),"v"(b));return r;}
typedef float f32x2_t __attribute__((ext_vector_type(2))); typedef __bf16 bf16x2_t __attribute__((ext_vector_type(2)));
__device__ __forceinline__ unsigned cvtpk_s(float lo,float hi){f32x2_t v={lo,hi};bf16x2_t b=__builtin_convertvector(v,bf16x2_t);return __builtin_bit_cast(unsigned,b);}
#define WAIT_BAR(N) asm volatile("s_waitcnt vmcnt(" #N ") lgkmcnt(0)\n\ts_barrier":::"memory")

__device__ __forceinline__ void qkt(f32x16&p0,f32x16&p1,const char*Kslot,const bf16x8*qr,int r32,int hi){
  const char*kb=Kslot+hi*1024+r32*16;
  #pragma unroll
  for(int d0=0;d0<4;++d0){
    const bf16x8 b0=*reinterpret_cast<const bf16x8*>(kb+d0*2048);
    const bf16x8 b1=*reinterpret_cast<const bf16x8*>(kb+d0*2048+512);
    p0=__builtin_amdgcn_mfma_f32_32x32x16_bf16(b0,qr[d0],p0,0,0,0);p1=__builtin_amdgcn_mfma_f32_32x32x16_bf16(b1,qr[d0],p1,0,0,0);}
}
typedef __attribute__((address_space(3))) const char* lds_cptr;
typedef float f32x4_t __attribute__((ext_vector_type(4)));
typedef short v4i16_t __attribute__((ext_vector_type(4)));
__device__ __forceinline__ void kload8(bf16x8*kf,lds_cptr kp){
  kf[0]=*(const __attribute__((address_space(3))) bf16x8*)(kp);      kf[1]=*(const __attribute__((address_space(3))) bf16x8*)(kp+512);
  kf[2]=*(const __attribute__((address_space(3))) bf16x8*)(kp+2048); kf[3]=*(const __attribute__((address_space(3))) bf16x8*)(kp+2560);
  kf[4]=*(const __attribute__((address_space(3))) bf16x8*)(kp+4096); kf[5]=*(const __attribute__((address_space(3))) bf16x8*)(kp+4608);
  kf[6]=*(const __attribute__((address_space(3))) bf16x8*)(kp+6144); kf[7]=*(const __attribute__((address_space(3))) bf16x8*)(kp+6656);
}
__device__ __forceinline__ void kload2(bf16x8*kf,lds_cptr kp,int j){ kf[2*j]=*(const __attribute__((address_space(3))) bf16x8*)(kp+j*2048); kf[2*j+1]=*(const __attribute__((address_space(3))) bf16x8*)(kp+j*2048+512); }
__device__ __forceinline__ s16x4 vtr(lds_cptr p){ return __builtin_bit_cast(s16x4,__builtin_amdgcn_ds_read_tr16_b64_v4i16((__attribute__((address_space(3))) v4i16_t*)p)); }
__device__ __forceinline__ float rowmax(const f32x16&p0,const f32x16&p1){
  float a=max3f(p0[0],p0[1],p1[0]),b=max3f(p0[2],p0[3],p1[1]);a=max3f(a,p1[2],p1[3]);
  #pragma unroll
  for(int r=4;r<16;r+=4){a=max3f(a,p0[r],p0[r+1]);b=max3f(b,p0[r+2],p0[r+3]);a=max3f(a,p1[r],p1[r+1]);b=max3f(b,p1[r+2],p1[r+3]);}
  const float m=max2f(a,b);
  auto rr=__builtin_amdgcn_permlane32_swap(__float_as_uint(m),__float_as_uint(m),false,false);
  return max2f(__uint_as_float(rr[0]),__uint_as_float(rr[1]));
}
__device__ __forceinline__ void pv(f32x16*o,int vb,bf16x8 pa0,bf16x8 pa1,bf16x8 pa2,bf16x8 pa3){
  #pragma unroll
  for(int d0=0;d0<2;++d0){s16x4 lo[4],hi[4];
    #pragma unroll
    for(int ks=0;ks<4;++ks){
      asm volatile("ds_read_b64_tr_b16 %0,%1 offset:%c2":"=&v"(lo[ks]):"v"(vb),"i"(d0*4096+ks*1024):"memory");
      asm volatile("ds_read_b64_tr_b16 %0,%1 offset:%c2":"=&v"(hi[ks]):"v"(vb),"i"(d0*4096+ks*1024+512):"memory");}
    asm volatile("s_waitcnt lgkmcnt(0)":::"memory");SBAR();
    #define PK(k) (bf16x8){lo[k][0],lo[k][1],lo[k][2],lo[k][3],hi[k][0],hi[k][1],hi[k][2],hi[k][3]}
    o[d0]=__builtin_amdgcn_mfma_f32_32x32x16_bf16(pa0,PK(0),o[d0],0,0,0);
    o[d0]=__builtin_amdgcn_mfma_f32_32x32x16_bf16(pa1,PK(1),o[d0],0,0,0);
    o[d0]=__builtin_amdgcn_mfma_f32_32x32x16_bf16(pa2,PK(2),o[d0],0,0,0);
    o[d0]=__builtin_amdgcn_mfma_f32_32x32x16_bf16(pa3,PK(3),o[d0],0,0,0);
    #undef PK
  }
}

#ifndef ATTN_STORE16
#define ATTN_STORE16(p,v) (*(u32x4*)(p)=(v))
#endif
template<int THRL> __device__ __forceinline__ void attn_unit(int b,int h,int qb,const bf16*Q,const bf16*__restrict__ K,const bf16*__restrict__ V,bf16*O,const float*__restrict__ FL,char*shm,const int wid){
  const int lane=pg8::lane_id_opaque(),tid=wid*64+lane,r32=lane&31,hi=lane>>5;
  const long rowbase=(long)b*SEQ; const int q0=qb*QB;
  int t0=0;
  {
    typedef __attribute__((address_space(3))) float lfl;
    lfl*cl=(lfl*)((lds_cptr)shm+LDS_CB); lfl*wt=(lfl*)((lds_cptr)shm+LDS_CBW);
    const int nk=q0+QB; float v[8];
    #pragma unroll
    for(int q=0;q<8;++q){const int s=8*tid+q; v[q]=(s<nk)?FL[(rowbase+s)*8+h]:0.f;}
    #pragma unroll
    for(int q=1;q<8;++q)v[q]+=v[q-1];
    const float tot=v[7]; float x=tot;
    #pragma unroll
    for(int off=1;off<64;off<<=1){const float t=__int_as_float(__builtin_amdgcn_ds_bpermute((lane-off)<<2,__float_as_int(x))); if(lane>=off)x+=t;}
    if(lane==63)wt[wid]=x;
    __syncthreads();
    float woff=0.f;
    #pragma unroll
    for(int w=0;w<NW;++w){const float tw=wt[w]; if(w<wid)woff+=tw;}
    const float ex=x-tot+woff;
    #pragma unroll
    for(int q=0;q<8;++q)cl[8*tid+q]=v[q]+ex;
    __syncthreads();
    { const int NTf=nk/KVBLK; const float cq0=cl[q0]; const float ck=(lane<NTf)?cl[64*lane+63]:0.f; const bool sk=(lane<NTf)&&(cq0-ck<-48.f);
      int ts=(int)__popcll(__ballot(sk))&~1; if(ts>NTf-4)ts=NTf-4; t0=__builtin_amdgcn_readfirstlane(ts); }
  }
  typedef __attribute__((address_space(3))) const f32x4_t* lf4p; const lf4p clq=(lf4p)((lds_cptr)shm+LDS_CB)+hi+16*t0;
  #define BIASLD(C0,C1,t) do{ const lf4p cp_=clq+16*(t); _Pragma("unroll") for(int i_=0;i_<4;++i_){ const f32x4_t a_=cp_[2*i_], b_=cp_[2*i_+8]; \
      C0[4*i_]=a_[0];C0[4*i_+1]=a_[1];C0[4*i_+2]=a_[2];C0[4*i_+3]=a_[3]; C1[4*i_]=b_[0];C1[4*i_+1]=b_[1];C1[4*i_+2]=b_[2];C1[4*i_+3]=b_[3]; } }while(0)
  #define BIASFIX(C0,C1) do{ _Pragma("unroll") for(int r_=0;r_<16;++r_){C0[r_]=nmh-C0[r_];C1[r_]=nmh-C1[r_];} }while(0)
  const bf16*Qw=Q+(rowbase+q0+wid*QBLK)*DM+h*D;
  const bf16*Kh=K+(rowbase+(long)t0*KVBLK)*DM+h*D,*Vh=V+(rowbase+(long)t0*KVBLK)*DM+h*D;
  const unsigned lds0=(unsigned)(uintptr_t)shm;
  float*wsf=(float*)(shm+LDS_WS)+wid*64;
  const bf16*ksrc=Kh+(long)lane*DM+wid*8;
  const bf16*vsrc=Vh+(long)(16*(wid&3)+(lane>>2))*DM+(wid>>2)*32+(lane&3)*8;
  const unsigned kdst=lds0+LDS_K+wid*1024, vdst=lds0+LDS_V+wid*1024;
  #define DMA_K(t,slot) glds16(ksrc+(long)(t)*KVBLK*DM,(unsigned)__builtin_amdgcn_readfirstlane(kdst+(slot)))
  #define DMA_V(t,slot) glds16(vsrc+(long)(t)*KVBLK*DM,(unsigned)__builtin_amdgcn_readfirstlane(vdst+(slot)))
  const int vb0=(int)(lds0+LDS_V)+((lane>>4)&1)*32+(lane&3)*8+(4*hi+((lane&15)>>2))*64;
  const char*Kbase=shm+LDS_K; bf16x8 kf[8];
  const lds_cptr shm3=(lds_cptr)shm; const lds_cptr kp0=shm3+LDS_K+hi*1024+r32*16; const lds_cptr vp0=shm3+LDS_V+((lane>>4)&1)*32+(lane&3)*8+(4*hi+((lane&15)>>2))*64;
  const int NT=(q0+QB)/KVBLK-t0;
  DMA_K(0,0);DMA_V(0,0);DMA_K(1,SLOTB);
  bf16x8 qr[4];
  #pragma unroll
  for(int d0=0;d0<4;++d0)qr[d0]=*reinterpret_cast<const bf16x8*>(&Qw[(long)r32*DM+d0*16+hi*8]);
  float mhat=0.f,l_reg=0.f,nmh=0.f;f32x16 o[2];o[0]=f32x16{};o[1]=f32x16{};
  const int qrel=wid*QBLK+r32;
  #define CMASK(P0,P1,t) do{int jb_=(t)-(NT-4); if(jb_>=0)cmask(P0,P1,jb_,qrel,hi);}while(0)
  bool resc=false;
  #define START(P0,P1) do{ const float rm=rowmax(P0,P1); resc=false; \
    { const float dl=rm; mhat=fadd_s(mhat,dl); \
      _Pragma("unroll") for(int r=0;r<16;++r){P0[r]=fsub_s(P0[r],dl);P1[r]=fsub_s(P1[r],dl);} \
      nmh=-mhat; } \
    _Pragma("unroll") for(int r=0;r<16;++r)P0[r]=__builtin_amdgcn_exp2f(P0[r]); }while(0)
  #define RESC() do{ if(resc){ asm volatile("s_waitcnt lgkmcnt(0)":::"memory"); \
      _Pragma("unroll") for(int d_=0;d_<2;++d_) _Pragma("unroll") for(int r=0;r<16;++r)o[d_][r]*=wsf[crow(r,hi)]; } }while(0)
  f32x16 pA0,pA1,pB0,pB1;
  BIASLD(pA0,pA1,0); BIASFIX(pA0,pA1);
  int sl_prev=0,sl_cur=0,sl_next=SLOTB;
  #define ROT() do{sl_prev=sl_cur;sl_cur=sl_next;sl_next=(sl_next==(NSLOT-1)*SLOTB)?0:sl_next+SLOTB;}while(0)
  DMA_K(2,2*SLOTB);
  WAIT_BAR(3);
  qkt(pA0,pA1,Kbase,qr,r32,hi);asm volatile("s_nop 15\n\ts_nop 7":"+v"(pA0),"+v"(pA1));CMASK(pA0,pA1,0);
  START(pA0,pA1);
  _Pragma("unroll") for(int r=0;r<16;++r)pA1[r]=__builtin_amdgcn_exp2f(pA1[r]);
  WAIT_BAR(0);
  DMA_K(3,0);DMA_V(1,SLOTB);
  ROT();
  kload8(kf,kp0+sl_cur);
  BIASLD(pB0,pB1,1);
  WAIT_BAR(2);
  s16x4 vlo[8],vhi[8]; u32x4 pw0,pw1,pw2,pw3;
  #define PKW(P,B) cvtpk_s(P[B],P[B+1])
  #define PAF(k) __builtin_bit_cast(bf16x8,pw##k)
  #define VFR(i) (bf16x8){vlo[i][0],vlo[i][1],vlo[i][2],vlo[i][3],vhi[i][0],vhi[i][1],vhi[i][2],vhi[i][3]}
  #define PIN(x) asm volatile("":"+v"(x))
  #define MX3(a,b,c) __builtin_fmaxf(__builtin_fmaxf((a),(b)),(c))
  #define GAPA(MF,A0,A1,A2,A3,W0,W1,PW) do{ MF; sacc+=A0; sacc+=A1; sacc+=A2; sacc+=A3; PIN(sacc); W0; W1; PIN(PW); SBAR(); }while(0)
  #define EX(v) __builtin_amdgcn_exp2f(v)
  #define GAPB(MF,X,B) do{ MF; X[B]=EX(X[B]); X[B+1]=EX(X[B+1]); X[B+2]=EX(X[B+2]); X[B+3]=EX(X[B+3]); PIN(X); SBAR(); }while(0)
  #define VRD(i) do{ vlo[i]=vtr(vp_+(((i)>>2)*4096+((i)&3)*1024)); vhi[i]=vtr(vp_+(((i)>>2)*4096+((i)&3)*1024+512)); }while(0)
  #define KRD(G,j) do{ if(G){ kload2(kf,kp0+sl_next,j); SBAR(); } }while(0)
  #define STEP(C0,C1,P0,P1,t,GK,GV,GL) do{ SBAR(); BIASFIX(C0,C1); SBAR(); \
    const lds_cptr vp_=vp0+sl_prev; \
    VRD(0); SBAR(); float sacc=(P0[0]+P0[1]); \
    GAPA(C0=__builtin_amdgcn_mfma_f32_32x32x16_bf16(kf[0],qr[0],C0,0,0,0), P0[2],P0[3],P0[4],P0[5],     pw0[0]=PKW(P0,0), pw0[1]=PKW(P0,2), pw0); \
    VRD(4); SBAR(); GAPA(C1=__builtin_amdgcn_mfma_f32_32x32x16_bf16(kf[1],qr[0],C1,0,0,0), P0[6],P0[7],P0[8],P0[9],     pw0[2]=PKW(P0,4), pw0[3]=PKW(P0,6), pw0); \
    VRD(1); SBAR(); GAPA(C0=__builtin_amdgcn_mfma_f32_32x32x16_bf16(kf[2],qr[1],C0,0,0,0),   P0[10],P0[11],P0[12],P0[13], pw1[0]=PKW(P0,8), pw1[1]=PKW(P0,10), pw1); \
    VRD(5); SBAR(); GAPA(C1=__builtin_amdgcn_mfma_f32_32x32x16_bf16(kf[3],qr[1],C1,0,0,0),   P0[14],P0[15],P1[0],P1[1],   pw1[2]=PKW(P0,12),pw1[3]=PKW(P0,14), pw1); \
    VRD(2); SBAR(); GAPA(C0=__builtin_amdgcn_mfma_f32_32x32x16_bf16(kf[4],qr[2],C0,0,0,0),   P1[2],P1[3],P1[4],P1[5],     pw2[0]=PKW(P1,0), pw2[1]=PKW(P1,2), pw2); \
    VRD(6); SBAR(); GAPA(C1=__builtin_amdgcn_mfma_f32_32x32x16_bf16(kf[5],qr[2],C1,0,0,0),   P1[6],P1[7],P1[8],P1[9],     pw2[2]=PKW(P1,4), pw2[3]=PKW(P1,6), pw2); \
    VRD(3); SBAR(); GAPA(C0=__builtin_amdgcn_mfma_f32_32x32x16_bf16(kf[6],qr[3],C0,0,0,0),   P1[10],P1[11],P1[12],P1[13], pw3[0]=PKW(P1,8), pw3[1]=PKW(P1,10), pw3); \
    VRD(7); SBAR(); GAPA(C1=__builtin_amdgcn_mfma_f32_32x32x16_bf16(kf[7],qr[3],C1,0,0,0),   P1[14],P1[15],0.f,0.f,       pw3[2]=PKW(P1,12),pw3[3]=PKW(P1,14), pw3); \
    l_reg+=sacc; \
    if(GK){DMA_K((t)+3,sl_cur);} if(GV){DMA_V((t)+1,sl_next);} \
    CMASK(C0,C1,t); \
    { float a=MX3(C0[0],C0[1],C1[0]),b=MX3(C0[2],C0[3],C1[1]); a=MX3(a,C1[2],C1[3]); \
      _Pragma("unroll") for(int r=4;r<16;r+=4){a=MX3(a,C0[r],C0[r+1]);b=MX3(b,C0[r+2],C0[r+3]);a=MX3(a,C1[r],C1[r+1]);b=MX3(b,C1[r+2],C1[r+3]);} \
      float rm=__builtin_fmaxf(a,b); { auto rr=__builtin_amdgcn_permlane32_swap(__float_as_uint(rm),__float_as_uint(rm),false,false); rm=__builtin_fmaxf(__uint_as_float(rr[0]),__uint_as_float(rr[1])); } \
      resc=false; \
      if(__builtin_expect(__any(rm>(float)THRL),0)){ const float dl=__builtin_fmaxf(rm,0.f); mhat+=dl; \
        _Pragma("unroll") for(int r=0;r<16;++r){C0[r]-=dl;C1[r]-=dl;} \
        nmh=-mhat; \
        const float f=__builtin_amdgcn_exp2f(-dl); l_reg*=f; if(hi==0)wsf[r32]=f; resc=true; } } \
    SBAR(); \
    GAPB(o[0]=__builtin_amdgcn_mfma_f32_32x32x16_bf16(PAF(0),VFR(0),o[0],0,0,0), C0,0); \
    GAPB(o[1]=__builtin_amdgcn_mfma_f32_32x32x16_bf16(PAF(0),VFR(4),o[1],0,0,0), C0,4); \
    KRD(GL,0); GAPB(o[0]=__builtin_amdgcn_mfma_f32_32x32x16_bf16(PAF(1),VFR(1),o[0],0,0,0), C0,8); \
    KRD(GL,1); GAPB(o[1]=__builtin_amdgcn_mfma_f32_32x32x16_bf16(PAF(1),VFR(5),o[1],0,0,0), C0,12); \
    KRD(GL,2); GAPB(o[0]=__builtin_amdgcn_mfma_f32_32x32x16_bf16(PAF(2),VFR(2),o[0],0,0,0), C1,0); \
    KRD(GL,3); GAPB(o[1]=__builtin_amdgcn_mfma_f32_32x32x16_bf16(PAF(2),VFR(6),o[1],0,0,0), C1,4); \
    GAPB(o[0]=__builtin_amdgcn_mfma_f32_32x32x16_bf16(PAF(3),VFR(3),o[0],0,0,0), C1,8); \
    GAPB(o[1]=__builtin_amdgcn_mfma_f32_32x32x16_bf16(PAF(3),VFR(7),o[1],0,0,0), C1,12); \
    if(GL){BIASLD(P0,P1,(t)+1);} \
    }while(0)
  int t=1;
  #undef CMASK
  #define CMASK(P0,P1,t) do{}while(0)
  for(;t+5<NT;t+=2){
    STEP(pB0,pB1,pA0,pA1,t,true,true,true);     WAIT_BAR(2); RESC(); ROT();
    STEP(pA0,pA1,pB0,pB1,t+1,true,true,true);   WAIT_BAR(2); RESC(); ROT();
  }
  #undef CMASK
  #define CMASK(P0,P1,t) do{int jb_=(t)-(NT-4); if(jb_>=0)cmask(P0,P1,jb_,qrel,hi);}while(0)
  #define ENDW(tt) do{ if((tt)+3<NT){WAIT_BAR(2);} else if((tt)+2<NT){WAIT_BAR(1);} else {WAIT_BAR(0);} }while(0)
  for(;t+1<NT;t+=2){
    STEP(pB0,pB1,pA0,pA1,t,(t+3<NT),(t+1<NT),(t+1<NT));       ENDW(t);   RESC(); ROT();
    STEP(pA0,pA1,pB0,pB1,t+1,(t+4<NT),(t+2<NT),(t+2<NT));     ENDW(t+1); RESC(); ROT();
  }
  STEP(pB0,pB1,pA0,pA1,NT-1,false,false,false); RESC();
  { float sacc=pB0[0]+pB0[1]; _Pragma("unroll") for(int r=2;r<16;++r)sacc+=pB0[r]; _Pragma("unroll") for(int r=0;r<16;++r)sacc+=pB1[r]; l_reg+=sacc;
    pw0=(u32x4){PKW(pB0,0),PKW(pB0,2),PKW(pB0,4),PKW(pB0,6)};pw1=(u32x4){PKW(pB0,8),PKW(pB0,10),PKW(pB0,12),PKW(pB0,14)};pw2=(u32x4){PKW(pB1,0),PKW(pB1,2),PKW(pB1,4),PKW(pB1,6)};pw3=(u32x4){PKW(pB1,8),PKW(pB1,10),PKW(pB1,12),PKW(pB1,14)};
    SBAR(); pv(o,vb0+sl_cur,PAF(0),PAF(1),PAF(2),PAF(3)); }
  #undef PKW
  #undef PAF
  #undef VFR
  #undef PIN
  #undef MX3
  #undef GAPA
  #undef GAPB
  #undef EX
  #undef VRD
  #undef KRD
  #undef STEP
  #undef ENDW
  {auto rr=__builtin_amdgcn_permlane32_swap(__float_as_uint(l_reg),__float_as_uint(l_reg),false,false);l_reg=__uint_as_float(rr[0])+__uint_as_float(rr[1]);}
  if(hi==0)wsf[32+r32]=l_reg;asm volatile("s_waitcnt lgkmcnt(0)":::"memory");
  float rli[16];
  #pragma unroll
  for(int r=0;r<16;++r)rli[r]=__builtin_amdgcn_rcpf(wsf[32+crow(r,hi)]);
  bf16*Ow=O+(rowbase+q0+wid*QBLK)*DM+h*D;
  { bf16*stg=(bf16*)(shm+LDS_OST)+wid*2048;
    #pragma unroll
    for(int r=0;r<16;++r){const int orow=crow(r,hi);
      #pragma unroll
      for(int d0=0;d0<2;++d0)stg[orow*64+d0*32+r32]=__float2bfloat16(o[d0][r]*rli[r]);}
    asm volatile("s_waitcnt lgkmcnt(0)":::"memory");
    #pragma unroll
    for(int i=0;i<4;++i){const int row=i*8+(lane>>3),ch=lane&7; const u32x4 v=*(const u32x4*)(stg+row*64+ch*8); ATTN_STORE16(Ow+(long)row*DM+ch*8,v);} }
  asm volatile("s_waitcnt lgkmcnt(0)\n\ts_barrier":::"memory");
  #undef BIASLD
  #undef BIASFIX
  #undef DMA_K
  #undef DMA_V
  #undef CMASK
  #undef START
  #undef RESC
  #undef ROT
}
constexpr int ATTN_LDS_BYTES=LDS_BYTES;
struct AttnTensors { const bf16* Q; const bf16* K; const bf16* V; bf16* O; const float* FL; };
struct AttnUnit { int bh; int qb; };
struct StaticOrder {
  int vcu, G;
  __device__ __forceinline__ explicit StaticOrder(int grid,int block):vcu((grid%8==0)?(block%8)*(grid/8)+block/8:block),G(grid){}
  __device__ __forceinline__ bool next(int i,AttnUnit&u)const{ const int idx=i*G+vcu; if(idx>=1024)return false; const int v=idx&255, r=idx>>8, s=2*(v&3); u.bh=(v>>5)*8+((((v>>2)&7)+2*r)&7); u.qb=(r==0)?s:(r==1)?15-s:(r==2)?s+1:14-s; return true; }
  __device__ __forceinline__ void a_ready(const AttnUnit&)const{}
  __device__ __forceinline__ void done(const AttnUnit&)const{}
};
template<class Sched,int THRL=8> __device__ __forceinline__ void attn_phase(char*lds,const AttnTensors&T,const Sched&S,const int wid){
  AttnUnit u;
  for(int i=0;S.next(i,u);++i){ S.a_ready(u); attn_unit<THRL>(u.bh/NHEAD,u.bh%NHEAD,u.qb,T.Q,T.K,T.V,T.O,T.FL,lds,wid); S.done(u); }
}
#undef SBAR
#undef WAIT_BAR
}

#include <hip/hip_cooperative_groups.h>
namespace cg = cooperative_groups;

#define GAS __attribute__((address_space(1)))
#define LAS __attribute__((address_space(3)))
typedef unsigned short bf16;
typedef unsigned v4u __attribute__((ext_vector_type(4)));
typedef unsigned v2u __attribute__((ext_vector_type(2)));
typedef float f32x4 __attribute__((ext_vector_type(4)));
typedef short bf16x8 __attribute__((ext_vector_type(8)));
#define RLX_AGENT __ATOMIC_RELAXED, __HIP_MEMORY_SCOPE_AGENT
#define LDS_WAIT() asm volatile("s_waitcnt lgkmcnt(0)" ::: "memory")

constexpr int NWAVES = 8, NTHR = 512;
constexpr int BATCH = 8, SEQ = 4096, D = 1024, M = BATCH * SEQ, DEPTH = 4;
constexpr int INC = 6664, NPROJ = 6656, DFF = 2816, DFE = 3584, NEXP = 8;
constexpr float DN_ALPHA = 1.6817928305074292f, LN_EPS = 1e-5f, RMS_EPS = 1e-6f, LOG2E = 1.4426950408889634f;

constexpr size_t MiB = 1u << 20;
constexpr size_t WS_CTL = 0, WS_COS = 1 * MiB, WS_SIN = 5 * MiB, WS_FLOG = 9 * MiB, WS_RE = 10 * MiB, WS_RR = 10 * MiB + 256 * 1024, WS_RW = 10 * MiB + 512 * 1024, WS_RROW = 10 * MiB + 768 * 1024;
constexpr size_t WS_WIN = 12 * MiB, WS_WBF = 25 * MiB, WS_WBR = 26 * MiB, WS_WOUT = 28 * MiB;
constexpr size_t WS_WFF = 32 * MiB;
constexpr size_t WS_XB = 210 * MiB, WS_HB = 274 * MiB, WS_ACT = 338 * MiB, WS_END = 954 * MiB;
constexpr size_t A_QA = 0, A_KA = 32 * MiB, A_VA = 64 * MiB, A_QB = 96 * MiB, A_KB = 128 * MiB, A_VB = 160 * MiB, A_GB = 224 * MiB, A_GATE = 288 * MiB, A_OB = 416 * MiB, A_T1 = 480 * MiB, A_PT = 544 * MiB;
constexpr size_t A_H = 0;
constexpr int XS_ROWS = 2 * M + 2048;
constexpr size_t A_XB8 = 544 * MiB;
constexpr size_t A_YSP = 600 * MiB;
constexpr size_t A_XS = 0, A_HS = 136 * MiB;
static_assert(A_HS + (size_t)XS_ROWS * DFE * 2 <= A_YSP && A_PT + 32 * MiB <= A_YSP && A_YSP + 16 * MiB <= WS_END - WS_ACT, "ws map");

__device__ __forceinline__ unsigned f2bf(float f) { unsigned u = __builtin_bit_cast(unsigned, f); return (u + 0x7fffu + ((u >> 16) & 1u)) >> 16; }
__device__ __forceinline__ unsigned pk2(float lo, float hi) { return f2bf(lo) | (f2bf(hi) << 16); }
__device__ __forceinline__ float bflo(unsigned w) { return __uint_as_float(w << 16); }
__device__ __forceinline__ float bfhi(unsigned w) { return __uint_as_float(w & 0xffff0000u); }
__device__ __forceinline__ float bf2f(bf16 b) { return __uint_as_float((unsigned)b << 16); }
__device__ __forceinline__ float fsigmoid(float x) { return __builtin_amdgcn_rcpf(1.f + __expf(-x)); }
__device__ __forceinline__ float shx(float v, int m, int lane) { return __int_as_float(__builtin_amdgcn_ds_bpermute((lane ^ m) << 2, __float_as_int(v))); }
__device__ __forceinline__ float shi(float v, int src) { return __int_as_float(__builtin_amdgcn_ds_bpermute(src << 2, __float_as_int(v))); }
__device__ __forceinline__ float wave_sum(float v, int lane) {
#pragma unroll
    for (int o = 1; o < 64; o <<= 1) v += shx(v, o, lane);
    return v;
}

__device__ __forceinline__ unsigned pk4_fp8(float a, float b, float c, float d) { int w = __builtin_amdgcn_cvt_pk_fp8_f32(a, b, 0, false); w = __builtin_amdgcn_cvt_pk_fp8_f32(c, d, w, true); return (unsigned)w; }
constexpr float F8_SW1 = 32.f, F8_SW2 = 64.f, F8_SH = 16.f;
struct Frame {
    LAS unsigned char* lds;
    unsigned* ctl;
    int tid, lane, wave, vcu, G, cofs, trow;
    unsigned char* ws;
};

namespace epi {
using pg8::f32x4; using pg8::Unit; using pg8::HALF; using pg8::BM; using pg8::cvt_pk_bf16;
typedef unsigned u32x4 __attribute__((ext_vector_type(4)));
typedef unsigned u32x2 __attribute__((ext_vector_type(2)));
__device__ __forceinline__ u32x4 pack8(f32x4 a, f32x4 b) { u32x4 w; w.x = cvt_pk_bf16(a[0], a[1]); w.y = cvt_pk_bf16(a[2], a[3]); w.z = cvt_pk_bf16(b[0], b[1]); w.w = cvt_pk_bf16(b[2], b[3]); return w; }
__device__ __forceinline__ u32x2 pack4(f32x4 a) { u32x2 w; w.x = cvt_pk_bf16(a[0], a[1]); w.y = cvt_pk_bf16(a[2], a[3]); return w; }
__device__ __forceinline__ f32x4 unlo(u32x4 w) { return (f32x4){bflo(w.x), bfhi(w.x), bflo(w.y), bfhi(w.y)}; }
__device__ __forceinline__ f32x4 unhi(u32x4 w) { return (f32x4){bflo(w.z), bfhi(w.z), bflo(w.w), bfhi(w.w)}; }
__device__ __forceinline__ f32x4 silu4(f32x4 v) { return (f32x4){v[0] * fsigmoid(v[0]), v[1] * fsigmoid(v[1]), v[2] * fsigmoid(v[2]), v[3] * fsigmoid(v[3])}; }
__device__ __forceinline__ f32x4 sigm4(f32x4 v) { return (f32x4){fsigmoid(v[0]), fsigmoid(v[1]), fsigmoid(v[2]), fsigmoid(v[3])}; }

struct EpiInProj {
    static constexpr bool PERM = false, AFTER_DRAIN = false;
    unsigned char* act; const float* cosT; const float* sinT;
    template <int ACT> __device__ __forceinline__ void plain(const f32x4 (&acc)[2][2][4][2], bf16* base, int ldo, int colt, float sc, int row0, int wc, int fq) const {
#pragma unroll
        for (int ai = 0; ai < 2; ++ai)
#pragma unroll
            for (int m = 0; m < 4; ++m) { bf16* rowp = base + (size_t)(row0 + ai * HALF + m * 16) * ldo + colt + wc * 32 + 8 * fq;
#pragma unroll
                for (int bj = 0; bj < 2; ++bj) { f32x4 v0 = acc[ai][bj][m][0], v1 = acc[ai][bj][m][1]; asm volatile("" : "+v"(v0), "+v"(v1));
                    if (ACT == 0) { v0 = v0 * sc; v1 = v1 * sc; } else if (ACT == 1) { v0 = silu4(v0); v1 = silu4(v1); } else { v0 = sigm4(v0); v1 = sigm4(v1); }
                    *(u32x4*)(rowp + bj * HALF) = pack8(v0, v1); }
                asm volatile("" ::: "memory"); __builtin_amdgcn_sched_barrier(0); }
    }
    __device__ __forceinline__ void operator()(const f32x4 (&acc)[2][2][4][2], const Unit& u, int wr, int wc, int fr, int fq) const {
        const int pn = u.pn, row0 = u.pm * BM + wr * 64 + fr;
        if (pn < 6) { plain<0>(acc, (bf16*)(act + A_QA + (size_t)(pn >> 1) * (32 * MiB)), 512, (pn & 1) * 256, pn < 2 ? attn_body::C2 : 1.f, row0, wc, fq); }
        else if (pn < 10) {
            bf16* base = (bf16*)(act + (pn < 8 ? A_QB : A_KB)); const float sc = pn < 8 ? 1.f : 0.125f; const int colt = (pn & 1) * 256, d0 = (wc & 1) * 16 + 4 * fq;
#pragma unroll
            for (int ai = 0; ai < 2; ++ai)
#pragma unroll
                for (int m = 0; m < 4; ++m) { const int row = row0 + ai * HALF + m * 16;
                    const f32x4 cs = *(const f32x4*)(cosT + (size_t)row * 32 + d0) * sc, sn = *(const f32x4*)(sinT + (size_t)row * 32 + d0) * sc;
#pragma unroll
                    for (int bj = 0; bj < 2; ++bj) { f32x4 x1 = acc[ai][bj][m][0], x2 = acc[ai][bj][m][1]; asm volatile("" : "+v"(x1), "+v"(x2));
                        bf16* p = base + (size_t)row * 512 + colt + (2 * bj + (wc >> 1)) * 64 + d0;
                        *(u32x2*)p = pack4(x1 * cs - x2 * sn); *(u32x2*)(p + 32) = pack4(x1 * sn + x2 * cs); }
                    asm volatile("" ::: "memory"); __builtin_amdgcn_sched_barrier(0); }
        }
        else if (pn < 14) plain<0>(acc, (bf16*)(act + A_VB), 1024, (pn - 10) * 256, 1.f, row0, wc, fq);
        else if (pn < 18) plain<0>(acc, (bf16*)(act + A_GB), 1024, (pn - 14) * 256, 1.f, row0, wc, fq);
        else plain<0>(acc, (bf16*)(act + A_GATE), 2048, (pn - 18) * 256, 1.f, row0, wc, fq);
    }
};
struct EpiGated {
    static constexpr bool PERM = false, AFTER_DRAIN = false;
    bf16* out; int ldo; const bf16* gate; int ldg; const bf16* add; float sc;
    __device__ __forceinline__ void operator()(const f32x4 (&acc)[2][2][4][2], const Unit& u, int wr, int wc, int fr, int fq) const {
        const int row0 = u.pm * BM + wr * 64 + fr, col0 = u.pn * BM + wc * 32 + 8 * fq;
#pragma unroll
        for (int ai = 0; ai < 2; ++ai)
#pragma unroll
            for (int m = 0; m < 4; ++m) { const size_t row = (size_t)(row0 + ai * HALF + m * 16);
#pragma unroll
                for (int bj = 0; bj < 2; ++bj) { f32x4 v0 = acc[ai][bj][m][0], v1 = acc[ai][bj][m][1]; asm volatile("" : "+v"(v0), "+v"(v1)); v0 = v0 * sc; v1 = v1 * sc; const int col = col0 + bj * HALF;
                    if (gate) { const u32x4 gv = *(const u32x4*)(gate + row * ldg + col); v0 = v0 * sigm4(unlo(gv)); v1 = v1 * sigm4(unhi(gv)); }
                    if (add) { const u32x4 av = *(const u32x4*)(add + row * ldo + col); v0 = v0 + unlo(av); v1 = v1 + unhi(av); }
                    *(u32x4*)(out + row * ldo + col) = pack8(v0, v1); }
                asm volatile("" ::: "memory"); __builtin_amdgcn_sched_barrier(0); }
    }
};
struct EpiSwiGLU {
    static constexpr bool PERM = false, AFTER_DRAIN = false;
    bf16* out; int ldo;
    __device__ __forceinline__ void operator()(const f32x4 (&acc)[2][2][4][2], const Unit& u, int wr, int wc, int fr, int fq) const {
        const int row0 = u.pm * BM + wr * 64 + fr, hid0 = u.pn * 128 + wc * 16 + 4 * fq;
#pragma unroll
        for (int ai = 0; ai < 2; ++ai)
#pragma unroll
            for (int m = 0; m < 4; ++m) { bf16* rowp = out + (size_t)(row0 + ai * HALF + m * 16) * ldo + hid0;
#pragma unroll
                for (int bj = 0; bj < 2; ++bj) { f32x4 v0 = acc[ai][bj][m][0], v1 = acc[ai][bj][m][1]; asm volatile("" : "+v"(v0), "+v"(v1)); *(u32x2*)(rowp + bj * 64) = pack4(silu4(v0) * v1); }
                asm volatile("" ::: "memory"); __builtin_amdgcn_sched_barrier(0); }
    }
};
struct EpiSwiGLU8 {
    static constexpr bool PERM = false, AFTER_DRAIN = false;
    unsigned char* out; int ldo; float si, so;
    __device__ __forceinline__ void operator()(const f32x4 (&acc)[2][2][4][2], const Unit& u, int wr, int wc, int fr, int fq) const {
        const int row0 = u.pm * BM + wr * 64 + fr, hid0 = u.pn * 128 + wc * 16 + 4 * fq;
#pragma unroll
        for (int ai = 0; ai < 2; ++ai)
#pragma unroll
            for (int m = 0; m < 4; ++m) { unsigned char* rowp = out + (size_t)(row0 + ai * HALF + m * 16) * ldo + hid0;
#pragma unroll
                for (int bj = 0; bj < 2; ++bj) { f32x4 v0 = acc[ai][bj][m][0], v1 = acc[ai][bj][m][1]; asm volatile("" : "+v"(v0), "+v"(v1));
                    const f32x4 h = silu4(v0 * si) * v1 * (si * so); *(unsigned*)(rowp + bj * 64) = pk4_fp8(h[0], h[1], h[2], h[3]); }
                asm volatile("" ::: "memory"); __builtin_amdgcn_sched_barrier(0); }
    }
};
struct MoeOrder {
    int ts[9]; int NT, G, c, lim;
    __device__ __forceinline__ bool next(int i, Unit& u) const {
        const int L = i * G + c; if (L >= lim) return false;
        const int rt = L / NT, pn = L - rt * NT; int e = 0;
#pragma unroll
        for (int j = 1; j < 8; ++j) e += (rt >= ts[j]) ? 1 : 0;
        u.pm = rt; u.pn = pn; u.pb = e * NT + pn; return true;
    }
    __device__ __forceinline__ void a_ready(const Unit&) const {}
    __device__ __forceinline__ void done(const Unit&) const {}
};
struct TailOrder {
    int ts[9]; int L;
    __device__ __forceinline__ bool next(int i, Unit& u) const {
        if (i > 0 || L < 0) return false;
        const int rt = L >> 2, pn = L & 3; int e = 0;
#pragma unroll
        for (int j = 1; j < 8; ++j) e += (rt >= ts[j]) ? 1 : 0;
        u.pm = rt; u.pn = pn; u.pb = e * 4 + pn; return true;
    }
    __device__ __forceinline__ void a_ready(const Unit&) const {}
    __device__ __forceinline__ void done(const Unit&) const {}
};
}

enum { CM_PLAIN = 0, CM_WIN = 1, CM_GU = 2 };
template <int MODE, bool F8 = false>
__device__ __forceinline__ void conv_job(const float* A, const float* B, int K, int pitch, bf16* dst, int ngroups, int gw, int NGW, LAS float* scr, int lane, float sc8 = 1.f) {
    const int nitems = (K >> 6) * ngroups, m = lane & 7, kq = lane >> 3;
    for (int it = gw; it < nitems; it += NGW) {
        const int kb = it / ngroups, g = it - kb * ngroups, k0 = kb * 64;
        const float* src; int sb;
        if (MODE == CM_GU) { src = (m < 4 ? A : B) + g * 16 + 4 * (m & 3); sb = 16 * (m >> 2) + 4 * (m & 3); }
        else { const int r0 = g * 32;
            if (MODE == CM_WIN && r0 >= 1536 && r0 < 2560) { const int p = r0 - 1536; src = A + 1544 + (p >> 6) * 64 + ((p >> 5) & 1) * 16 + 32 * (m >> 2) + 4 * (m & 3); sb = 16 * (m >> 2) + 4 * (m & 3); }
            else { src = A + r0 + ((MODE == CM_WIN && r0 >= 2560) ? 8 : 0) + 4 * m; sb = 16 * (m & 1) + 4 * (m >> 1); } }
        src += (size_t)k0 * pitch;
        f32x4 v[8];
#pragma unroll
        for (int i = 0; i < 8; ++i) v[i] = *(const f32x4*)(src + (size_t)(kq + 8 * i) * pitch);
#pragma unroll
        for (int i = 0; i < 8; ++i) { LAS float* s = scr + (kq + 8 * i) * 33 + sb; s[0] = v[i][0]; s[1] = v[i][1]; s[2] = v[i][2]; s[3] = v[i][3]; }
        LDS_WAIT();
        const int c = lane & 7;
#pragma unroll
        for (int j = 0; j < 4; ++j) { const int n = (lane >> 3) + 8 * j; const LAS float* s = scr + (8 * c) * 33 + n;
            if (F8) { v2u o; o.x = pk4_fp8(s[0 * 33] * sc8, s[1 * 33] * sc8, s[2 * 33] * sc8, s[3 * 33] * sc8); o.y = pk4_fp8(s[4 * 33] * sc8, s[5 * 33] * sc8, s[6 * 33] * sc8, s[7 * 33] * sc8);
                *(v2u*)((unsigned char*)dst + (size_t)(g * 32 + n) * K + k0 + 8 * c) = o; }
            else { v4u o; o.x = pk2(s[0 * 33], s[1 * 33]); o.y = pk2(s[2 * 33], s[3 * 33]); o.z = pk2(s[4 * 33], s[5 * 33]); o.w = pk2(s[6 * 33], s[7 * 33]);
                *(v4u*)(dst + (size_t)(g * 32 + n) * K + k0 + 8 * c) = o; } }
        LDS_WAIT();
    }
}
__device__ __forceinline__ void conv_layer(Frame& F, const float* const* in, int l, int part) {
    LAS float* scr = (LAS float*)(F.lds + F.wave * 16384);
    const int gw = F.vcu * NWAVES + F.wave, NGW = F.G * NWAVES;
    unsigned char* ws = F.ws;
    if (part == 0) {
    conv_job<CM_WIN>(in[2] + (size_t)l * D * INC, nullptr, D, INC, (bf16*)(ws + WS_WIN), NPROJ / 32, gw, NGW, scr, F.lane);
    conv_job<CM_PLAIN>(in[5] + (size_t)l * 512 * D, nullptr, 512, D, (bf16*)(ws + WS_WBF), D / 32, gw, NGW, scr, F.lane);
    conv_job<CM_PLAIN>(in[6] + (size_t)l * D * D, nullptr, D, D, (bf16*)(ws + WS_WBR), D / 32, gw, NGW, scr, F.lane);
    conv_job<CM_PLAIN>(in[7] + (size_t)l * D * D, nullptr, D, D, (bf16*)(ws + WS_WOUT), D / 32, gw, NGW, scr, F.lane);
    return; }
    const int i = l >> 1;
    if ((l & 1) == 0) {
        conv_job<CM_GU, true>(in[10] + (size_t)i * D * DFF, in[11] + (size_t)i * D * DFF, D, DFF, (bf16*)(ws + WS_WFF), 2 * DFF / 32, gw, NGW, scr, F.lane, F8_SW1);
        conv_job<CM_PLAIN, true>(in[12] + (size_t)i * DFF * D, nullptr, DFF, D, (bf16*)(ws + WS_WFF + 12 * MiB), D / 32, gw, NGW, scr, F.lane, F8_SW2);
    } else {
        for (int e = 0; e < NEXP; ++e) {
            const size_t o = ((size_t)i * NEXP + e) * D * DFE;
            conv_job<CM_GU, true>(in[14] + o, in[15] + o, D, DFE, (bf16*)(ws + WS_WFF + (size_t)e * 7 * MiB), 2 * DFE / 32, gw, NGW, scr, F.lane, F8_SW1);
            conv_job<CM_PLAIN, true>(in[16] + o, nullptr, DFE, D, (bf16*)(ws + WS_WFF + 56 * MiB + (size_t)e * (7 * MiB / 2)), D / 32, gw, NGW, scr, F.lane, F8_SW2);
        }
    }
}

template <int MODE, int EXTRA>
__device__ __forceinline__ void row_pass(Frame& F, const float* xin, float* xout, const float* lng, const float* lnb, const float* Wx, int wpitch, const float* bfg) {
    LAS float* WL = (LAS float*)F.lds;
    LAS int* EL = (LAS int*)(F.lds + 32768);
    unsigned char* ws = F.ws;
    const int lane = F.lane, wid = F.wave;
    float alpha_ = DN_ALPHA; asm volatile("" : "+v"(alpha_));
    if (EXTRA == 1 || EXTRA == 2) { for (int idx = F.tid; idx < 8192; idx += NTHR) { const int k = idx >> 3, hh = idx & 7; WL[hh * 1024 + k] = Wx[(size_t)k * wpitch + hh]; } }
    __syncthreads();
    f32x4 gv[4], bv[4];
    if (MODE) {
#pragma unroll
        for (int j = 0; j < 4; ++j) { gv[j] = *(const f32x4*)(lng + 4 * lane + 256 * j); bv[j] = *(const f32x4*)(lnb + 4 * lane + 256 * j); }
    }
    const bf16* HB = (const bf16*)(ws + WS_HB); const bf16* YS = (const bf16*)(ws + WS_ACT + A_XS); const bf16* YSP = (const bf16*)(ws + WS_ACT + A_YSP);
    bf16* XB = (bf16*)(ws + WS_XB);
    for (int blk = blockIdx.x; blk < M / 128; blk += F.G) {
        f32x4 xr[4]; v2u ha[4]; f32x4 hx[4];
#define ROW_LOAD(rr) do { const size_t r_ = (rr); \
            _Pragma("unroll") for (int j = 0; j < 4; ++j) xr[j] = *(const f32x4*)(xin + r_ * D + 4 * lane + 256 * j); \
            if (MODE == 1) { _Pragma("unroll") for (int j = 0; j < 4; ++j) ha[j] = *(const v2u*)(HB + r_ * D + 4 * lane + 256 * j); } \
            else if (MODE == 2) { const int rr_[2] = {((const int*)(ws + WS_RROW))[2 * r_], ((const int*)(ws + WS_RROW))[2 * r_ + 1]}; \
                const float ww_[2] = {((const float*)(ws + WS_RW))[2 * r_], ((const float*)(ws + WS_RW))[2 * r_ + 1]}; \
                _Pragma("unroll") for (int j = 0; j < 4; ++j) hx[j] = (f32x4){0.f, 0.f, 0.f, 0.f}; \
                _Pragma("unroll") for (int k_ = 0; k_ < 2; ++k_) { \
                    if (rr_[k_] < F.trow) { _Pragma("unroll") for (int j = 0; j < 4; ++j) { const v2u a_ = *(const v2u*)(YS + (size_t)rr_[k_] * D + 4 * lane + 256 * j); \
                            hx[j] += (f32x4){bflo(a_.x), bfhi(a_.x), bflo(a_.y), bfhi(a_.y)} * ww_[k_]; } } \
                    else { _Pragma("unroll") for (int s_ = 0; s_ < 4; ++s_) _Pragma("unroll") for (int j = 0; j < 4; ++j) { \
                            const v2u a_ = *(const v2u*)(YSP + ((size_t)s_ * 2048 + (size_t)(rr_[k_] - F.trow)) * D + 4 * lane + 256 * j); \
                            hx[j] += (f32x4){bflo(a_.x), bfhi(a_.x), bflo(a_.y), bfhi(a_.y)} * ww_[k_]; } } } } } while (0)
        ROW_LOAD((size_t)blk * 128 + wid);
        for (int i = 0; i < 16; ++i) {
            const int lr = wid + 8 * i; const size_t row = (size_t)blk * 128 + lr;
            f32x4 v[4];
            if (MODE == 3) {
#pragma unroll
                for (int j = 0; j < 4; ++j) v[j] = xr[j] * alpha_;
            } else if (MODE == 1) {
#pragma unroll
                for (int j = 0; j < 4; ++j) v[j] = xr[j] * alpha_ + (f32x4){bflo(ha[j].x), bfhi(ha[j].x), bflo(ha[j].y), bfhi(ha[j].y)};
            } else if (MODE == 2) {
#pragma unroll
                for (int j = 0; j < 4; ++j) v[j] = xr[j] * alpha_ + hx[j];
            } else {
#pragma unroll
                for (int j = 0; j < 4; ++j) v[j] = xr[j];
            }
            if (i + 1 < 16) ROW_LOAD(row + 8);
            if (MODE) {
                float s = 0.f;
#pragma unroll
                for (int j = 0; j < 4; ++j) s += (v[j][0] + v[j][1]) + (v[j][2] + v[j][3]);
                const float mean = wave_sum(s, lane) * (1.f / D); float s2 = 0.f;
#pragma unroll
                for (int j = 0; j < 4; ++j) { v[j] = v[j] - mean; s2 += (v[j][0] * v[j][0] + v[j][1] * v[j][1]) + (v[j][2] * v[j][2] + v[j][3] * v[j][3]); }
                const float rstd = 1.f / sqrtf(wave_sum(s2, lane) * (1.f / D) + LN_EPS);
#pragma unroll
                for (int j = 0; j < 4; ++j) v[j] = v[j] * rstd * gv[j] + bv[j];
            }
#pragma unroll
            for (int j = 0; j < 4; ++j) { if (MODE) *(f32x4*)(xout + row * D + 4 * lane + 256 * j) = v[j];
                if (!(EXTRA == 3 || EXTRA == 2 || (MODE == 2 && EXTRA == 0))) { v2u o; o.x = pk2(v[j][0], v[j][1]); o.y = pk2(v[j][2], v[j][3]); *(v2u*)(XB + row * D + 4 * lane + 256 * j) = o; }
                if (EXTRA == 3 || EXTRA == 2) *(unsigned*)(ws + WS_ACT + A_XB8 + row * D + 4 * lane + 256 * j) = pk4_fp8(v[j][0], v[j][1], v[j][2], v[j][3]); }
            if (EXTRA == 1 || EXTRA == 2) {
                float d8[8];
#pragma unroll
                for (int hh = 0; hh < 8; ++hh) { float a = 0.f;
#pragma unroll
                    for (int j = 0; j < 4; ++j) { const f32x4 w = *(const LAS f32x4*)(WL + hh * 1024 + 4 * lane + 256 * j); a += (v[j][0] * w[0] + v[j][1] * w[1]) + (v[j][2] * w[2] + v[j][3] * w[3]); }
                    d8[hh] = a; }
                float d4[4], d2[2], d1;
                { const bool up = lane & 1;
#pragma unroll
                  for (int q = 0; q < 4; ++q) { const float snd = up ? d8[q] : d8[q + 4]; const float r = shx(snd, 1, lane); d4[q] = (up ? d8[q + 4] : d8[q]) + r; } }
                { const bool up = lane & 2;
#pragma unroll
                  for (int q = 0; q < 2; ++q) { const float snd = up ? d4[q] : d4[q + 2]; const float r = shx(snd, 2, lane); d2[q] = (up ? d4[q + 2] : d4[q]) + r; } }
                { const bool up = lane & 4; const float snd = up ? d2[0] : d2[1]; const float r = shx(snd, 4, lane); d1 = (up ? d2[1] : d2[0]) + r; }
                d1 += shx(d1, 8, lane); d1 += shx(d1, 16, lane); d1 += shx(d1, 32, lane);
                const int myh = ((lane & 1) << 2) | (lane & 2) | ((lane >> 2) & 1);
                if (EXTRA == 1) {
                    const float z = d1 + bfg[myh];
                    const float lf = fminf(z, 0.f) - __logf(1.f + __expf(-fabsf(z)));
                    if (lane < 8) ((float*)(ws + WS_FLOG))[row * 8 + myh] = lf * LOG2E;
                } else {
                    float lg[8];
#pragma unroll
                    for (int e = 0; e < 8; ++e) lg[e] = shi(d1, ((e & 4) >> 2) | (e & 2) | ((e & 1) << 2));
                    int e0 = 0; float v0 = lg[0];
#pragma unroll
                    for (int e = 1; e < 8; ++e) if (lg[e] > v0) { v0 = lg[e]; e0 = e; }
                    int e1 = -1; float v1 = -INFINITY;
#pragma unroll
                    for (int e = 0; e < 8; ++e) if (e != e0 && lg[e] > v1) { v1 = lg[e]; e1 = e; }
                    const float w1 = 1.f / (1.f + expf(v0 - v1)), w0 = 1.f - w1;
                    if (lane == 0) { EL[2 * lr] = e0; EL[2 * lr + 1] = e1;
                        ((int*)(ws + WS_RE))[2 * row] = e0; ((int*)(ws + WS_RE))[2 * row + 1] = e1;
                        ((float*)(ws + WS_RW))[2 * row] = w0; ((float*)(ws + WS_RW))[2 * row + 1] = w1; }
                }
            }
        }
        if (EXTRA == 2) {
            __syncthreads();
            int msk[4]; int cnt = 0; unsigned long long bm[4];
#pragma unroll
            for (int q = 0; q < 4; ++q) { msk[q] = (EL[q * 64 + lane] == wid); bm[q] = __ballot(msk[q]); cnt += __popcll(bm[q]); }
            int base = 0;
            if (lane == 0) base = (int)__hip_atomic_fetch_add(F.ctl + F.cofs + wid, (unsigned)cnt, RLX_AGENT);
            base = __builtin_amdgcn_readfirstlane(base);
            int run = base;
#pragma unroll
            for (int q = 0; q < 4; ++q) { const int entry = q * 64 + lane; const int rk = run + __popcll(bm[q] & ((1ull << lane) - 1ull));
                if (msk[q]) ((int*)(ws + WS_RR))[(size_t)blk * 256 + entry] = rk;
                run += __popcll(bm[q]); }
            __syncthreads();
        }
    }
#undef ROW_LOAD
    __syncthreads();
}

__device__ __forceinline__ void moe_starts(Frame& F, int (&rs)[9]) {
    int a = 0;
#pragma unroll
    for (int e = 0; e < 8; ++e) { rs[e] = a; const int c = __builtin_amdgcn_readfirstlane((int)__hip_atomic_load(F.ctl + F.cofs + e, RLX_AGENT)); a += (c + 255) & ~255; }
    rs[8] = a;
}
__device__ __forceinline__ void moe_gather(Frame& F) {
    int rs[9]; moe_starts(F, rs);
    unsigned char* ws = F.ws;
    const int gw = F.vcu * NWAVES + F.wave, NGW = F.G * NWAVES;
    const v4u* XB8 = (const v4u*)(ws + WS_ACT + A_XB8); v4u* XS = (v4u*)(ws + WS_ACT + A_XS);
    for (int t = gw; t < M; t += NGW) {
        const v4u a = XB8[(size_t)t * 64 + F.lane];
#pragma unroll
        for (int k = 0; k < 2; ++k) {
            const int e = ((const int*)(ws + WS_RE))[2 * t + k], rel = ((const int*)(ws + WS_RR))[2 * t + k];
            int st = 0;
#pragma unroll
            for (int j = 0; j < 8; ++j) st = (e == j) ? rs[j] : st;
            const int row = st + rel;
            if (F.lane == 0) ((int*)(ws + WS_RROW))[2 * t + k] = row;
            XS[(size_t)row * 64 + F.lane] = a;
        }
    }
}

__device__ __forceinline__ void cs_table(Frame& F, const int* pos) {
    float* cosT = (float*)(F.ws + WS_COS); float* sinT = (float*)(F.ws + WS_SIN);
    const int gt = F.vcu * NTHR + F.tid, NG = F.G * NTHR;
    for (int idx = gt; idx < M * 32; idx += NG) {
        const int row = idx >> 5, i = idx & 31;
        const float inv = powf(10000.0f, -(float)i / 32.0f);
        const float ang = (float)pos[row] * inv;
        cosT[idx] = cosf(ang); sinT[idx] = sinf(ang);
    }
}

__device__ __forceinline__ void ret_state(Frame& F) {
    unsigned char* ws = F.ws;
    const bf16* KB = (const bf16*)(ws + WS_ACT + A_KB); const bf16* VB = (const bf16*)(ws + WS_ACT + A_VB); bf16* PT = (bf16*)(ws + WS_ACT + A_PT);
    const int tid = F.tid, lane = F.lane, wid = F.wave, et = wid >> 2, dt = wid & 3, fr = lane & 15, fq = lane >> 4;
    for (int it = F.vcu; it < 256; it += F.G) {
        const int b = it >> 5, h = (it >> 2) & 7, eq = it & 3;
        const float l2g = log2f(1.f - exp2f(-5.f - (float)h));
        const int j = tid & 127, pp = tid >> 7;
        const float kdec = exp2f((float)(127 - j) * l2g), cd = exp2f(128.f * l2g);
        const bf16* kp = KB + ((size_t)b * SEQ + j) * 512 + h * 64 + pp * 8;
        const bf16* vp = VB + ((size_t)b * SEQ + j) * 1024 + h * 128 + eq * 32 + pp * 8;
        f32x4 acc = {0.f, 0.f, 0.f, 0.f};
        v4u k0 = *(const v4u*)kp, k1 = *(const v4u*)(kp + 32), vv = *(const v4u*)vp;
        for (int n = 0; n < 32; ++n) {
            LAS bf16* KT = (LAS bf16*)(F.lds + (n & 1) * 26112); LAS bf16* VT = KT + 64 * 136;
#pragma unroll
            for (int i = 0; i < 4; ++i) { const unsigned a = k0[i], c = k1[i], d = vv[i];
                KT[(pp * 8 + 2 * i) * 136 + j] = (bf16)f2bf(bflo(a) * kdec); KT[(pp * 8 + 2 * i + 1) * 136 + j] = (bf16)f2bf(bfhi(a) * kdec);
                KT[(pp * 8 + 32 + 2 * i) * 136 + j] = (bf16)f2bf(bflo(c) * kdec); KT[(pp * 8 + 33 + 2 * i) * 136 + j] = (bf16)f2bf(bfhi(c) * kdec);
                VT[(pp * 8 + 2 * i) * 136 + j] = (bf16)(d & 0xffffu); VT[(pp * 8 + 2 * i + 1) * 136 + j] = (bf16)(d >> 16); }
            if (n + 1 < 32) { const size_t o = (size_t)(n + 1) * 128; k0 = *(const v4u*)(kp + o * 512); k1 = *(const v4u*)(kp + o * 512 + 32); vv = *(const v4u*)(vp + o * 1024); }
            __syncthreads();
            bf16* pt = PT + ((((size_t)b * 32 + n) * 8 + h) * 128 + eq * 32 + et * 16 + 4 * fq) * 64 + dt * 16 + fr;
#pragma unroll
            for (int q = 0; q < 4; ++q) pt[q * 64] = (bf16)f2bf(acc[q]);
            acc = acc * cd;
#pragma unroll
            for (int ks = 0; ks < 4; ++ks) {
                const bf16x8 a = *(const LAS bf16x8*)(VT + (et * 16 + fr) * 136 + ks * 32 + 8 * fq);
                const bf16x8 bb = *(const LAS bf16x8*)(KT + (dt * 16 + fr) * 136 + ks * 32 + 8 * fq);
                acc = __builtin_amdgcn_mfma_f32_16x16x32_bf16(a, bb, acc, 0, 0, 0);
            }
        }
        __syncthreads();
    }
}
template <bool FULL>
__device__ __forceinline__ void ret_out(Frame& F, const float* rng) {
    unsigned char* ws = F.ws;
    const bf16* QB = (const bf16*)(ws + WS_ACT + A_QB); const bf16* KB = (const bf16*)(ws + WS_ACT + A_KB); const bf16* VB = (const bf16*)(ws + WS_ACT + A_VB);
    const bf16* GB = (const bf16*)(ws + WS_ACT + A_GB); const bf16* PT = (const bf16*)(ws + WS_ACT + A_PT); bf16* OB = (bf16*)(ws + WS_ACT + A_OB);
    LAS bf16* Qs = (LAS bf16*)F.lds; LAS bf16* Ks = Qs + 128 * 72; LAS bf16* Ps = Ks + 128 * 72; LAS bf16* VT = Ps + 128 * 72; LAS bf16* Ss = VT + 128 * 136;
    const int tid = F.tid, lane = F.lane, wid = F.wave, fr = lane & 15, fq = lane >> 4;
    const int il = 16 * wid + fr;
    int u = F.vcu; if (u >= 2048) return;
    v4u rq[2], rk[2], rp[2], rv[4];
#define RET_LOAD(uu) do { const int b_ = (uu) >> 8, n_ = ((uu) >> 3) & 31, h_ = (uu) & 7; const size_t t0_ = (size_t)b_ * SEQ + n_ * 128; \
        _Pragma("unroll") for (int i = 0; i < 2; ++i) { const int p = tid + 512 * i, r = p >> 3, c = p & 7; \
            rq[i] = *(const v4u*)(QB + (t0_ + r) * 512 + h_ * 64 + c * 8); rk[i] = *(const v4u*)(KB + (t0_ + r) * 512 + h_ * 64 + c * 8); \
            rp[i] = *(const v4u*)(PT + ((((size_t)b_ * 32 + n_) * 8 + h_) * 128 + r) * 64 + c * 8); } \
        _Pragma("unroll") for (int i = 0; i < 4; ++i) { const int p = tid + 512 * i, ep = p >> 7, j = p & 127; rv[i] = *(const v4u*)(VB + (t0_ + j) * 1024 + h_ * 128 + ep * 8); } } while (0)
    RET_LOAD(u);
    for (;;) {
        const int b = u >> 8, n = (u >> 3) & 31, h = u & 7;
        const float l2g = log2f(1.f - exp2f(-5.f - (float)h));
        const size_t tok0 = (size_t)b * SEQ + n * 128;
#pragma unroll
        for (int i = 0; i < 2; ++i) { const int p = tid + 512 * i, r = p >> 3, c = p & 7;
            *(LAS v4u*)(Qs + r * 72 + c * 8) = rq[i]; *(LAS v4u*)(Ks + r * 72 + c * 8) = rk[i]; *(LAS v4u*)(Ps + r * 72 + c * 8) = rp[i]; }
#pragma unroll
        for (int i = 0; i < 4; ++i) { const int p = tid + 512 * i, ep = p >> 7, j = p & 127;
#pragma unroll
            for (int q = 0; q < 4; ++q) { VT[(ep * 8 + 2 * q) * 136 + j] = (bf16)(rv[i][q] & 0xffffu); VT[(ep * 8 + 2 * q + 1) * 136 + j] = (bf16)(rv[i][q] >> 16); } }
        asm volatile("s_waitcnt lgkmcnt(0)\n\ts_barrier" ::: "memory");
        const int un = u + F.G;
        const size_t row = tok0 + il;
        v2u gbr[8]; f32x4 g4[8];
        if (FULL) {
#pragma unroll
        for (int et = 0; et < 8; ++et) { const int e = h * 128 + et * 16 + 4 * fq; gbr[et] = *(const v2u*)(GB + row * 1024 + e); g4[et] = *(const f32x4*)(rng + e); }
        }
        if (un < 2048) RET_LOAD(un);
        if (FULL) {
        bf16x8 qf[2];
#pragma unroll
        for (int ks = 0; ks < 2; ++ks) qf[ks] = *(const LAS bf16x8*)(Qs + il * 72 + ks * 32 + 8 * fq);
        const int nks = (wid >> 1) + 1;
#pragma unroll
        for (int jt = 0; jt < 8; ++jt) {
            if (jt <= wid) {
                f32x4 st = {0.f, 0.f, 0.f, 0.f};
#pragma unroll
                for (int ks = 0; ks < 2; ++ks) { const bf16x8 kf = *(const LAS bf16x8*)(Ks + (jt * 16 + fr) * 72 + ks * 32 + 8 * fq); st = __builtin_amdgcn_mfma_f32_16x16x32_bf16(kf, qf[ks], st, 0, 0, 0); }
                f32x4 o;
#pragma unroll
                for (int q = 0; q < 4; ++q) { const int jj = jt * 16 + 4 * fq + q; o[q] = (il >= jj) ? st[q] * exp2f((float)(il - jj) * l2g) : 0.f; }
                v2u w; w.x = pk2(o[0], o[1]); w.y = pk2(o[2], o[3]);
                *(LAS v2u*)(Ss + il * 136 + jt * 16 + 4 * fq) = w;
            } else if (jt < 2 * nks) { *(LAS v2u*)(Ss + il * 136 + jt * 16 + 4 * fq) = (v2u){0u, 0u}; }
        }
        LDS_WAIT();
        f32x4 acc[8];
        const float qd = exp2f((float)(il + 1) * l2g);
#pragma unroll
        for (int et = 0; et < 8; ++et) { f32x4 a = {0.f, 0.f, 0.f, 0.f};
#pragma unroll
            for (int ks = 0; ks < 2; ++ks) { const bf16x8 pf = *(const LAS bf16x8*)(Ps + (et * 16 + fr) * 72 + ks * 32 + 8 * fq); a = __builtin_amdgcn_mfma_f32_16x16x32_bf16(pf, qf[ks], a, 0, 0, 0); }
            acc[et] = a * qd; }
#pragma unroll
        for (int ks = 0; ks < 4; ++ks) { if (ks < nks) { const bf16x8 sf = *(const LAS bf16x8*)(Ss + il * 136 + ks * 32 + 8 * fq);
#pragma unroll
            for (int et = 0; et < 8; ++et) { const bf16x8 vf = *(const LAS bf16x8*)(VT + (et * 16 + fr) * 136 + ks * 32 + 8 * fq); acc[et] = __builtin_amdgcn_mfma_f32_16x16x32_bf16(vf, sf, acc[et], 0, 0, 0); } } }
        float ss = 0.f;
#pragma unroll
        for (int et = 0; et < 8; ++et) ss += (acc[et][0] * acc[et][0] + acc[et][1] * acc[et][1]) + (acc[et][2] * acc[et][2] + acc[et][3] * acc[et][3]);
        ss += shx(ss, 16, lane); ss += shx(ss, 32, lane);
        const float rn = 1.f / sqrtf(ss * (1.f / 128.f) + RMS_EPS);
#pragma unroll
        for (int et = 0; et < 8; ++et) { const int e = h * 128 + et * 16 + 4 * fq;
            const f32x4 gg = {bflo(gbr[et].x), bfhi(gbr[et].x), bflo(gbr[et].y), bfhi(gbr[et].y)};
            const f32x4 o = acc[et] * rn * g4[et] * (f32x4){gg[0] * fsigmoid(gg[0]), gg[1] * fsigmoid(gg[1]), gg[2] * fsigmoid(gg[2]), gg[3] * fsigmoid(gg[3])};
            v2u w; w.x = pk2(o[0], o[1]); w.y = pk2(o[2], o[3]); *(v2u*)(OB + row * 1024 + e) = w; }
        }
        asm volatile("s_waitcnt lgkmcnt(0)\n\ts_barrier" ::: "memory");
        if (un >= 2048) break;
        u = un;
    }
#undef RET_LOAD
}

#ifdef RETCHK
__device__ __forceinline__ int qerr(float e) { return e > 0.25f ? 0 : e > 0.03f ? 1 : e > 0.004f ? 2 : e > 0.0005f ? 3 : 4; }
__device__ __forceinline__ void ret_check(Frame& F, const float* const* in, const float* rng) {
    if (blockIdx.x != 0) return;
    unsigned char* ws = F.ws;
    const bf16* QB = (const bf16*)(ws + WS_ACT + A_QB); const bf16* KB = (const bf16*)(ws + WS_ACT + A_KB); const bf16* VB = (const bf16*)(ws + WS_ACT + A_VB);
    const bf16* GB = (const bf16*)(ws + WS_ACT + A_GB); const bf16* PT = (const bf16*)(ws + WS_ACT + A_PT); const bf16* OB = (const bf16*)(ws + WS_ACT + A_OB);
    const int lane = F.lane;
    float w1 = 0.f, w2 = 0.f, w3 = 0.f;
    for (int p = F.wave; p < 64; p += 8) {
        const int ti = p >> 3, h = p & 7;
        const int row = ti == 0 ? 0 : ti == 1 ? 1 : ti == 2 ? 127 : ti == 3 ? 128 : ti == 4 ? 200 : ti == 5 ? 1000 : ti == 6 ? 4095 : 4096 + 2500;
        const int b = row / SEQ, t = row % SEQ, n = t >> 7, i = t & 127;
        const float l2g = log2f(1.f - exp2f(-5.f - (float)h));
        float q[64];
#pragma unroll
        for (int d = 0; d < 64; ++d) q[d] = bf2f(QB[(size_t)row * 512 + h * 64 + d]);
        float y0 = 0.f, y1 = 0.f, yi0 = 0.f, yi1 = 0.f;
        for (int s = 0; s <= t; ++s) {
            const bf16* kr = KB + ((size_t)b * SEQ + s) * 512 + h * 64; float dot = 0.f;
#pragma unroll
            for (int d = 0; d < 64; ++d) dot += q[d] * bf2f(kr[d]);
            const float w = dot * exp2f((float)(t - s) * l2g);
            const float v0 = bf2f(VB[((size_t)b * SEQ + s) * 1024 + h * 128 + 2 * lane]), v1 = bf2f(VB[((size_t)b * SEQ + s) * 1024 + h * 128 + 2 * lane + 1]);
            y0 += w * v0; y1 += w * v1; if (s >= n * 128) { yi0 += w * v0; yi1 += w * v1; }
        }
        const bf16* pt = PT + ((((size_t)b * 32 + n) * 8 + h) * 128 + 2 * lane) * 64; float c0 = 0.f, c1 = 0.f;
#pragma unroll
        for (int d = 0; d < 64; ++d) { c0 += q[d] * bf2f(pt[d]); c1 += q[d] * bf2f(pt[64 + d]); }
        const float qd = exp2f((float)(i + 1) * l2g);
        const float z0 = yi0 + qd * c0, z1 = yi1 + qd * c1;
        const float ms = wave_sum(y0 * y0 + y1 * y1, lane) * (1.f / 128.f), rms = sqrtf(ms) + 1e-20f;
        float e1 = fmaxf(fabsf(z0 - y0), fabsf(z1 - y1)) / rms;
#pragma unroll
        for (int o = 1; o < 64; o <<= 1) e1 = fmaxf(e1, shx(e1, o, lane));
        w1 = fmaxf(w1, e1);
        const float rn = 1.f / sqrtf(ms + RMS_EPS); const int e = h * 128 + 2 * lane;
        const float o0 = y0 * rn * rng[e] * bf2f(GB[(size_t)row * 1024 + e]), o1 = y1 * rn * rng[e + 1] * bf2f(GB[(size_t)row * 1024 + e + 1]);
        const float os = sqrtf(wave_sum(o0 * o0 + o1 * o1, lane) * (1.f / 128.f)) + 1e-20f;
        float e2 = fmaxf(fabsf(o0 - bf2f(OB[(size_t)row * 1024 + e])), fabsf(o1 - bf2f(OB[(size_t)row * 1024 + e + 1]))) / os;
#pragma unroll
        for (int o = 1; o < 64; o <<= 1) e2 = fmaxf(e2, shx(e2, o, lane));
        w2 = fmaxf(w2, e2);
    }
    {
        const int sel = (lane >> 1) & 3; const int cc = (3 + 37 * (lane >> 3) + F.wave * 101) % 1024;
        const int r = (sel == 0 ? 2560 : sel == 1 ? 4608 : sel == 2 ? 5632 : 3584) + cc; const int rho = r & 31; const int col = r - rho + 8 + pg8::perm32(rho);
        const bf16* WT = (const bf16*)(ws + WS_WIN); const float* W = in[2];
        float e3 = 0.f;
        for (int kk = 0; kk < 16; ++kk) { const int k = kk * 64 + ((lane & 1) * 32 + (lane >> 3) * 3 + F.wave) % 64; e3 += fabsf(bf2f(WT[(size_t)r * D + k]) - W[(size_t)k * INC + col]); }
        e3 *= (1.f / 16.f) * 30.f;
        e3 += shx(e3, 1, lane); e3 += shx(e3, 8, lane); e3 += shx(e3, 16, lane); e3 += shx(e3, 32, lane);
        w3 = e3 * (1.f / 16.f);
    }
    LAS float* red = (LAS float*)F.lds;
    if (lane == 0 || lane == 2 || lane == 4 || lane == 6) red[F.wave * 4 + (lane >> 1)] = w3;
    __syncthreads();
    if (F.tid == 0) { float s[4] = {0.f, 0.f, 0.f, 0.f}; for (int w = 0; w < 8; ++w) { s[0] += red[w * 4] * 0.125f; s[1] += red[w * 4 + 1] * 0.125f; s[2] += red[w * 4 + 2] * 0.125f; s[3] += red[w * 4 + 3] * 0.125f; }
        ((float*)F.ctl)[200] = 1000.f * (1.f + floorf(100.f * s[CHKSEL] + 0.5f)); }
    __syncthreads();
}
#endif
#define XB_TMO      128
#define XB_XCNT(j)  (256  + 64 * (j))
#define XB_XSUB(j)  (1280 + 64 * (j))
#define XB_XGEN(j)  (2304 + 64 * (j))
#define XB_TOP      3328
#define XB_TOPGEN   3392
#define XCD_BAR_WORDS 3456
#define XB_SPIN_CAP (1u << 18)

__device__ __forceinline__ unsigned xb_ld(unsigned* p)              { return __hip_atomic_load(p, __ATOMIC_RELAXED, __HIP_MEMORY_SCOPE_AGENT); }
__device__ __forceinline__ unsigned xb_add(unsigned* p, unsigned v) { return __hip_atomic_fetch_add(p, v, __ATOMIC_RELAXED, __HIP_MEMORY_SCOPE_AGENT); }
__device__ __forceinline__ unsigned xb_xcc_id() { return (unsigned)__builtin_amdgcn_s_getreg((3 << 11) | 20) & 0xFu; }
#define XB_SPIN(cond, bar) do { unsigned _sp = 0; while (cond) { __builtin_amdgcn_s_sleep(1); \
    if ((++_sp & 255u) == 0u) { if (xb_ld(&(bar)[XB_TMO])) break; if (_sp > XB_SPIN_CAP) { atomicAdd(&(bar)[XB_TMO], 1u); break; } } } } while (0)

struct XcdBarrier {
    unsigned* bar; unsigned x;
    volatile LAS unsigned* st;
};

__device__ __forceinline__ XcdBarrier xcd_barrier_post(unsigned* bar, volatile LAS unsigned* st) {
    XcdBarrier b; b.bar = bar; b.x = xb_xcc_id(); b.st = st;
    if (threadIdx.x == 0) (void)xb_add(&bar[XB_XCNT(b.x)], 1u);
    return b;
}
__device__ __forceinline__ void xcd_barrier_complete(unsigned* bar, unsigned x, unsigned& nloc, unsigned& nx) {
    const unsigned G = gridDim.x * gridDim.y * gridDim.z;
    unsigned sum, cnt, mine, sp = 0u;
    for (;;) {
        sum = 0u; cnt = 0u; mine = 0u;
#pragma unroll
        for (unsigned j = 0; j < 16; ++j) { const unsigned c = xb_ld(&bar[XB_XCNT(j)]); sum += c; cnt += (c > 0u) ? 1u : 0u; mine = (j == x) ? c : mine; }
        if (sum == G) break;
        __builtin_amdgcn_s_sleep(1);
        if ((++sp & 255u) == 0u) { if (xb_ld(&bar[XB_TMO])) break; if (sp > XB_SPIN_CAP) { atomicAdd(&bar[XB_TMO], 1u); break; } }
    }
    nloc = mine > 0u ? mine : 1u; nx = cnt > 0u ? cnt : 1u;
}

__device__ __forceinline__ void xcd_barrier(const XcdBarrier& b) {
    asm volatile("s_waitcnt vmcnt(0)" ::: "memory");
    __syncthreads();
    if (threadIdx.x == 0) {
        unsigned* bar = b.bar; asm volatile("" : "+s"(bar));
        __builtin_amdgcn_s_waitcnt(0);
        const unsigned bx_ = (unsigned)__builtin_amdgcn_readfirstlane((int)b.x);
        unsigned nloc = b.st[0], nx = b.st[1];
        if (nloc == 0u) { xcd_barrier_complete(bar, bx_, nloc, nx); b.st[0] = nloc; b.st[1] = nx; }
        const unsigned old = xb_add(&bar[XB_XSUB(bx_)], 1u);
        const unsigned gen = old / nloc;
        if (old + 1u == (gen + 1u) * nloc) {
            __builtin_amdgcn_fence(__ATOMIC_RELEASE, "agent");
            asm volatile("s_waitcnt vmcnt(0)" ::: "memory");
            const unsigned og = xb_add(&bar[XB_TOP], 1u);
            const unsigned tg = og / nx;
            if (og + 1u == (tg + 1u) * nx) xb_add(&bar[XB_TOPGEN], 1u);
            else XB_SPIN(xb_ld(&bar[XB_TOPGEN]) == tg, bar);
            __builtin_amdgcn_fence(__ATOMIC_ACQUIRE, "agent");
            xb_add(&bar[XB_XGEN(bx_)], 1u);
            asm volatile("s_waitcnt vmcnt(0)" ::: "memory");
        } else {
            XB_SPIN(xb_ld(&bar[XB_XGEN(bx_)]) == gen, bar);
            __builtin_amdgcn_fence(__ATOMIC_ACQUIRE, "agent");
            asm volatile("s_waitcnt vmcnt(0)" ::: "memory");
        }
    }
    __syncthreads();
}

#ifndef PHM
#define PHM 0xffff
#endif
#ifndef ZH
#define ZH 0
#endif
#ifndef ZB
#define ZB 0
#endif
#ifndef DUP
#define DUP 0
#endif
struct Args { const float* in[19]; float* out; unsigned char* ws; };
__global__ void __launch_bounds__(NTHR, 2) mega_fwd(Args args) {
    extern __shared__ __attribute__((aligned(16))) unsigned char lds[];
    cg::grid_group grid = cg::this_grid();
    Frame F;
    F.lds = (LAS unsigned char*)lds; F.ws = args.ws; F.ctl = (unsigned*)(args.ws + WS_CTL);
    F.tid = threadIdx.x; F.lane = F.tid & 63; F.wave = __builtin_amdgcn_readfirstlane(F.tid >> 6);
    F.cofs = 64; F.trow = 1 << 30; F.G = gridDim.x; { const int bx = blockIdx.x; F.vcu = (F.G % 8 == 0) ? (bx % 8) * (F.G / 8) + bx / 8 : bx; }
    unsigned char* ws = args.ws; unsigned char* act = ws + WS_ACT;
    volatile LAS unsigned* xst = (volatile LAS unsigned*)(F.lds + 131072 + 512);
    if (F.tid < 2) xst[F.tid] = 0u;
    __syncthreads();
    const float* const* in = args.in;
    float* X = args.out;
    bf16* XB = (bf16*)(ws + WS_XB); bf16* HB = (bf16*)(ws + WS_HB);
    typedef pg8::StaticOrder SO;
#define GSYNC0() do { asm volatile("s_waitcnt vmcnt(0) lgkmcnt(0)" ::: "memory"); grid.sync(); __builtin_amdgcn_fence(__ATOMIC_ACQUIRE, "agent"); asm volatile("s_waitcnt vmcnt(0)" ::: "memory"); } while (0)
#define GSYNC() xcd_barrier(xbar)
#define OPQ() do { asm volatile("" : "+s"(F.wave), "+s"(F.vcu), "+s"(ws), "+s"(act)); F.ws = ws; F.lane = pg8::lane_id_opaque(); F.tid = F.wave * 64 + F.lane; } while (0)
#define GEMM(EpiT, OrdT, g, S, E) pg8::gemm_phase<EpiT, OrdT, true, true>(F.lds, g, S, E, F.wave)
#define GEMM8(EpiT, OrdT, g, S, E) pg8::gemm_phase<EpiT, OrdT, true, true, true>(F.lds, g, S, E, F.wave)

    if (blockIdx.x == 0) { for (int i_ = F.tid; i_ < 8192; i_ += NTHR) F.ctl[i_] = 0u; }
    GSYNC0();
    const XcdBarrier xbar = xcd_barrier_post(F.ctl + 4096, xst);
    if (PHM & 1) cs_table(F, (const int*)in[1]);
    if (PHM & 2) row_pass<0, 1>(F, in[0], X, nullptr, nullptr, in[2] + 1536, INC, in[3]);
    if (PHM & 4) conv_layer(F, in, 0, 0);
    GSYNC();

#pragma unroll 1
    for (int l = 0; l < DEPTH; ++l) {
        const int fi = l >> 1; const bool moe = (l & 1) != 0; F.cofs = 64 + 16 * fi; OPQ();
        if (DUP & 32) { for (int k_ = 0; k_ < 10; ++k_) { GSYNC(); } }
        if (PHM & 8) { pg8::Gemm g{XB, (const bf16*)(ws + WS_WIN), M, NPROJ, D}; SO S; S.init(M, NPROJ, F.G, (int)blockIdx.x);
          epi::EpiInProj E{act, (const float*)(ws + WS_COS), (const float*)(ws + WS_SIN)};
          GEMM(epi::EpiInProj, SO, g, S, E); if (DUP & 16) { OPQ(); GEMM(epi::EpiInProj, SO, g, S, E); } }
        GSYNC(); OPQ();
        if (PHM & 16) ret_state(F);
        if (DUP & 2) { OPQ(); ret_state(F); }
        OPQ();
        if (PHM & 32) { const attn_body::AttnTensors AT{(const attn_body::bf16*)(act + A_QA), (const attn_body::bf16*)(act + A_KA), (const attn_body::bf16*)(act + A_VA), (attn_body::bf16*)(act + A_QA), (const float*)(ws + WS_FLOG)};
          const attn_body::StaticOrder S((int)F.G, (int)blockIdx.x);
          attn_body::attn_phase<attn_body::StaticOrder>((char*)lds, AT, S, F.wave); }
        GSYNC(); OPQ();
        if (PHM & 64) ret_out<true>(F, in[4] + (size_t)l * 1024);
        if (DUP & 4) { OPQ(); ret_out<true>(F, in[4] + (size_t)l * 1024); }
        if (DUP & 64) { OPQ(); ret_out<false>(F, in[4] + (size_t)l * 1024); }
        GSYNC(); OPQ();
#ifdef RETCHK
        if (l == 0) { ret_check(F, in, in[4]); OPQ(); }
#endif
        if (PHM & 128) { pg8::Gemm g{(const bf16*)(act + A_QA), (const bf16*)(ws + WS_WBF), M, D, 512}; SO S; S.init(M, D, F.G, (int)blockIdx.x);
          epi::EpiGated E{(bf16*)(act + A_T1), D, (const bf16*)(act + A_GATE), 2048, nullptr, (ZB & 1) ? 0.f : 1.f};
          GEMM(epi::EpiGated, SO, g, S, E); }
        OPQ();
        if (PHM & 128) { pg8::Gemm g{(const bf16*)(act + A_OB), (const bf16*)(ws + WS_WBR), M, D, D}; SO S; S.init(M, D, F.G, (int)blockIdx.x);
          epi::EpiGated E{(bf16*)(act + A_T1), D, (const bf16*)(act + A_GATE) + 1024, 2048, (const bf16*)(act + A_T1), (ZB & 2) ? 0.f : 1.f};
          GEMM(epi::EpiGated, SO, g, S, E); }
        GSYNC(); OPQ();
        if (PHM & 128) { pg8::Gemm g{(const bf16*)(act + A_T1), (const bf16*)(ws + WS_WOUT), M, D, D}; SO S; S.init(M, D, F.G, (int)blockIdx.x);
          epi::EpiGated E{HB, D, nullptr, 0, nullptr, 1.f};
          GEMM(epi::EpiGated, SO, g, S, E); if (DUP & 128) { OPQ(); GEMM(epi::EpiGated, SO, g, S, E); } }
        GSYNC(); OPQ();
        if (!(PHM & 256)) {} else if (moe) row_pass<(ZH & 1) ? 3 : 1, 2>(F, X, X, in[8] + (size_t)l * D, in[9] + (size_t)l * D, in[13] + (size_t)fi * D * NEXP, NEXP, nullptr);
        else row_pass<(ZH & 1) ? 3 : 1, 3>(F, l == 0 ? in[0] : (const float*)X, X, in[8] + (size_t)l * D, in[9] + (size_t)l * D, nullptr, 0, nullptr);
        OPQ();
        if ((PHM & 4) && !moe) conv_layer(F, in, l, 1);
        GSYNC(); OPQ();
#ifdef ONLYMOE
        if (!moe) {} else
#endif
        if (!(PHM & 512)) {} else if (!moe) {
            { pg8::Gemm g{(const bf16*)(act + A_XB8), (const bf16*)(ws + WS_WFF), M, 2 * DFF, D / 2, 0}; SO S; S.init(M, 2 * DFF, F.G, (int)blockIdx.x);
              epi::EpiSwiGLU8 E{(unsigned char*)(act + A_H), DFF, 1.f / F8_SW1, F8_SH};
              GEMM8(epi::EpiSwiGLU8, SO, g, S, E); }
            GSYNC(); OPQ();
            { pg8::Gemm g{(const bf16*)(act + A_H), (const bf16*)(ws + WS_WFF + 12 * MiB), M, D, DFF / 2, 0}; SO S; S.init(M, D, F.G, (int)blockIdx.x);
              epi::EpiGated E{HB, D, nullptr, 0, nullptr, 1.f / (F8_SH * F8_SW2)};
              GEMM8(epi::EpiGated, SO, g, S, E); }
            GSYNC(); OPQ();
            row_pass<(ZH & 2) ? 3 : 1, 1>(F, X, X, in[17] + (size_t)l * D, in[18] + (size_t)l * D, in[2] + (size_t)(l + 1) * D * INC + 1536, INC, in[3] + (l + 1) * 8);
        } else {
            moe_gather(F);
            OPQ();
            if (PHM & 4) conv_layer(F, in, l, 1);
            GSYNC(); OPQ();
            { epi::MoeOrder S; moe_starts(F, S.ts);
#pragma unroll
              for (int e = 0; e < 9; ++e) S.ts[e] >>= 8;
              S.NT = 2 * DFE / 256; S.G = F.G; S.c = (int)blockIdx.x; S.lim = S.ts[8] * S.NT;
              pg8::Gemm g{(const bf16*)(act + A_XS), (const bf16*)(ws + WS_WFF), XS_ROWS, 2 * DFE, D / 2, 0};
              epi::EpiSwiGLU8 E{(unsigned char*)(act + A_HS), DFE, 1.f / F8_SW1, F8_SH};
              GEMM8(epi::EpiSwiGLU8, epi::MoeOrder, g, S, E); if (DUP & 8) { OPQ(); GEMM8(epi::EpiSwiGLU8, epi::MoeOrder, g, S, E); } }
            GSYNC(); OPQ();
            { epi::MoeOrder S; moe_starts(F, S.ts);
#pragma unroll
              for (int e = 0; e < 9; ++e) S.ts[e] >>= 8;
              S.NT = D / 256; S.G = F.G; S.c = (int)blockIdx.x;
              S.lim = S.ts[8] * 4;
              pg8::Gemm g{(const bf16*)(act + A_HS), (const bf16*)(ws + WS_WFF + 56 * MiB), XS_ROWS, D, DFE / 2, 0};
              epi::EpiGated E{(bf16*)(act + A_XS), D, nullptr, 0, nullptr, 1.f / (F8_SH * F8_SW2)};
              GEMM8(epi::EpiGated, epi::MoeOrder, g, S, E);
              F.trow = 1 << 30; }
            GSYNC(); OPQ();
            if (l + 1 < DEPTH) row_pass<(ZH & 4) ? 3 : 2, 1>(F, X, X, in[17] + (size_t)l * D, in[18] + (size_t)l * D, in[2] + (size_t)(l + 1) * D * INC + 1536, INC, in[3] + (l + 1) * 8);
            else row_pass<(ZH & 4) ? 3 : 2, 0>(F, X, X, in[17] + (size_t)l * D, in[18] + (size_t)l * D, nullptr, 0, nullptr);
        }
        if (l + 1 < DEPTH) { if (PHM & 4) conv_layer(F, in, l + 1, 0); GSYNC(); }
    }
#ifdef RETCHK
    GSYNC();
    if (blockIdx.x == 0 && F.tid == 0) { X[0] = ((float*)F.ctl)[200]; }
#endif
#undef GEMM
}

constexpr int LDS_DYN = 147456;
extern "C" void kernel_launch(void* const* d_in, const int* in_sizes, int n_in, void* d_out, int out_size, void* d_ws, size_t ws_size, hipStream_t stream) {
    static int grid = 0;
    if (grid == 0) {
        if (n_in != 19 || out_size != M * D || ws_size < WS_END) { fprintf(stderr, "kernel_launch: bad shapes (n_in %d out %d ws %zu need %zu)\n", n_in, out_size, ws_size, (size_t)WS_END); grid = -1; return; }
        int dev = 0, cus = 0, per_cu = 0;
        hipGetDevice(&dev); hipDeviceGetAttribute(&cus, hipDeviceAttributeMultiprocessorCount, dev);
        if (hipFuncSetAttribute((const void*)mega_fwd, hipFuncAttributeMaxDynamicSharedMemorySize, LDS_DYN) != hipSuccess) { fprintf(stderr, "kernel_launch: hipFuncSetAttribute failed\n"); grid = -1; return; }
        if (hipOccupancyMaxActiveBlocksPerMultiprocessor(&per_cu, (const void*)mega_fwd, NTHR, LDS_DYN) != hipSuccess || per_cu < 1) { fprintf(stderr, "kernel_launch: occupancy query says %d\n", per_cu); per_cu = 1; }
        (void)hipGetLastError();
        grid = cus * per_cu;
        fprintf(stderr, "kernel_launch: grid %d (cus %d x %d)\n", grid, cus, per_cu);
    }
    if (grid < 0) return;
    (void)hipMemsetAsync((char*)d_ws + WS_CTL, 0, 65536, stream);
    Args a{};
    for (int i = 0; i < 19; ++i) a.in[i] = (const float*)d_in[i];
    a.out = (float*)d_out; a.ws = (unsigned char*)d_ws;
    void* kargs[] = {&a};
    const hipError_t e = hipLaunchCooperativeKernel((const void*)mega_fwd, dim3(grid), dim3(NTHR), kargs, LDS_DYN, stream);
    if (e != hipSuccess) fprintf(stderr, "kernel_launch: cooperative launch failed: %s (grid %d)\n", hipGetErrorString(e), grid);
}
```

```cpp
#include <hip/hip_runtime.h>
#include <cstdio>
#include <cstdint>
namespace pg8 {
#define PG8_LAS __attribute__((address_space(3)))
typedef unsigned short bf16_t;
typedef short bf16x8 __attribute__((ext_vector_type(8)));
typedef float f32x4 __attribute__((ext_vector_type(4)));
typedef unsigned u32x4 __attribute__((ext_vector_type(4)));
constexpr int BM = 256, BK = 64, HALF = 128, HTB = HALF * BK * 2  , STAGE_BYTES = 8 * HTB, NXCD = 8, WGM = 8;

__host__ __device__ __forceinline__ int lds_byte(int r, int c) { const int st = (r >> 4) * 2 + (c >> 5), rr = r & 15, cc = c & 31, ob = rr * 64 + cc * 2; return st * 1024 + (ob ^ (((ob >> 9) & 1) << 5)); }
__host__ __device__ __forceinline__ void stage_rc(int b, int& R, int& C) { const int st = b / 1024, sb = b % 1024, swz = sb ^ (((sb >> 9) & 1) << 5); R = (st >> 1) * 16 + swz / 64; C = (st & 1) * 32 + (swz % 64) / 2; }
__host__ __device__ __forceinline__ int perm32(int rho) { const int n = rho >> 4, i = rho & 15; return 8 * (i >> 2) + 4 * n + (i & 3); }

__device__ __forceinline__ int lane_id_opaque() { unsigned m_ = ~0u; asm volatile("" : "+s"(m_)); return (int)__builtin_amdgcn_mbcnt_hi(m_, __builtin_amdgcn_mbcnt_lo(m_, 0u)); }
struct Unit { int pm, pn, pb; };
struct Gemm { const bf16_t* A; const bf16_t* Bt; int M, N, K, Kp; };

struct StaticOrder {
    int nM, nN, nwg, G, c;
    __host__ __device__ void init(int M, int N, int G_, int c_) { nM = M / BM; nN = N / BM; nwg = nM * nN; G = G_; c = c_; }
    __host__ __device__ bool next(int i, Unit& u) const {
        const long L = (long)i * G + c; if (L >= nwg) return false;
        int wgid = (int)L; { const int q = nwg / NXCD, r = nwg % NXCD, xcd = wgid % NXCD, off = wgid / NXCD; wgid = (xcd < r ? xcd * (q + 1) : r * (q + 1) + (xcd - r) * q) + off; }
        const int nig = WGM * nN, gid = wgid / nig, fm = gid * WGM, gsz = (nM - fm) < WGM ? (nM - fm) : WGM;
        u.pm = fm + ((wgid % nig) % gsz); u.pn = (wgid % nig) / gsz; u.pb = u.pn; return true;
    }
    __device__ __forceinline__ void a_ready(const Unit&) const {}
    __device__ __forceinline__ void done(const Unit&) const {}
};

__device__ __forceinline__ unsigned cvt_pk_bf16(float lo, float hi) { unsigned r; asm volatile("v_cvt_pk_bf16_f32 %0, %1, %2" : "=v"(r) : "v"(lo), "v"(hi)); return r; }
typedef float f32x2 __attribute__((ext_vector_type(2)));
__device__ __forceinline__ f32x2 gelu_pk(f32x2 v) {
    const f32x2 av = __builtin_elementwise_abs(v), d = av * 0.2316418882f + 1.0f;
    f32x2 t; t.x = __builtin_amdgcn_rcpf(d.x); t.y = __builtin_amdgcn_rcpf(d.y);
    f32x2 q = t * 0.5307027145f + (-0.7265760135f); q = q * t + 0.7107068705f; q = q * t + (-0.142248368f); q = q * t + 0.127414796f; q = q * t;
    const f32x2 s = (v * v) * (-0.72134752044f);
    f32x2 e; e.x = __builtin_amdgcn_exp2f(s.x); e.y = __builtin_amdgcn_exp2f(s.y);
    const f32x2 m = v * (q * e), r = v - m;
    f32x2 o; o.x = v.x < 0.f ? m.x : r.x; o.y = v.y < 0.f ? m.y : r.y; return o;
}

template <int ACT  > struct EpiBf16 {
    static constexpr bool PERM = true, AFTER_DRAIN = false; static_assert(ACT == 0 || ACT == 1, "EpiBf16: ACT is 0 (none) or 1 (gelu_pk)");
    bf16_t* O; int ldc; const float* bias; int split_cols; size_t split_stride; float scale0;
    __device__ __forceinline__ void operator()(const f32x4 (&acc)[2][2][4][2], const Unit& u, int wr, int wc, int fr, int fq) const {
        const int row0 = u.pm * BM + wr * 64 + fr; int colt = u.pn * BM; bf16_t* base = O;
        float sc = 1.f; if (split_cols) { const int t = colt / split_cols; base += (size_t)t * split_stride; colt -= t * split_cols; if (t == 0) sc = scale0; }
        const int col0 = colt + wc * 32 + 8 * fq, bcol0 = u.pn * BM + wc * 32 + 8 * fq;
        f32x4 bv[2][2];
#pragma unroll
        for (int bj = 0; bj < 2; ++bj)
#pragma unroll
            for (int n = 0; n < 2; ++n) bv[bj][n] = bias ? *(const f32x4*)(bias + bcol0 + bj * HALF + 4 * n) : (f32x4){0.f, 0.f, 0.f, 0.f};
#pragma unroll
        for (int ai = 0; ai < 2; ++ai)
#pragma unroll
            for (int m = 0; m < 4; ++m) { bf16_t* rowp = base + (size_t)(row0 + ai * HALF + m * 16) * ldc + col0;
#pragma unroll
                for (int bj = 0; bj < 2; ++bj) { f32x4 v0 = acc[ai][bj][m][0] + bv[bj][0], v1 = acc[ai][bj][m][1] + bv[bj][1];
                    if (ACT == 1) { f32x2 a = gelu_pk((f32x2){v0[0], v0[1]}), b = gelu_pk((f32x2){v0[2], v0[3]}), c = gelu_pk((f32x2){v1[0], v1[1]}), d = gelu_pk((f32x2){v1[2], v1[3]});
                        v0 = (f32x4){a.x, a.y, b.x, b.y}; v1 = (f32x4){c.x, c.y, d.x, d.y}; }
                    v0 = v0 * sc; v1 = v1 * sc; u32x4 w; w.x = cvt_pk_bf16(v0[0], v0[1]); w.y = cvt_pk_bf16(v0[2], v0[3]); w.z = cvt_pk_bf16(v1[0], v1[1]); w.w = cvt_pk_bf16(v1[2], v1[3]);
                    *(u32x4*)(rowp + bj * HALF) = w; } }
    }
};

struct PanelStats {
    unsigned* xbuf;
    unsigned* cnt;
    unsigned* tmo;
    int ntn; float eps;
    unsigned code;
    __device__ __forceinline__ bool run(const f32x4 (&v)[2][2][4][2], const Unit& u, int wr, int wc, int fr, int fq, PG8_LAS unsigned char* lds, int wid, int lane) const {
        typedef float f32x2v __attribute__((ext_vector_type(2)));
        PG8_LAS f32x2v* P = (PG8_LAS f32x2v*)lds;
        PG8_LAS f32x2v* S = (PG8_LAS f32x2v*)(lds + 8192);
        PG8_LAS unsigned* flag = (PG8_LAS unsigned*)(lds + 8192 + 2048);
#pragma unroll
        for (int ai = 0; ai < 2; ++ai)
#pragma unroll
            for (int m = 0; m < 4; ++m) {
                float s = 0.f;
#pragma unroll
                for (int bj = 0; bj < 2; ++bj)
#pragma unroll
                    for (int n = 0; n < 2; ++n) { const f32x4 x = v[ai][bj][m][n]; s += (x[0] + x[1]) + (x[2] + x[3]); }
                s += __shfl_xor(s, 16); s += __shfl_xor(s, 32);
                const float mw = s * (1.0f / 64.0f); float q = 0.f;
#pragma unroll
                for (int bj = 0; bj < 2; ++bj)
#pragma unroll
                    for (int n = 0; n < 2; ++n) { const f32x4 d = v[ai][bj][m][n] - mw; q += (d[0] * d[0] + d[1] * d[1]) + (d[2] * d[2] + d[3] * d[3]); }
                q += __shfl_xor(q, 16); q += __shfl_xor(q, 32);
                if (fq == 0) P[(ai * HALF + wr * 64 + m * 16 + fr) * 4 + wc] = (f32x2v){mw, q};
            }
        asm volatile("s_waitcnt lgkmcnt(0)" ::: "memory"); __builtin_amdgcn_s_barrier(); asm volatile("" ::: "memory");
#if defined(BROKEN_EXCHANGE_NO_WAIT)
#warning BROKEN CONTROL BUILD: the row-statistics exchange does not wait; results are wrong by design
        if (blockIdx.x >= 64) { const long long t0_ = clock64(); while (clock64() - t0_ < 60000) __builtin_amdgcn_s_sleep(8); }
#endif
        const int row = wid * 32 + (lane & 31);
        if (lane < 32) {
            const f32x2v a = P[row * 4 + 0], b = P[row * 4 + 1], c = P[row * 4 + 2], d = P[row * 4 + 3];
            const float mt = (a.x + b.x + c.x + d.x) * 0.25f;
            const float da = a.x - mt, db = b.x - mt, dc = c.x - mt, dd = d.x - mt;
            const float m2 = (a.y + b.y) + (c.y + d.y) + 64.0f * ((da * da + db * db) + (dc * dc + dd * dd));
            unsigned long long* slot = (unsigned long long*)xbuf + ((size_t)(u.pm * BM + row) * 4 + u.pn);
            __hip_atomic_store(slot, ((unsigned long long)__float_as_uint(m2) << 32) | __float_as_uint(mt), __ATOMIC_RELAXED, __HIP_MEMORY_SCOPE_AGENT);
        }
        asm volatile("s_waitcnt vmcnt(0)" ::: "memory");
        if (lane == 0) __hip_atomic_fetch_add(cnt + 64 * u.pm, 1u, __ATOMIC_RELAXED, __HIP_MEMORY_SCOPE_AGENT);
        if (wid == 0) {
            bool dead = false; const unsigned long long t0 = __builtin_amdgcn_s_memrealtime(); const unsigned want = 8u * (unsigned)ntn;
            for (;;) {
#if defined(BROKEN_EXCHANGE_NO_WAIT)
                break;
#endif
                if ((unsigned)__builtin_amdgcn_readfirstlane(__hip_atomic_load(cnt + 64 * u.pm, __ATOMIC_RELAXED, __HIP_MEMORY_SCOPE_AGENT)) >= want) break;
                if (__builtin_amdgcn_s_memrealtime() - t0 > 2000000ull) {
                    if (lane == 0) { unsigned expect = 0u; __hip_atomic_compare_exchange_strong(tmo + 1, &expect, code | (unsigned)(u.pm & 0xff), __ATOMIC_RELAXED, __ATOMIC_RELAXED, __HIP_MEMORY_SCOPE_AGENT);
                                     __hip_atomic_store(tmo, 1u, __ATOMIC_RELAXED, __HIP_MEMORY_SCOPE_AGENT); }
                    dead = true; break; }
                __builtin_amdgcn_s_sleep(2);
            }
            __builtin_amdgcn_fence(__ATOMIC_ACQUIRE, "agent");
            if (lane == 0) flag[0] = dead ? 1u : 0u;
        }
        asm volatile("s_waitcnt vmcnt(0) lgkmcnt(0)" ::: "memory"); __builtin_amdgcn_s_barrier(); asm volatile("" ::: "memory");
        const bool bad = flag[0] != 0u;
        if (lane < 32) {
            const unsigned long long* slot = (const unsigned long long*)xbuf + (size_t)(u.pm * BM + row) * 4; float mt[4], m2[4]; float ms = 0.f;
#pragma unroll
            for (int t = 0; t < 4; ++t) { if (t < ntn) { const unsigned long long w = __hip_atomic_load(slot + t, __ATOMIC_RELAXED, __HIP_MEMORY_SCOPE_AGENT); mt[t] = __uint_as_float((unsigned)w); m2[t] = __uint_as_float((unsigned)(w >> 32)); } else { mt[t] = 0.f; m2[t] = 0.f; } ms += mt[t]; }
            const float mean = ms / (float)ntn; float q = 0.f;
#pragma unroll
            for (int t = 0; t < 4; ++t) if (t < ntn) { const float dm = mt[t] - mean; q += m2[t] + 256.0f * dm * dm; }
            S[row] = (f32x2v){mean, 1.0f / sqrtf(q / (256.0f * (float)ntn) + eps)};
        }
        asm volatile("s_waitcnt lgkmcnt(0)" ::: "memory"); __builtin_amdgcn_s_barrier(); asm volatile("" ::: "memory");
        return bad;
    }
};
struct EpiLnRes {
    static constexpr bool PERM = false, AFTER_DRAIN = true;
    const float* base; float* out; int ldc; const float* bias; PanelStats st; unsigned poison;
    __device__ __forceinline__ void fused(f32x4 (&acc)[2][2][4][2], const Unit& u, int wr, int wc, int fr, int fq, PG8_LAS unsigned char* lds, int wid, int lane) const {
        typedef float f32x2v __attribute__((ext_vector_type(2)));
        const PG8_LAS f32x2v* S = (const PG8_LAS f32x2v*)(lds + 8192);
        const int col0 = u.pn * BM + wc * 32 + 4 * fq;
#pragma unroll
        for (int bj = 0; bj < 2; ++bj)
#pragma unroll
            for (int n = 0; n < 2; ++n) { const f32x4 bv = bias ? *(const f32x4*)(bias + col0 + bj * HALF + n * 16) : (f32x4){0.f, 0.f, 0.f, 0.f};
#pragma unroll
                for (int ai = 0; ai < 2; ++ai)
#pragma unroll
                    for (int m = 0; m < 4; ++m) acc[ai][bj][m][n] += bv; }
        f32x4 pre[4][2][2];
#pragma unroll
        for (int m = 0; m < 4; ++m) { const size_t off = (size_t)(u.pm * BM + wr * 64 + m * 16 + fr) * ldc + col0;
#pragma unroll
            for (int bj = 0; bj < 2; ++bj)
#pragma unroll
                for (int n = 0; n < 2; ++n) pre[m][bj][n] = *(const f32x4*)(base + off + bj * HALF + n * 16); }
        const bool bad = st.run(acc, u, wr, wc, fr, fq, lds, wid, lane) || poison != 0u;
        const float qnan = __builtin_nanf("");
#pragma unroll
        for (int ai = 0; ai < 2; ++ai)
#pragma unroll
            for (int m = 0; m < 4; ++m) { const int r = ai * HALF + wr * 64 + m * 16 + fr; const f32x2v sr = S[r]; const size_t off = (size_t)(u.pm * BM + r) * ldc + col0;
#pragma unroll
                for (int bj = 0; bj < 2; ++bj)
#pragma unroll
                    for (int n = 0; n < 2; ++n) { const f32x4 bs = ai == 0 ? pre[m][bj][n] : *(const f32x4*)(base + off + bj * HALF + n * 16); f32x4 o = bs + (acc[ai][bj][m][n] - sr.x) * sr.y;
                        if (bad) o = (f32x4){qnan, qnan, qnan, qnan}; *(f32x4*)(out + off + bj * HALF + n * 16) = o; }
                if (m & 1) asm volatile("" ::: "memory"); }
    }
};
struct EpiLnResLn {
    static constexpr bool PERM = false, AFTER_DRAIN = true;
    const float* base; float* out; bf16_t* xn; int ldc; const float* bias; PanelStats st1, st2; unsigned poison;
    __device__ __forceinline__ void fused(f32x4 (&acc)[2][2][4][2], const Unit& u, int wr, int wc, int fr, int fq, PG8_LAS unsigned char* lds, int wid, int lane) const {
        typedef float f32x2v __attribute__((ext_vector_type(2))); typedef unsigned u32x2v __attribute__((ext_vector_type(2)));
        const PG8_LAS f32x2v* S = (const PG8_LAS f32x2v*)(lds + 8192);
        const int col0 = u.pn * BM + wc * 32 + 4 * fq;
#pragma unroll
        for (int bj = 0; bj < 2; ++bj)
#pragma unroll
            for (int n = 0; n < 2; ++n) { const f32x4 bv = bias ? *(const f32x4*)(bias + col0 + bj * HALF + n * 16) : (f32x4){0.f, 0.f, 0.f, 0.f};
#pragma unroll
                for (int ai = 0; ai < 2; ++ai)
#pragma unroll
                    for (int m = 0; m < 4; ++m) acc[ai][bj][m][n] += bv; }
        bool bad = st1.run(acc, u, wr, wc, fr, fq, lds, wid, lane) || poison != 0u;
        const float qnan = __builtin_nanf("");
#pragma unroll
        for (int ai = 0; ai < 2; ++ai)
#pragma unroll
            for (int m = 0; m < 4; ++m) { const int r = ai * HALF + wr * 64 + m * 16 + fr; const f32x2v sr = S[r]; const size_t off = (size_t)(u.pm * BM + r) * ldc + col0;
#pragma unroll
                for (int bj = 0; bj < 2; ++bj)
#pragma unroll
                    for (int n = 0; n < 2; ++n) { const f32x4 bs = *(const f32x4*)(base + off + bj * HALF + n * 16); acc[ai][bj][m][n] = bs + (acc[ai][bj][m][n] - sr.x) * sr.y; }
                asm volatile("" : "+v"(acc[ai][0][m][0]), "+v"(acc[ai][0][m][1]), "+v"(acc[ai][1][m][0]), "+v"(acc[ai][1][m][1]));
                if (m & 1) asm volatile("" ::: "memory"); }
        const bool bad1 = bad;
        bad = st2.run(acc, u, wr, wc, fr, fq, lds, wid, lane) || bad;
#pragma unroll
        for (int ai = 0; ai < 2; ++ai)
#pragma unroll
            for (int m = 0; m < 4; ++m) { const int r = ai * HALF + wr * 64 + m * 16 + fr; const f32x2v sr = S[r]; const size_t off = (size_t)(u.pm * BM + r) * ldc + col0;
#pragma unroll
                for (int bj = 0; bj < 2; ++bj)
#pragma unroll
                    for (int n = 0; n < 2; ++n) { const f32x4 x1 = acc[ai][bj][m][n]; *(f32x4*)(out + off + bj * HALF + n * 16) = bad1 ? (f32x4){qnan, qnan, qnan, qnan} : x1;
                        const f32x4 o = (x1 - sr.x) * sr.y; u32x2v w; w.x = cvt_pk_bf16(o[0], o[1]); w.y = cvt_pk_bf16(o[2], o[3]);
                        if (bad) { w.x = 0x7fc07fc0u; w.y = 0x7fc07fc0u; } *(u32x2v*)(xn + off + bj * HALF + n * 16) = w; }
                asm volatile("" ::: "memory"); }
    }
};

typedef int v4i_t __attribute__((ext_vector_type(4)));
typedef int v8i_t __attribute__((ext_vector_type(8)));
template <bool F8> struct Frag { bf16x8 v[2]; };
template <> struct Frag<true> { v8i_t v; };
template <class Epi, class Sched, bool ALIGN_EPI = false, bool SP2 = false, bool FP8 = false>
__device__ __forceinline__ void gemm_phase(PG8_LAS unsigned char* lds, const Gemm g, const Sched& S, const Epi& E, const int wid) {
    const int lane = lane_id_opaque(), tid = wid * 64 + lane, wr = wid >> 2, wc = wid & 3, fr = lane & 15, fq = lane >> 4;
    int K_ = g.K, Kp_ = g.Kp ? g.Kp : g.K; asm volatile("" : "+s"(K_), "+s"(Kp_));
    const int K = K_, nt = K / BK, Kp = Kp_;
    const char* gA_ = (const char*)g.A; const char* gB_ = (const char*)g.Bt; asm volatile("" : "+s"(gA_), "+s"(gB_));
    unsigned voffA[2], voffB[2];
#pragma unroll
    for (int i = 0; i < 2; ++i) { int R, C; stage_rc(tid * 16 + i * 8192, R, C); const int Rb = Epi::PERM ? ((R & ~31) + perm32(R & 31)) : R;
        voffA[i] = (unsigned)(R * Kp + C) * 2u; voffB[i] = (unsigned)(Rb * Kp + C) * 2u; }
    const size_t kstep = (size_t)(BK * 2);
    const size_t hstep = (size_t)HALF * Kp * 2;
    const size_t tstep = 2 * hstep;
    const unsigned ldsw = (unsigned)wid * 1024u;
    const int lf_ = FP8 ? lds_byte(fr, fq * 16) : lds_byte(fr, fq * 8);
    const int aoff = lf_ + wr * 8192, boff = lf_ + wc * 4096;
#define PG8_SA(b, h) (((b) * 2 + (h)) * HTB)
#define PG8_SB(b, h) ((4 + (b) * 2 + (h)) * HTB)
#define PG8_STAGE(bufoff, gbase, voff) do { _Pragma("unroll") for (int _i = 0; _i < 2; ++_i) { unsigned vo_ = (voff)[_i]; asm volatile("" : "+v"(vo_));     \
        __builtin_amdgcn_global_load_lds((const unsigned*)((const char*)(gbase) + vo_), (PG8_LAS unsigned*)(lds + (bufoff) + ldsw + _i * 8192), 16, 0, 0); } } while (0)
#define PG8_LDF(dst, off) do { if constexpr (FP8) { dst.v = *(const PG8_LAS v8i_t*)(lds + (off)); } \
        else { dst.v[0] = *(const PG8_LAS bf16x8*)(lds + (off)); dst.v[1] = *(const PG8_LAS bf16x8*)(lds + (off) + 1024); } } while (0)
#define PG8_LDA(dst, b, h) do { _Pragma("unroll") for (int m = 0; m < 4; ++m) PG8_LDF(dst[m], PG8_SA(b, h) + aoff + m * 2048); } while (0)
#define PG8_LDB(dst, b, h) do { _Pragma("unroll") for (int n = 0; n < 2; ++n) PG8_LDF(dst[n], PG8_SB(b, h) + boff + n * 2048); } while (0)
#define PG8_CAT8(lo, hi) __builtin_shufflevector(__builtin_bit_cast(v4i_t, lo), __builtin_bit_cast(v4i_t, hi), 0, 1, 2, 3, 4, 5, 6, 7)
#define PG8_MMA(ai, bj, At, Bt) do { __builtin_amdgcn_s_setprio(1); _Pragma("unroll") for (int m = 0; m < 4; ++m) _Pragma("unroll") for (int n = 0; n < 2; ++n) { \
        if constexpr (FP8) { asm volatile("v_mfma_f32_16x16x128_f8f6f4 %0, %1, %2, %0" : "+v"(acc[ai][bj][m][n]) : "v"(Bt[n].v), "v"(At[m].v)); }     \
        else { _Pragma("unroll") for (int k = 0; k < 2; ++k) acc[ai][bj][m][n] = __builtin_amdgcn_mfma_f32_16x16x32_bf16(Bt[n].v[k], At[m].v[k], acc[ai][bj][m][n], 0, 0, 0); } } \
        __builtin_amdgcn_s_setprio(0); } while (0)
#define PG8_WAIT_V(n) asm volatile("s_waitcnt vmcnt(" #n ")" ::: "memory")
#define PG8_WAIT_L(n) asm volatile("s_waitcnt lgkmcnt(" #n ")" ::: "memory")
#define PG8_BAR __builtin_amdgcn_s_barrier()
#define PG8_SCHED __builtin_amdgcn_sched_barrier(0)
    Unit cur, nxt; int ui = 0;
    if (!S.next(0, cur)) return;
    f32x4 acc[2][2][4][2];
#pragma unroll
    for (int a = 0; a < 2; ++a)
#pragma unroll
        for (int b = 0; b < 2; ++b)
#pragma unroll
            for (int m = 0; m < 4; ++m)
#pragma unroll
                for (int n = 0; n < 2; ++n) acc[a][b][m][n] = (f32x4){0.f, 0.f, 0.f, 0.f};
    Frag<FP8> At[4], B0[2], B1[2];
    const char* cA = gA_ + (size_t)cur.pm * tstep; const char* cB = gB_ + (size_t)cur.pb * tstep;
    S.a_ready(cur);
    if constexpr (SP2) {
        PG8_STAGE(PG8_SB(0, 0), cB, voffB); PG8_STAGE(PG8_SB(0, 1), cB + hstep, voffB); PG8_STAGE(PG8_SA(0, 0), cA, voffA); PG8_STAGE(PG8_SA(0, 1), cA + hstep, voffA);
        if (wr == 1) PG8_BAR;
        PG8_WAIT_V(2); PG8_BAR;
        PG8_STAGE(PG8_SB(1, 0), cB + kstep, voffB); PG8_STAGE(PG8_SA(1, 0), cA + kstep, voffA); PG8_STAGE(PG8_SB(1, 1), cB + hstep + kstep, voffB);
        PG8_WAIT_V(6); PG8_BAR;
    } else {
        PG8_STAGE(PG8_SB(0, 0), cB, voffB); PG8_STAGE(PG8_SA(0, 0), cA, voffA); PG8_STAGE(PG8_SB(0, 1), cB + hstep, voffB); PG8_STAGE(PG8_SA(0, 1), cA + hstep, voffA);
        if (wr == 1) PG8_BAR;
        PG8_WAIT_V(4); PG8_BAR;
        PG8_STAGE(PG8_SB(1, 0), cB + kstep, voffB); PG8_STAGE(PG8_SA(1, 0), cA + kstep, voffA); PG8_STAGE(PG8_SB(1, 1), cB + hstep + kstep, voffB);
        PG8_WAIT_V(6); PG8_BAR;
    }
    for (;;) {
        const bool has_next = S.next(ui + 1, nxt);
        const char* nA = has_next ? gA_ + (size_t)nxt.pm * tstep : cA; const char* nB = has_next ? gB_ + (size_t)nxt.pb * tstep : cB;
        for (int t = 0; t < nt; t += 2) {
            const bool last = (t == nt - 2);
            const char* a1 = cA + (size_t)(t + 1) * kstep;
            const char* a2 = last ? nA : cA + (size_t)(t + 2) * kstep; const char* b2 = last ? nB : cB + (size_t)(t + 2) * kstep;
            const char* a3 = a2 + kstep; const char* b3 = b2 + kstep;
            if (last && has_next) S.a_ready(nxt);
            if constexpr (SP2) {
            PG8_LDB(B0, 0, 0); PG8_LDB(B1, 0, 1); PG8_SCHED; PG8_LDA(At, 0, 0); PG8_STAGE(PG8_SA(1, 1), a1 + hstep, voffA);
            PG8_WAIT_V(8); PG8_WAIT_L(0); PG8_BAR; PG8_MMA(0, 0, At, B0); PG8_MMA(0, 1, At, B1); PG8_BAR; PG8_SCHED;
            PG8_LDA(At, 0, 1); PG8_STAGE(PG8_SB(0, 0), b2, voffB); PG8_STAGE(PG8_SB(0, 1), b2 + hstep, voffB); PG8_STAGE(PG8_SA(0, 0), a2, voffA);
            PG8_WAIT_V(8); PG8_WAIT_L(0); PG8_BAR; PG8_MMA(1, 0, At, B0); PG8_MMA(1, 1, At, B1); PG8_BAR; PG8_SCHED;
            PG8_LDB(B0, 1, 0); PG8_LDB(B1, 1, 1); PG8_SCHED; PG8_LDA(At, 1, 0); PG8_STAGE(PG8_SA(0, 1), a2 + hstep, voffA);
            PG8_WAIT_V(8); PG8_WAIT_L(0); PG8_BAR; PG8_MMA(0, 0, At, B0); PG8_MMA(0, 1, At, B1); PG8_BAR; PG8_SCHED;
            PG8_LDA(At, 1, 1); PG8_STAGE(PG8_SB(1, 0), b3, voffB); PG8_STAGE(PG8_SB(1, 1), b3 + hstep, voffB); PG8_STAGE(PG8_SA(1, 0), a3, voffA);
            PG8_WAIT_V(8); PG8_WAIT_L(0); PG8_BAR; PG8_MMA(1, 0, At, B0); PG8_MMA(1, 1, At, B1); PG8_BAR; PG8_SCHED;
            } else {
            PG8_LDB(B0, 0, 0); PG8_SCHED; PG8_LDA(At, 0, 0); PG8_STAGE(PG8_SA(1, 1), a1 + hstep, voffA);
            PG8_WAIT_L(8); PG8_BAR; PG8_WAIT_L(0); PG8_MMA(0, 0, At, B0); PG8_BAR; PG8_SCHED;
            PG8_LDB(B1, 0, 1); PG8_STAGE(PG8_SB(0, 0), b2, voffB);
            PG8_BAR; PG8_WAIT_L(0); PG8_MMA(0, 1, At, B1); PG8_BAR;
            PG8_LDA(At, 0, 1); PG8_STAGE(PG8_SA(0, 0), a2, voffA);
            PG8_BAR; PG8_WAIT_L(0); PG8_MMA(1, 0, At, B0); PG8_BAR; PG8_SCHED;
            PG8_STAGE(PG8_SB(0, 1), b2 + hstep, voffB);
            PG8_WAIT_V(6); PG8_BAR; PG8_MMA(1, 1, At, B1); PG8_BAR;
            PG8_LDB(B0, 1, 0); PG8_SCHED; PG8_LDA(At, 1, 0); PG8_STAGE(PG8_SA(0, 1), a2 + hstep, voffA);
            PG8_WAIT_L(8); PG8_BAR; PG8_WAIT_L(0); PG8_MMA(0, 0, At, B0); PG8_BAR; PG8_SCHED;
            PG8_LDB(B1, 1, 1); PG8_STAGE(PG8_SB(1, 0), b3, voffB);
            PG8_BAR; PG8_WAIT_L(0); PG8_MMA(0, 1, At, B1); PG8_BAR;
            PG8_LDA(At, 1, 1); PG8_STAGE(PG8_SA(1, 0), a3, voffA);
            PG8_BAR; PG8_WAIT_L(0); PG8_MMA(1, 0, At, B0); PG8_BAR; PG8_SCHED;
            PG8_STAGE(PG8_SB(1, 1), b3 + hstep, voffB);
            PG8_WAIT_V(6); PG8_BAR; PG8_MMA(1, 1, At, B1); PG8_BAR;
            }
        }
        if constexpr (ALIGN_EPI) { if (wr == 0) PG8_BAR; }
        if constexpr (FP8) { asm volatile("s_nop 15\n\ts_nop 15" ::: "memory"); }
        if constexpr (!Epi::AFTER_DRAIN) { const int ln_ = lane_id_opaque(); const int fr_ = ln_ & 15, fq_ = ln_ >> 4; int wr_ = wr, wc_ = wc; asm volatile("" : "+s"(wr_), "+s"(wc_)); E(acc, cur, wr_, wc_, fr_, fq_); S.done(cur); }
        if (!has_next) break;
#pragma unroll
        for (int a = 0; a < 2; ++a)
#pragma unroll
            for (int b = 0; b < 2; ++b)
#pragma unroll
                for (int m = 0; m < 4; ++m)
#pragma unroll
                    for (int n = 0; n < 2; ++n) acc[a][b][m][n] = (f32x4){0.f, 0.f, 0.f, 0.f};
        cur = nxt; cA = nA; cB = nB; ++ui;
        if constexpr (ALIGN_EPI) { if (wr == 1) PG8_BAR; }
    }
    PG8_WAIT_V(0);
    if constexpr (!ALIGN_EPI) { if (wr == 0) PG8_BAR; }
    PG8_BAR;
    if constexpr (Epi::AFTER_DRAIN) { E.fused(acc, cur, wr, wc, fr, fq, lds, wid, lane); S.done(cur); }
#undef PG8_SA
#undef PG8_SB
#undef PG8_STAGE
#undef PG8_LDA
#undef PG8_LDF
#undef PG8_LDB
#undef PG8_MMA
#undef PG8_CAT8
#undef PG8_WAIT_V
#undef PG8_WAIT_L
#undef PG8_BAR
#undef PG8_SCHED
}
}

#ifndef PG8_SP2
#define PG8_SP2 true
#endif
#ifndef PG8_ALIGN
#define PG8_ALIGN true
#endif
#include <hip/hip_bf16.h>
#include <cmath>
namespace attn_body {
using bf16=__hip_bfloat16;
using bf16x8=__attribute__((ext_vector_type(8)))short;
using s16x4=__attribute__((ext_vector_type(4)))short;
using f32x16=__attribute__((ext_vector_type(16)))float;
using u32x4=__attribute__((ext_vector_type(4)))unsigned;
constexpr int BATCH=8,NHEAD=8,SEQ=4096,D=64,DM=NHEAD*D;
constexpr int NW=8,QBLK=32,QB=QBLK*NW,KVBLK=64,NQB=SEQ/QB;
constexpr int ATTN_PITCH=DM, ATTN_UNIT_ROWS=QB;
__device__ __forceinline__ int crow(int r,int hi){return (r&3)+8*(r>>2)+4*hi;}
#define SBAR() __builtin_amdgcn_sched_barrier(0)
__device__ __forceinline__ void cmask(f32x16&p0,f32x16&p1,int jb,int qrel,int hi){
  const float NEG=-INFINITY; int kb=64*jb+4*hi;
  #pragma unroll
  for(int r=0;r<16;++r){int kv=kb+(r&3)+8*(r>>2); if(kv>qrel)p0[r]=NEG; if(kv+32>qrel)p1[r]=NEG;}
}

constexpr int NSLOT=3, SLOTB=8192;
constexpr int LDS_K=0, LDS_V=NSLOT*SLOTB, LDS_WS=2*NSLOT*SLOTB, LDS_OST=LDS_WS+NW*64*4, LDS_BYTES=LDS_OST+NW*4096, LDS_CB=86016, LDS_CBW=LDS_CB+16384;
constexpr float C2=0.125f*1.4426950408889634f;
__device__ __forceinline__ void glds16(const void*gsrc,unsigned lds_dst){unsigned keep;
  asm volatile("s_mov_b32 %0, m0\n\ts_mov_b32 m0, %2\n\ts_nop 0\n\tglobal_load_lds_dwordx4 %1, off\n\ts_mov_b32 m0, %0":"=&s"(keep):"v"(gsrc),"s"(lds_dst):"memory");}
__device__ __forceinline__ float max3f(float a,float b,float c){float r;asm("v_max3_f32 %0, %1, %2, %3":"=v"(r):"v"(a),"v"(b),"v"(c));return r;}
__device__ __forceinline__ float max2f(float a,float b){float r;asm("v_max_f32_e32 %0, %1, %2":"=v"(r):"v"(a),"v"(b));return r;}
__device__ __forceinline__ float fadd_s(float a,float b){float r;asm("v_add_f32_e32 %0, %1, %2":"=v"(r):"v"(a),"v"(b));return r;}
__device__ __forceinline__ float fsub_s(float a,float b){float r;asm("v_sub_f32_e32 %0, %1, %2":"=v"(r):"v"(a),"v"(b));return r;}
typedef float f32x2_t __attribute__((ext_vector_type(2))); typedef __bf16 bf16x2_t __attribute__((ext_vector_type(2)));
__device__ __forceinline__ unsigned cvtpk_s(float lo,float hi){f32x2_t v={lo,hi};bf16x2_t b=__builtin_convertvector(v,bf16x2_t);return __builtin_bit_cast(unsigned,b);}
#define WAIT_BAR(N) asm volatile("s_waitcnt vmcnt(" #N ") lgkmcnt(0)\n\ts_barrier":::"memory")

__device__ __forceinline__ void qkt(f32x16&p0,f32x16&p1,const char*Kslot,const bf16x8*qr,int r32,int hi){
  const char*kb=Kslot+hi*1024+r32*16;
  #pragma unroll
  for(int d0=0;d0<4;++d0){
    const bf16x8 b0=*reinterpret_cast<const bf16x8*>(kb+d0*2048);
    const bf16x8 b1=*reinterpret_cast<const bf16x8*>(kb+d0*2048+512);
    p0=__builtin_amdgcn_mfma_f32_32x32x16_bf16(b0,qr[d0],p0,0,0,0);p1=__builtin_amdgcn_mfma_f32_32x32x16_bf16(b1,qr[d0],p1,0,0,0);}
}
typedef __attribute__((address_space(3))) const char* lds_cptr;
typedef float f32x4_t __attribute__((ext_vector_type(4)));
typedef short v4i16_t __attribute__((ext_vector_type(4)));
__device__ __forceinline__ void kload8(bf16x8*kf,lds_cptr kp){
  kf[0]=*(const __attribute__((address_space(3))) bf16x8*)(kp);      kf[1]=*(const __attribute__((address_space(3))) bf16x8*)(kp+512);
  kf[2]=*(const __attribute__((address_space(3))) bf16x8*)(kp+2048); kf[3]=*(const __attribute__((address_space(3))) bf16x8*)(kp+2560);
  kf[4]=*(const __attribute__((address_space(3))) bf16x8*)(kp+4096); kf[5]=*(const __attribute__((address_space(3))) bf16x8*)(kp+4608);
  kf[6]=*(const __attribute__((address_space(3))) bf16x8*)(kp+6144); kf[7]=*(const __attribute__((address_space(3))) bf16x8*)(kp+6656);
}
__device__ __forceinline__ void kload2(bf16x8*kf,lds_cptr kp,int j){ kf[2*j]=*(const __attribute__((address_space(3))) bf16x8*)(kp+j*2048); kf[2*j+1]=*(const __attribute__((address_space(3))) bf16x8*)(kp+j*2048+512); }
__device__ __forceinline__ s16x4 vtr(lds_cptr p){ return __builtin_bit_cast(s16x4,__builtin_amdgcn_ds_read_tr16_b64_v4i16((__attribute__((address_space(3))) v4i16_t*)p)); }
__device__ __forceinline__ float rowmax(const f32x16&p0,const f32x16&p1){
  float a=max3f(p0[0],p0[1],p1[0]),b=max3f(p0[2],p0[3],p1[1]);a=max3f(a,p1[2],p1[3]);
  #pragma unroll
  for(int r=4;r<16;r+=4){a=max3f(a,p0[r],p0[r+1]);b=max3f(b,p0[r+2],p0[r+3]);a=max3f(a,p1[r],p1[r+1]);b=max3f(b,p1[r+2],p1[r+3]);}
  const float m=max2f(a,b);
  auto rr=__builtin_amdgcn_permlane32_swap(__float_as_uint(m),__float_as_uint(m),false,false);
  return max2f(__uint_as_float(rr[0]),__uint_as_float(rr[1]));
}
__device__ __forceinline__ void pv(f32x16*o,int vb,bf16x8 pa0,bf16x8 pa1,bf16x8 pa2,bf16x8 pa3){
  #pragma unroll
  for(int d0=0;d0<2;++d0){s16x4 lo[4],hi[4];
    #pragma unroll
    for(int ks=0;ks<4;++ks){
      asm volatile("ds_read_b64_tr_b16 %0,%1 offset:%c2":"=&v"(lo[ks]):"v"(vb),"i"(d0*4096+ks*1024):"memory");
      asm volatile("ds_read_b64_tr_b16 %0,%1 offset:%c2":"=&v"(hi[ks]):"v"(vb),"i"(d0*4096+ks*1024+512):"memory");}
    asm volatile("s_waitcnt lgkmcnt(0)":::"memory");SBAR();
    #define PK(k) (bf16x8){lo[k][0],lo[k][1],lo[k][2],lo[k][3],hi[k][0],hi[k][1],hi[k][2],hi[k][3]}
    o[d0]=__builtin_amdgcn_mfma_f32_32x32x16_bf16(pa0,PK(0),o[d0],0,0,0);
    o[d0]=__builtin_amdgcn_mfma_f32_32x32x16_bf16(pa1,PK(1),o[d0],0,0,0);
    o[d0]=__builtin_amdgcn_mfma_f32_32x32x16_bf16(pa2,PK(2),o[d0],0,0,0);
    o[d0]=__builtin_amdgcn_mfma_f32_32x32x16_bf16(pa3,PK(3),o[d0],0,0,0);
    #undef PK
  }
}

#ifndef ATTN_STORE16
#define ATTN_STORE16(p,v) (*(u32x4*)(p)=(v))
#endif
template<int THRL> __device__ __forceinline__ void attn_unit(int b,int h,int qb,const bf16*Q,const bf16*__restrict__ K,const bf16*__restrict__ V,bf16*O,const float*__restrict__ FL,char*shm,const int wid){
  const int lane=pg8::lane_id_opaque(),tid=wid*64+lane,r32=lane&31,hi=lane>>5;
  const long rowbase=(long)b*SEQ; const int q0=qb*QB;
  int t0=0;
  {
    typedef __attribute__((address_space(3))) float lfl;
    lfl*cl=(lfl*)((lds_cptr)shm+LDS_CB); lfl*wt=(lfl*)((lds_cptr)shm+LDS_CBW);
    const int nk=q0+QB; float v[8];
    #pragma unroll
    for(int q=0;q<8;++q){const int s=8*tid+q; v[q]=(s<nk)?FL[(rowbase+s)*8+h]:0.f;}
    #pragma unroll
    for(int q=1;q<8;++q)v[q]+=v[q-1];
    const float tot=v[7]; float x=tot;
    #pragma unroll
    for(int off=1;off<64;off<<=1){const float t=__int_as_float(__builtin_amdgcn_ds_bpermute((lane-off)<<2,__float_as_int(x))); if(lane>=off)x+=t;}
    if(lane==63)wt[wid]=x;
    __syncthreads();
    float woff=0.f;
    #pragma unroll
    for(int w=0;w<NW;++w){const float tw=wt[w]; if(w<wid)woff+=tw;}
    const float ex=x-tot+woff;
    #pragma unroll
    for(int q=0;q<8;++q)cl[8*tid+q]=v[q]+ex;
    __syncthreads();
    { const int NTf=nk/KVBLK; const float cq0=cl[q0]; const float ck=(lane<NTf)?cl[64*lane+63]:0.f; const bool sk=(lane<NTf)&&(cq0-ck<-48.f);
      int ts=(int)__popcll(__ballot(sk))&~1; if(ts>NTf-4)ts=NTf-4; t0=__builtin_amdgcn_readfirstlane(ts); }
  }
  typedef __attribute__((address_space(3))) const f32x4_t* lf4p; const lf4p clq=(lf4p)((lds_cptr)shm+LDS_CB)+hi+16*t0;
  #define BIASLD(C0,C1,t) do{ const lf4p cp_=clq+16*(t); _Pragma("unroll") for(int i_=0;i_<4;++i_){ const f32x4_t a_=cp_[2*i_], b_=cp_[2*i_+8]; \
      C0[4*i_]=a_[0];C0[4*i_+1]=a_[1];C0[4*i_+2]=a_[2];C0[4*i_+3]=a_[3]; C1[4*i_]=b_[0];C1[4*i_+1]=b_[1];C1[4*i_+2]=b_[2];C1[4*i_+3]=b_[3]; } }while(0)
  #define BIASFIX(C0,C1) do{ _Pragma("unroll") for(int r_=0;r_<16;++r_){C0[r_]=nmh-C0[r_];C1[r_]=nmh-C1[r_];} }while(0)
  const bf16*Qw=Q+(rowbase+q0+wid*QBLK)*DM+h*D;
  const bf16*Kh=K+(rowbase+(long)t0*KVBLK)*DM+h*D,*Vh=V+(rowbase+(long)t0*KVBLK)*DM+h*D;
  const unsigned lds0=(unsigned)(uintptr_t)shm;
  float*wsf=(float*)(shm+LDS_WS)+wid*64;
  const bf16*ksrc=Kh+(long)lane*DM+wid*8;
  const bf16*vsrc=Vh+(long)(16*(wid&3)+(lane>>2))*DM+(wid>>2)*32+(lane&3)*8;
  const unsigned kdst=lds0+LDS_K+wid*1024, vdst=lds0+LDS_V+wid*1024;
  #define DMA_K(t,slot) glds16(ksrc+(long)(t)*KVBLK*DM,(unsigned)__builtin_amdgcn_readfirstlane(kdst+(slot)))
  #define DMA_V(t,slot) glds16(vsrc+(long)(t)*KVBLK*DM,(unsigned)__builtin_amdgcn_readfirstlane(vdst+(slot)))
  const int vb0=(int)(lds0+LDS_V)+((lane>>4)&1)*32+(lane&3)*8+(4*hi+((lane&15)>>2))*64;
  const char*Kbase=shm+LDS_K; bf16x8 kf[8];
  const lds_cptr shm3=(lds_cptr)shm; const lds_cptr kp0=shm3+LDS_K+hi*1024+r32*16; const lds_cptr vp0=shm3+LDS_V+((lane>>4)&1)*32+(lane&3)*8+(4*hi+((lane&15)>>2))*64;
  const int NT=(q0+QB)/KVBLK-t0;
  DMA_K(0,0);DMA_V(0,0);DMA_K(1,SLOTB);
  bf16x8 qr[4];
  #pragma unroll
  for(int d0=0;d0<4;++d0)qr[d0]=*reinterpret_cast<const bf16x8*>(&Qw[(long)r32*DM+d0*16+hi*8]);
  float mhat=0.f,l_reg=0.f,nmh=0.f;f32x16 o[2];o[0]=f32x16{};o[1]=f32x16{};
  const int qrel=wid*QBLK+r32;
  #define CMASK(P0,P1,t) do{int jb_=(t)-(NT-4); if(jb_>=0)cmask(P0,P1,jb_,qrel,hi);}while(0)
  bool resc=false;
  #define START(P0,P1) do{ const float rm=rowmax(P0,P1); resc=false; \
    { const float dl=rm; mhat=fadd_s(mhat,dl); \
      _Pragma("unroll") for(int r=0;r<16;++r){P0[r]=fsub_s(P0[r],dl);P1[r]=fsub_s(P1[r],dl);} \
      nmh=-mhat; } \
    _Pragma("unroll") for(int r=0;r<16;++r)P0[r]=__builtin_amdgcn_exp2f(P0[r]); }while(0)
  #define RESC() do{ if(resc){ asm volatile("s_waitcnt lgkmcnt(0)":::"memory"); \
      _Pragma("unroll") for(int d_=0;d_<2;++d_) _Pragma("unroll") for(int r=0;r<16;++r)o[d_][r]*=wsf[crow(r,hi)]; } }while(0)
  f32x16 pA0,pA1,pB0,pB1;
  BIASLD(pA0,pA1,0); BIASFIX(pA0,pA1);
  int sl_prev=0,sl_cur=0,sl_next=SLOTB;
  #define ROT() do{sl_prev=sl_cur;sl_cur=sl_next;sl_next=(sl_next==(NSLOT-1)*SLOTB)?0:sl_next+SLOTB;}while(0)
  DMA_K(2,2*SLOTB);
  WAIT_BAR(3);
  qkt(pA0,pA1,Kbase,qr,r32,hi);asm volatile("s_nop 15\n\ts_nop 7":"+v"(pA0),"+v"(pA1));CMASK(pA0,pA1,0);
  START(pA0,pA1);
  _Pragma("unroll") for(int r=0;r<16;++r)pA1[r]=__builtin_amdgcn_exp2f(pA1[r]);
  WAIT_BAR(0);
  DMA_K(3,0);DMA_V(1,SLOTB);
  ROT();
  kload8(kf,kp0+sl_cur);
  BIASLD(pB0,pB1,1);
  WAIT_BAR(2);
  s16x4 vlo[8],vhi[8]; u32x4 pw0,pw1,pw2,pw3;
  #define PKW(P,B) cvtpk_s(P[B],P[B+1])
  #define PAF(k) __builtin_bit_cast(bf16x8,pw##k)
  #define VFR(i) (bf16x8){vlo[i][0],vlo[i][1],vlo[i][2],vlo[i][3],vhi[i][0],vhi[i][1],vhi[i][2],vhi[i][3]}
  #define PIN(x) asm volatile("":"+v"(x))
  #define MX3(a,b,c) __builtin_fmaxf(__builtin_fmaxf((a),(b)),(c))
  #define GAPA(MF,A0,A1,A2,A3,W0,W1,PW) do{ MF; sacc+=A0; sacc+=A1; sacc+=A2; sacc+=A3; PIN(sacc); W0; W1; PIN(PW); SBAR(); }while(0)
  #define EX(v) __builtin_amdgcn_exp2f(v)
  #define GAPB(MF,X,B) do{ MF; X[B]=EX(X[B]); X[B+1]=EX(X[B+1]); X[B+2]=EX(X[B+2]); X[B+3]=EX(X[B+3]); PIN(X); SBAR(); }while(0)
  #define VRD(i) do{ vlo[i]=vtr(vp_+(((i)>>2)*4096+((i)&3)*1024)); vhi[i]=vtr(vp_+(((i)>>2)*4096+((i)&3)*1024+512)); }while(0)
  #define KRD(G,j) do{ if(G){ kload2(kf,kp0+sl_next,j); SBAR(); } }while(0)
  #define STEP(C0,C1,P0,P1,t,GK,GV,GL) do{ SBAR(); BIASFIX(C0,C1); SBAR(); \
    const lds_cptr vp_=vp0+sl_prev; \
    VRD(0); SBAR(); float sacc=(P0[0]+P0[1]); \
    GAPA(C0=__builtin_amdgcn_mfma_f32_32x32x16_bf16(kf[0],qr[0],C0,0,0,0), P0[2],P0[3],P0[4],P0[5],     pw0[0]=PKW(P0,0), pw0[1]=PKW(P0,2), pw0); \
    VRD(4); SBAR(); GAPA(C1=__builtin_amdgcn_mfma_f32_32x32x16_bf16(kf[1],qr[0],C1,0,0,0), P0[6],P0[7],P0[8],P0[9],     pw0[2]=PKW(P0,4), pw0[3]=PKW(P0,6), pw0); \
    VRD(1); SBAR(); GAPA(C0=__builtin_amdgcn_mfma_f32_32x32x16_bf16(kf[2],qr[1],C0,0,0,0),   P0[10],P0[11],P0[12],P0[13], pw1[0]=PKW(P0,8), pw1[1]=PKW(P0,10), pw1); \
    VRD(5); SBAR(); GAPA(C1=__builtin_amdgcn_mfma_f32_32x32x16_bf16(kf[3],qr[1],C1,0,0,0),   P0[14],P0[15],P1[0],P1[1],   pw1[2]=PKW(P0,12),pw1[3]=PKW(P0,14), pw1); \
    VRD(2); SBAR(); GAPA(C0=__builtin_amdgcn_mfma_f32_32x32x16_bf16(kf[4],qr[2],C0,0,0,0),   P1[2],P1[3],P1[4],P1[5],     pw2[0]=PKW(P1,0), pw2[1]=PKW(P1,2), pw2); \
    VRD(6); SBAR(); GAPA(C1=__builtin_amdgcn_mfma_f32_32x32x16_bf16(kf[5],qr[2],C1,0,0,0),   P1[6],P1[7],P1[8],P1[9],     pw2[2]=PKW(P1,4), pw2[3]=PKW(P1,6), pw2); \
    VRD(3); SBAR(); GAPA(C0=__builtin_amdgcn_mfma_f32_32x32x16_bf16(kf[6],qr[3],C0,0,0,0),   P1[10],P1[11],P1[12],P1[13], pw3[0]=PKW(P1,8), pw3[1]=PKW(P1,10), pw3); \
    VRD(7); SBAR(); GAPA(C1=__builtin_amdgcn_mfma_f32_32x32x16_bf16(kf[7],qr[3],C1,0,0,0),   P1[14],P1[15],0.f,0.f,       pw3[2]=PKW(P1,12),pw3[3]=PKW(P1,14), pw3); \
    l_reg+=sacc; \
    if(GK){DMA_K((t)+3,sl_cur);} if(GV){DMA_V((t)+1,sl_next);} \
    CMASK(C0,C1,t); \
    { float a=MX3(C0[0],C0[1],C1[0]),b=MX3(C0[2],C0[3],C1[1]); a=MX3(a,C1[2],C1[3]); \
      _Pragma("unroll") for(int r=4;r<16;r+=4){a=MX3(a,C0[r],C0[r+1]);b=MX3(b,C0[r+2],C0[r+3]);a=MX3(a,C1[r],C1[r+1]);b=MX3(b,C1[r+2],C1[r+3]);} \
      float rm=__builtin_fmaxf(a,b); { auto rr=__builtin_amdgcn_permlane32_swap(__float_as_uint(rm),__float_as_uint(rm),false,false); rm=__builtin_fmaxf(__uint_as_float(rr[0]),__uint_as_float(rr[1])); } \
      resc=false; \
      if(__builtin_expect(__any(rm>(float)THRL),0)){ const float dl=__builtin_fmaxf(rm,0.f); mhat+=dl; \
        _Pragma("unroll") for(int r=0;r<16;++r){C0[r]-=dl;C1[r]-=dl;} \
        nmh=-mhat; \
        const float f=__builtin_amdgcn_exp2f(-dl); l_reg*=f; if(hi==0)wsf[r32]=f; resc=true; } } \
    SBAR(); \
    GAPB(o[0]=__builtin_amdgcn_mfma_f32_32x32x16_bf16(PAF(0),VFR(0),o[0],0,0,0), C0,0); \
    GAPB(o[1]=__builtin_amdgcn_mfma_f32_32x32x16_bf16(PAF(0),VFR(4),o[1],0,0,0), C0,4); \
    KRD(GL,0); GAPB(o[0]=__builtin_amdgcn_mfma_f32_32x32x16_bf16(PAF(1),VFR(1),o[0],0,0,0), C0,8); \
    KRD(GL,1); GAPB(o[1]=__builtin_amdgcn_mfma_f32_32x32x16_bf16(PAF(1),VFR(5),o[1],0,0,0), C0,12); \
    KRD(GL,2); GAPB(o[0]=__builtin_amdgcn_mfma_f32_32x32x16_bf16(PAF(2),VFR(2),o[0],0,0,0), C1,0); \
    KRD(GL,3); GAPB(o[1]=__builtin_amdgcn_mfma_f32_32x32x16_bf16(PAF(2),VFR(6),o[1],0,0,0), C1,4); \
    GAPB(o[0]=__builtin_amdgcn_mfma_f32_32x32x16_bf16(PAF(3),VFR(3),o[0],0,0,0), C1,8); \
    GAPB(o[1]=__builtin_amdgcn_mfma_f32_32x32x16_bf16(PAF(3),VFR(7),o[1],0,0,0), C1,12); \
    if(GL){BIASLD(P0,P1,(t)+1);} \
    }while(0)
  int t=1;
  #undef CMASK
  #define CMASK(P0,P1,t) do{}while(0)
  for(;t+5<NT;t+=2){
    STEP(pB0,pB1,pA0,pA1,t,true,true,true);     WAIT_BAR(2); RESC(); ROT();
    STEP(pA0,pA1,pB0,pB1,t+1,true,true,true);   WAIT_BAR(2); RESC(); ROT();
  }
  #undef CMASK
  #define CMASK(P0,P1,t) do{int jb_=(t)-(NT-4); if(jb_>=0)cmask(P0,P1,jb_,qrel,hi);}while(0)
  #define ENDW(tt) do{ if((tt)+3<NT){WAIT_BAR(2);} else if((tt)+2<NT){WAIT_BAR(1);} else {WAIT_BAR(0);} }while(0)
  for(;t+1<NT;t+=2){
    STEP(pB0,pB1,pA0,pA1,t,(t+3<NT),(t+1<NT),(t+1<NT));       ENDW(t);   RESC(); ROT();
    STEP(pA0,pA1,pB0,pB1,t+1,(t+4<NT),(t+2<NT),(t+2<NT));     ENDW(t+1); RESC(); ROT();
  }
  STEP(pB0,pB1,pA0,pA1,NT-1,false,false,false); RESC();
  { float sacc=pB0[0]+pB0[1]; _Pragma("unroll") for(int r=2;r<16;++r)sacc+=pB0[r]; _Pragma("unroll") for(int r=0;r<16;++r)sacc+=pB1[r]; l_reg+=sacc;
    pw0=(u32x4){PKW(pB0,0),PKW(pB0,2),PKW(pB0,4),PKW(pB0,6)};pw1=(u32x4){PKW(pB0,8),PKW(pB0,10),PKW(pB0,12),PKW(pB0,14)};pw2=(u32x4){PKW(pB1,0),PKW(pB1,2),PKW(pB1,4),PKW(pB1,6)};pw3=(u32x4){PKW(pB1,8),PKW(pB1,10),PKW(pB1,12),PKW(pB1,14)};
    SBAR(); pv(o,vb0+sl_cur,PAF(0),PAF(1),PAF(2),PAF(3)); }
  #undef PKW
  #undef PAF
  #undef VFR
  #undef PIN
  #undef MX3
  #undef GAPA
  #undef GAPB
  #undef EX
  #undef VRD
  #undef KRD
  #undef STEP
  #undef ENDW
  {auto rr=__builtin_amdgcn_permlane32_swap(__float_as_uint(l_reg),__float_as_uint(l_reg),false,false);l_reg=__uint_as_float(rr[0])+__uint_as_float(rr[1]);}
  if(hi==0)wsf[32+r32]=l_reg;asm volatile("s_waitcnt lgkmcnt(0)":::"memory");
  float rli[16];
  #pragma unroll
  for(int r=0;r<16;++r)rli[r]=__builtin_amdgcn_rcpf(wsf[32+crow(r,hi)]);
  bf16*Ow=O+(rowbase+q0+wid*QBLK)*DM+h*D;
  { bf16*stg=(bf16*)(shm+LDS_OST)+wid*2048;
    #pragma unroll
    for(int r=0;r<16;++r){const int orow=crow(r,hi);
      #pragma unroll
      for(int d0=0;d0<2;++d0)stg[orow*64+d0*32+r32]=__float2bfloat16(o[d0][r]*rli[r]);}
    asm volatile("s_waitcnt lgkmcnt(0)":::"memory");
    #pragma unroll
    for(int i=0;i<4;++i){const int row=i*8+(lane>>3),ch=lane&7; const u32x4 v=*(const u32x4*)(stg+row*64+ch*8); ATTN_STORE16(Ow+(long)row*DM+ch*8,v);} }
  asm volatile("s_waitcnt lgkmcnt(0)\n\ts_barrier":::"memory");
  #undef BIASLD
  #undef BIASFIX
  #undef DMA_K
  #undef DMA_V
  #undef CMASK
  #undef START
  #undef RESC
  #undef ROT
}
constexpr int ATTN_LDS_BYTES=LDS_BYTES;
struct AttnTensors { const bf16* Q; const bf16* K; const bf16* V; bf16* O; const float* FL; };
struct AttnUnit { int bh; int qb; };
struct StaticOrder {
  int vcu, G;
  __device__ __forceinline__ explicit StaticOrder(int grid,int block):vcu((grid%8==0)?(block%8)*(grid/8)+block/8:block),G(grid){}
  __device__ __forceinline__ bool next(int i,AttnUnit&u)const{ const int idx=i*G+vcu; if(idx>=1024)return false; const int v=idx&255, r=idx>>8, s=2*(v&3); u.bh=(v>>5)*8+((((v>>2)&7)+2*r)&7); u.qb=(r==0)?s:(r==1)?15-s:(r==2)?s+1:14-s; return true; }
  __device__ __forceinline__ void a_ready(const AttnUnit&)const{}
  __device__ __forceinline__ void done(const AttnUnit&)const{}
};
template<class Sched,int THRL=8> __device__ __forceinline__ void attn_phase(char*lds,const AttnTensors&T,const Sched&S,const int wid){
  AttnUnit u;
  for(int i=0;S.next(i,u);++i){ S.a_ready(u); attn_unit<THRL>(u.bh/NHEAD,u.bh%NHEAD,u.qb,T.Q,T.K,T.V,T.O,T.FL,lds,wid); S.done(u); }
}
#undef SBAR
#undef WAIT_BAR
}

#include <hip/hip_cooperative_groups.h>
namespace cg = cooperative_groups;

#define GAS __attribute__((address_space(1)))
#define LAS __attribute__((address_space(3)))
typedef unsigned short bf16;
typedef unsigned v4u __attribute__((ext_vector_type(4)));
typedef unsigned v2u __attribute__((ext_vector_type(2)));
typedef float f32x4 __attribute__((ext_vector_type(4)));
typedef short bf16x8 __attribute__((ext_vector_type(8)));
#define RLX_AGENT __ATOMIC_RELAXED, __HIP_MEMORY_SCOPE_AGENT
#define LDS_WAIT() asm volatile("s_waitcnt lgkmcnt(0)" ::: "memory")

constexpr int NWAVES = 8, NTHR = 512;
constexpr int BATCH = 8, SEQ = 4096, D = 1024, M = BATCH * SEQ, DEPTH = 4;
constexpr int INC = 6664, NPROJ = 6656, DFF = 2816, DFE = 3584, NEXP = 8;
constexpr float DN_ALPHA = 1.6817928305074292f, LN_EPS = 1e-5f, RMS_EPS = 1e-6f, LOG2E = 1.4426950408889634f;

constexpr size_t MiB = 1u << 20;
constexpr size_t WS_CTL = 0, WS_COS = 1 * MiB, WS_SIN = 5 * MiB, WS_FLOG = 9 * MiB, WS_RE = 10 * MiB, WS_RR = 10 * MiB + 256 * 1024, WS_RW = 10 * MiB + 512 * 1024, WS_RROW = 10 * MiB + 768 * 1024;
constexpr size_t WS_WIN = 12 * MiB, WS_WBF = 25 * MiB, WS_WBR = 26 * MiB, WS_WOUT = 28 * MiB;
constexpr size_t WS_WFF = 32 * MiB;
constexpr size_t WS_XB = 210 * MiB, WS_HB = 274 * MiB, WS_ACT = 338 * MiB, WS_END = 954 * MiB;
constexpr size_t A_QA = 0, A_KA = 32 * MiB, A_VA = 64 * MiB, A_QB = 96 * MiB, A_KB = 128 * MiB, A_VB = 160 * MiB, A_GB = 224 * MiB, A_GATE = 288 * MiB, A_OB = 416 * MiB, A_T1 = 480 * MiB, A_PT = 544 * MiB;
constexpr size_t A_H = 0;
constexpr int XS_ROWS = 2 * M + 2048;
constexpr size_t A_XB8 = 544 * MiB;
constexpr size_t A_YSP = 600 * MiB;
constexpr size_t A_XS = 0, A_HS = 136 * MiB;
static_assert(A_HS + (size_t)XS_ROWS * DFE * 2 <= A_YSP && A_PT + 32 * MiB <= A_YSP && A_YSP + 16 * MiB <= WS_END - WS_ACT, "ws map");

__device__ __forceinline__ unsigned f2bf(float f) { unsigned u = __builtin_bit_cast(unsigned, f); return (u + 0x7fffu + ((u >> 16) & 1u)) >> 16; }
__device__ __forceinline__ unsigned pk2(float lo, float hi) { return f2bf(lo) | (f2bf(hi) << 16); }
__device__ __forceinline__ float bflo(unsigned w) { return __uint_as_float(w << 16); }
__device__ __forceinline__ float bfhi(unsigned w) { return __uint_as_float(w & 0xffff0000u); }
__device__ __forceinline__ float bf2f(bf16 b) { return __uint_as_float((unsigned)b << 16); }
__device__ __forceinline__ float fsigmoid(float x) { return __builtin_amdgcn_rcpf(1.f + __expf(-x)); }
__device__ __forceinline__ float shx(float v, int m, int lane) { return __int_as_float(__builtin_amdgcn_ds_bpermute((lane ^ m) << 2, __float_as_int(v))); }
__device__ __forceinline__ float shi(float v, int src) { return __int_as_float(__builtin_amdgcn_ds_bpermute(src << 2, __float_as_int(v))); }
__device__ __forceinline__ float wave_sum(float v, int lane) {
#pragma unroll
    for (int o = 1; o < 64; o <<= 1) v += shx(v, o, lane);
    return v;
}

__device__ __forceinline__ unsigned pk4_fp8(float a, float b, float c, float d) { int w = __builtin_amdgcn_cvt_pk_fp8_f32(a, b, 0, false); w = __builtin_amdgcn_cvt_pk_fp8_f32(c, d, w, true); return (unsigned)w; }
constexpr float F8_SW1 = 32.f, F8_SW2 = 64.f, F8_SH = 16.f;
struct Frame {
    LAS unsigned char* lds;
    unsigned* ctl;
    int tid, lane, wave, vcu, G, cofs, trow;
    unsigned char* ws;
};

namespace epi {
using pg8::f32x4; using pg8::Unit; using pg8::HALF; using pg8::BM; using pg8::cvt_pk_bf16;
typedef unsigned u32x4 __attribute__((ext_vector_type(4)));
typedef unsigned u32x2 __attribute__((ext_vector_type(2)));
__device__ __forceinline__ u32x4 pack8(f32x4 a, f32x4 b) { u32x4 w; w.x = cvt_pk_bf16(a[0], a[1]); w.y = cvt_pk_bf16(a[2], a[3]); w.z = cvt_pk_bf16(b[0], b[1]); w.w = cvt_pk_bf16(b[2], b[3]); return w; }
__device__ __forceinline__ u32x2 pack4(f32x4 a) { u32x2 w; w.x = cvt_pk_bf16(a[0], a[1]); w.y = cvt_pk_bf16(a[2], a[3]); return w; }
__device__ __forceinline__ f32x4 unlo(u32x4 w) { return (f32x4){bflo(w.x), bfhi(w.x), bflo(w.y), bfhi(w.y)}; }
__device__ __forceinline__ f32x4 unhi(u32x4 w) { return (f32x4){bflo(w.z), bfhi(w.z), bflo(w.w), bfhi(w.w)}; }
__device__ __forceinline__ f32x4 silu4(f32x4 v) { return (f32x4){v[0] * fsigmoid(v[0]), v[1] * fsigmoid(v[1]), v[2] * fsigmoid(v[2]), v[3] * fsigmoid(v[3])}; }
__device__ __forceinline__ f32x4 sigm4(f32x4 v) { return (f32x4){fsigmoid(v[0]), fsigmoid(v[1]), fsigmoid(v[2]), fsigmoid(v[3])}; }

struct EpiInProj {
    static constexpr bool PERM = false, AFTER_DRAIN = false;
    unsigned char* act; const float* cosT; const float* sinT;
    template <int ACT> __device__ __forceinline__ void plain(const f32x4 (&acc)[2][2][4][2], bf16* base, int ldo, int colt, float sc, int row0, int wc, int fq) const {
#pragma unroll
        for (int ai = 0; ai < 2; ++ai)
#pragma unroll
            for (int m = 0; m < 4; ++m) { bf16* rowp = base + (size_t)(row0 + ai * HALF + m * 16) * ldo + colt + wc * 32 + 8 * fq;
#pragma unroll
                for (int bj = 0; bj < 2; ++bj) { f32x4 v0 = acc[ai][bj][m][0], v1 = acc[ai][bj][m][1]; asm volatile("" : "+v"(v0), "+v"(v1));
                    if (ACT == 0) { v0 = v0 * sc; v1 = v1 * sc; } else if (ACT == 1) { v0 = silu4(v0); v1 = silu4(v1); } else { v0 = sigm4(v0); v1 = sigm4(v1); }
                    *(u32x4*)(rowp + bj * HALF) = pack8(v0, v1); }
                asm volatile("" ::: "memory"); __builtin_amdgcn_sched_barrier(0); }
    }
    __device__ __forceinline__ void operator()(const f32x4 (&acc)[2][2][4][2], const Unit& u, int wr, int wc, int fr, int fq) const {
        const int pn = u.pn, row0 = u.pm * BM + wr * 64 + fr;
        if (pn < 6) { plain<0>(acc, (bf16*)(act + A_QA + (size_t)(pn >> 1) * (32 * MiB)), 512, (pn & 1) * 256, pn < 2 ? attn_body::C2 : 1.f, row0, wc, fq); }
        else if (pn < 10) {
            bf16* base = (bf16*)(act + (pn < 8 ? A_QB : A_KB)); const float sc = pn < 8 ? 1.f : 0.125f; const int colt = (pn & 1) * 256, d0 = (wc & 1) * 16 + 4 * fq;
#pragma unroll
            for (int ai = 0; ai < 2; ++ai)
#pragma unroll
                for (int m = 0; m < 4; ++m) { const int row = row0 + ai * HALF + m * 16;
                    const f32x4 cs = *(const f32x4*)(cosT + (size_t)row * 32 + d0) * sc, sn = *(const f32x4*)(sinT + (size_t)row * 32 + d0) * sc;
#pragma unroll
                    for (int bj = 0; bj < 2; ++bj) { f32x4 x1 = acc[ai][bj][m][0], x2 = acc[ai][bj][m][1]; asm volatile("" : "+v"(x1), "+v"(x2));
                        bf16* p = base + (size_t)row * 512 + colt + (2 * bj + (wc >> 1)) * 64 + d0;
                        *(u32x2*)p = pack4(x1 * cs - x2 * sn); *(u32x2*)(p + 32) = pack4(x1 * sn + x2 * cs); }
                    asm volatile("" ::: "memory"); __builtin_amdgcn_sched_barrier(0); }
        }
        else if (pn < 14) plain<0>(acc, (bf16*)(act + A_VB), 1024, (pn - 10) * 256, 1.f, row0, wc, fq);
        else if (pn < 18) plain<0>(acc, (bf16*)(act + A_GB), 1024, (pn - 14) * 256, 1.f, row0, wc, fq);
        else plain<0>(acc, (bf16*)(act + A_GATE), 2048, (pn - 18) * 256, 1.f, row0, wc, fq);
    }
};
struct EpiGated {
    static constexpr bool PERM = false, AFTER_DRAIN = false;
    bf16* out; int ldo; const bf16* gate; int ldg; const bf16* add; float sc;
    __device__ __forceinline__ void operator()(const f32x4 (&acc)[2][2][4][2], const Unit& u, int wr, int wc, int fr, int fq) const {
        const int row0 = u.pm * BM + wr * 64 + fr, col0 = u.pn * BM + wc * 32 + 8 * fq;
#pragma unroll
        for (int ai = 0; ai < 2; ++ai)
#pragma unroll
            for (int m = 0; m < 4; ++m) { const size_t row = (size_t)(row0 + ai * HALF + m * 16);
#pragma unroll
                for (int bj = 0; bj < 2; ++bj) { f32x4 v0 = acc[ai][bj][m][0], v1 = acc[ai][bj][m][1]; asm volatile("" : "+v"(v0), "+v"(v1)); v0 = v0 * sc; v1 = v1 * sc; const int col = col0 + bj * HALF;
                    if (gate) { const u32x4 gv = *(const u32x4*)(gate + row * ldg + col); v0 = v0 * sigm4(unlo(gv)); v1 = v1 * sigm4(unhi(gv)); }
                    if (add) { const u32x4 av = *(const u32x4*)(add + row * ldo + col); v0 = v0 + unlo(av); v1 = v1 + unhi(av); }
                    *(u32x4*)(out + row * ldo + col) = pack8(v0, v1); }
                asm volatile("" ::: "memory"); __builtin_amdgcn_sched_barrier(0); }
    }
};
struct EpiSwiGLU {
    static constexpr bool PERM = false, AFTER_DRAIN = false;
    bf16* out; int ldo;
    __device__ __forceinline__ void operator()(const f32x4 (&acc)[2][2][4][2], const Unit& u, int wr, int wc, int fr, int fq) const {
        const int row0 = u.pm * BM + wr * 64 + fr, hid0 = u.pn * 128 + wc * 16 + 4 * fq;
#pragma unroll
        for (int ai = 0; ai < 2; ++ai)
#pragma unroll
            for (int m = 0; m < 4; ++m) { bf16* rowp = out + (size_t)(row0 + ai * HALF + m * 16) * ldo + hid0;
#pragma unroll
                for (int bj = 0; bj < 2; ++bj) { f32x4 v0 = acc[ai][bj][m][0], v1 = acc[ai][bj][m][1]; asm volatile("" : "+v"(v0), "+v"(v1)); *(u32x2*)(rowp + bj * 64) = pack4(silu4(v0) * v1); }
                asm volatile("" ::: "memory"); __builtin_amdgcn_sched_barrier(0); }
    }
};
struct EpiSwiGLU8 {
    static constexpr bool PERM = false, AFTER_DRAIN = false;
    unsigned char* out; int ldo; float si, so;
    __device__ __forceinline__ void operator()(const f32x4 (&acc)[2][2][4][2], const Unit& u, int wr, int wc, int fr, int fq) const {
        const int row0 = u.pm * BM + wr * 64 + fr, hid0 = u.pn * 128 + wc * 16 + 4 * fq;
#pragma unroll
        for (int ai = 0; ai < 2; ++ai)
#pragma unroll
            for (int m = 0; m < 4; ++m) { unsigned char* rowp = out + (size_t)(row0 + ai * HALF + m * 16) * ldo + hid0;
#pragma unroll
                for (int bj = 0; bj < 2; ++bj) { f32x4 v0 = acc[ai][bj][m][0], v1 = acc[ai][bj][m][1]; asm volatile("" : "+v"(v0), "+v"(v1));
                    const f32x4 h = silu4(v0 * si) * v1 * (si * so); *(unsigned*)(rowp + bj * 64) = pk4_fp8(h[0], h[1], h[2], h[3]); }
                asm volatile("" ::: "memory"); __builtin_amdgcn_sched_barrier(0); }
    }
};
struct MoeOrder {
    int ts[9]; int NT, G, c, lim, rev;
    __device__ __forceinline__ bool next(int i, Unit& u) const {
        const int L = i * G + c; if (L >= lim) return false;
        int rt = L / NT; const int pn = L - rt * NT; if (rev) rt = ts[8] - 1 - rt; int e = 0;
#pragma unroll
        for (int j = 1; j < 8; ++j) e += (rt >= ts[j]) ? 1 : 0;
        u.pm = rt; u.pn = pn; u.pb = e * NT + pn; return true;
    }
    __device__ __forceinline__ void a_ready(const Unit&) const {}
    __device__ __forceinline__ void done(const Unit&) const {}
};
struct TailOrder {
    int ts[9]; int L;
    __device__ __forceinline__ bool next(int i, Unit& u) const {
        if (i > 0 || L < 0) return false;
        const int rt = L >> 2, pn = L & 3; int e = 0;
#pragma unroll
        for (int j = 1; j < 8; ++j) e += (rt >= ts[j]) ? 1 : 0;
        u.pm = rt; u.pn = pn; u.pb = e * 4 + pn; return true;
    }
    __device__ __forceinline__ void a_ready(const Unit&) const {}
    __device__ __forceinline__ void done(const Unit&) const {}
};
}

enum { CM_PLAIN = 0, CM_WIN = 1, CM_GU = 2 };
template <int MODE, bool F8 = false>
__device__ __forceinline__ void conv_job(const float* A, const float* B, int K, int pitch, bf16* dst, int ngroups, int gw, int NGW, LAS float* scr, int lane, float sc8 = 1.f) {
    const int nitems = (K >> 6) * ngroups, m = lane & 7, kq = lane >> 3;
    for (int it = gw; it < nitems; it += NGW) {
        const int kb = it / ngroups, g = it - kb * ngroups, k0 = kb * 64;
        const float* src; int sb;
        if (MODE == CM_GU) { src = (m < 4 ? A : B) + g * 16 + 4 * (m & 3); sb = 16 * (m >> 2) + 4 * (m & 3); }
        else { const int r0 = g * 32;
            if (MODE == CM_WIN && r0 >= 1536 && r0 < 2560) { const int p = r0 - 1536; src = A + 1544 + (p >> 6) * 64 + ((p >> 5) & 1) * 16 + 32 * (m >> 2) + 4 * (m & 3); sb = 16 * (m >> 2) + 4 * (m & 3); }
            else { src = A + r0 + ((MODE == CM_WIN && r0 >= 2560) ? 8 : 0) + 4 * m; sb = 16 * (m & 1) + 4 * (m >> 1); } }
        src += (size_t)k0 * pitch;
        f32x4 v[8];
#pragma unroll
        for (int i = 0; i < 8; ++i) v[i] = *(const f32x4*)(src + (size_t)(kq + 8 * i) * pitch);
#pragma unroll
        for (int i = 0; i < 8; ++i) { LAS float* s = scr + (kq + 8 * i) * 33 + sb; s[0] = v[i][0]; s[1] = v[i][1]; s[2] = v[i][2]; s[3] = v[i][3]; }
        LDS_WAIT();
        const int c = lane & 7;
#pragma unroll
        for (int j = 0; j < 4; ++j) { const int n = (lane >> 3) + 8 * j; const LAS float* s = scr + (8 * c) * 33 + n;
            if (F8) { v2u o; o.x = pk4_fp8(s[0 * 33] * sc8, s[1 * 33] * sc8, s[2 * 33] * sc8, s[3 * 33] * sc8); o.y = pk4_fp8(s[4 * 33] * sc8, s[5 * 33] * sc8, s[6 * 33] * sc8, s[7 * 33] * sc8);
                *(v2u*)((unsigned char*)dst + (size_t)(g * 32 + n) * K + k0 + 8 * c) = o; }
            else { v4u o; o.x = pk2(s[0 * 33], s[1 * 33]); o.y = pk2(s[2 * 33], s[3 * 33]); o.z = pk2(s[4 * 33], s[5 * 33]); o.w = pk2(s[6 * 33], s[7 * 33]);
                *(v4u*)(dst + (size_t)(g * 32 + n) * K + k0 + 8 * c) = o; } }
        LDS_WAIT();
    }
}
__device__ __forceinline__ void conv_layer(Frame& F, const float* const* in, int l, int part) {
    LAS float* scr = (LAS float*)(F.lds + F.wave * 16384);
    const int gw = F.vcu * NWAVES + F.wave, NGW = F.G * NWAVES;
    unsigned char* ws = F.ws;
    if (part == 0) {
    conv_job<CM_WIN>(in[2] + (size_t)l * D * INC, nullptr, D, INC, (bf16*)(ws + WS_WIN), NPROJ / 32, gw, NGW, scr, F.lane);
    conv_job<CM_PLAIN>(in[5] + (size_t)l * 512 * D, nullptr, 512, D, (bf16*)(ws + WS_WBF), D / 32, gw, NGW, scr, F.lane);
    conv_job<CM_PLAIN>(in[6] + (size_t)l * D * D, nullptr, D, D, (bf16*)(ws + WS_WBR), D / 32, gw, NGW, scr, F.lane);
    conv_job<CM_PLAIN>(in[7] + (size_t)l * D * D, nullptr, D, D, (bf16*)(ws + WS_WOUT), D / 32, gw, NGW, scr, F.lane);
    return; }
    const int i = l >> 1;
    if ((l & 1) == 0) {
        conv_job<CM_GU, true>(in[10] + (size_t)i * D * DFF, in[11] + (size_t)i * D * DFF, D, DFF, (bf16*)(ws + WS_WFF), 2 * DFF / 32, gw, NGW, scr, F.lane, F8_SW1);
        conv_job<CM_PLAIN, true>(in[12] + (size_t)i * DFF * D, nullptr, DFF, D, (bf16*)(ws + WS_WFF + 12 * MiB), D / 32, gw, NGW, scr, F.lane, F8_SW2);
    } else {
        for (int e = 0; e < NEXP; ++e) {
            const size_t o = ((size_t)i * NEXP + e) * D * DFE;
            conv_job<CM_GU, true>(in[14] + o, in[15] + o, D, DFE, (bf16*)(ws + WS_WFF + (size_t)e * 7 * MiB), 2 * DFE / 32, gw, NGW, scr, F.lane, F8_SW1);
            conv_job<CM_PLAIN, true>(in[16] + o, nullptr, DFE, D, (bf16*)(ws + WS_WFF + 56 * MiB + (size_t)e * (7 * MiB / 2)), D / 32, gw, NGW, scr, F.lane, F8_SW2);
        }
    }
}

template <int MODE, int EXTRA>
__device__ __forceinline__ void row_pass(Frame& F, const float* xin, float* xout, const float* lng, const float* lnb, const float* Wx, int wpitch, const float* bfg) {
    LAS float* WL = (LAS float*)F.lds;
    LAS int* EL = (LAS int*)(F.lds + 32768);
    unsigned char* ws = F.ws;
    const int lane = F.lane, wid = F.wave;
    float alpha_ = DN_ALPHA; asm volatile("" : "+v"(alpha_));
    if (EXTRA == 1 || EXTRA == 2) { for (int idx = F.tid; idx < 8192; idx += NTHR) { const int k = idx >> 3, hh = idx & 7; WL[hh * 1024 + k] = Wx[(size_t)k * wpitch + hh]; } }
    __syncthreads();
    f32x4 gv[4], bv[4];
    if (MODE) {
#pragma unroll
        for (int j = 0; j < 4; ++j) { gv[j] = *(const f32x4*)(lng + 4 * lane + 256 * j); bv[j] = *(const f32x4*)(lnb + 4 * lane + 256 * j); }
    }
    const bf16* HB = (const bf16*)(ws + WS_HB); const bf16* YS = (const bf16*)(ws + WS_ACT + A_XS); const bf16* YSP = (const bf16*)(ws + WS_ACT + A_YSP);
    bf16* XB = (bf16*)(ws + WS_XB);
    for (int blk = blockIdx.x; blk < M / 128; blk += F.G) {
        f32x4 xr[4]; v2u ha[4]; f32x4 hx[4];
#define ROW_LOAD(rr) do { const size_t r_ = (rr); \
            _Pragma("unroll") for (int j = 0; j < 4; ++j) xr[j] = *(const f32x4*)(xin + r_ * D + 4 * lane + 256 * j); \
            if (MODE == 1) { _Pragma("unroll") for (int j = 0; j < 4; ++j) ha[j] = *(const v2u*)(HB + r_ * D + 4 * lane + 256 * j); } \
            else if (MODE == 2) { const int rr_[2] = {((const int*)(ws + WS_RROW))[2 * r_], ((const int*)(ws + WS_RROW))[2 * r_ + 1]}; \
                const float ww_[2] = {((const float*)(ws + WS_RW))[2 * r_], ((const float*)(ws + WS_RW))[2 * r_ + 1]}; \
                _Pragma("unroll") for (int j = 0; j < 4; ++j) hx[j] = (f32x4){0.f, 0.f, 0.f, 0.f}; \
                _Pragma("unroll") for (int k_ = 0; k_ < 2; ++k_) { \
                    if (rr_[k_] < F.trow) { _Pragma("unroll") for (int j = 0; j < 4; ++j) { const v2u a_ = *(const v2u*)(YS + (size_t)rr_[k_] * D + 4 * lane + 256 * j); \
                            hx[j] += (f32x4){bflo(a_.x), bfhi(a_.x), bflo(a_.y), bfhi(a_.y)} * ww_[k_]; } } \
                    else { _Pragma("unroll") for (int s_ = 0; s_ < 4; ++s_) _Pragma("unroll") for (int j = 0; j < 4; ++j) { \
                            const v2u a_ = *(const v2u*)(YSP + ((size_t)s_ * 2048 + (size_t)(rr_[k_] - F.trow)) * D + 4 * lane + 256 * j); \
                            hx[j] += (f32x4){bflo(a_.x), bfhi(a_.x), bflo(a_.y), bfhi(a_.y)} * ww_[k_]; } } } } } while (0)
        ROW_LOAD((size_t)blk * 128 + wid);
        for (int i = 0; i < 16; ++i) {
            const int lr = wid + 8 * i; const size_t row = (size_t)blk * 128 + lr;
            f32x4 v[4];
            if (MODE == 3) {
#pragma unroll
                for (int j = 0; j < 4; ++j) v[j] = xr[j] * alpha_;
            } else if (MODE == 1) {
#pragma unroll
                for (int j = 0; j < 4; ++j) v[j] = xr[j] * alpha_ + (f32x4){bflo(ha[j].x), bfhi(ha[j].x), bflo(ha[j].y), bfhi(ha[j].y)};
            } else if (MODE == 2) {
#pragma unroll
                for (int j = 0; j < 4; ++j) v[j] = xr[j] * alpha_ + hx[j];
            } else {
#pragma unroll
                for (int j = 0; j < 4; ++j) v[j] = xr[j];
            }
            if (i + 1 < 16) ROW_LOAD(row + 8);
            if (MODE) {
                float s = 0.f;
#pragma unroll
                for (int j = 0; j < 4; ++j) s += (v[j][0] + v[j][1]) + (v[j][2] + v[j][3]);
                const float mean = wave_sum(s, lane) * (1.f / D); float s2 = 0.f;
#pragma unroll
                for (int j = 0; j < 4; ++j) { v[j] = v[j] - mean; s2 += (v[j][0] * v[j][0] + v[j][1] * v[j][1]) + (v[j][2] * v[j][2] + v[j][3] * v[j][3]); }
                const float rstd = 1.f / sqrtf(wave_sum(s2, lane) * (1.f / D) + LN_EPS);
#pragma unroll
                for (int j = 0; j < 4; ++j) v[j] = v[j] * rstd * gv[j] + bv[j];
            }
#pragma unroll
            for (int j = 0; j < 4; ++j) { if (MODE) *(f32x4*)(xout + row * D + 4 * lane + 256 * j) = v[j];
                if (!(EXTRA == 3 || EXTRA == 2 || (MODE == 2 && EXTRA == 0))) { v2u o; o.x = pk2(v[j][0], v[j][1]); o.y = pk2(v[j][2], v[j][3]); *(v2u*)(XB + row * D + 4 * lane + 256 * j) = o; }
                if (EXTRA == 3 || EXTRA == 2) *(unsigned*)(ws + WS_ACT + A_XB8 + row * D + 4 * lane + 256 * j) = pk4_fp8(v[j][0], v[j][1], v[j][2], v[j][3]); }
            if (EXTRA == 1 || EXTRA == 2) {
                float d8[8];
#pragma unroll
                for (int hh = 0; hh < 8; ++hh) { float a = 0.f;
#pragma unroll
                    for (int j = 0; j < 4; ++j) { const f32x4 w = *(const LAS f32x4*)(WL + hh * 1024 + 4 * lane + 256 * j); a += (v[j][0] * w[0] + v[j][1] * w[1]) + (v[j][2] * w[2] + v[j][3] * w[3]); }
                    d8[hh] = a; }
                float d4[4], d2[2], d1;
                { const bool up = lane & 1;
#pragma unroll
                  for (int q = 0; q < 4; ++q) { const float snd = up ? d8[q] : d8[q + 4]; const float r = shx(snd, 1, lane); d4[q] = (up ? d8[q + 4] : d8[q]) + r; } }
                { const bool up = lane & 2;
#pragma unroll
                  for (int q = 0; q < 2; ++q) { const float snd = up ? d4[q] : d4[q + 2]; const float r = shx(snd, 2, lane); d2[q] = (up ? d4[q + 2] : d4[q]) + r; } }
                { const bool up = lane & 4; const float snd = up ? d2[0] : d2[1]; const float r = shx(snd, 4, lane); d1 = (up ? d2[1] : d2[0]) + r; }
                d1 += shx(d1, 8, lane); d1 += shx(d1, 16, lane); d1 += shx(d1, 32, lane);
                const int myh = ((lane & 1) << 2) | (lane & 2) | ((lane >> 2) & 1);
                if (EXTRA == 1) {
                    const float z = d1 + bfg[myh];
                    const float lf = fminf(z, 0.f) - __logf(1.f + __expf(-fabsf(z)));
                    if (lane < 8) ((float*)(ws + WS_FLOG))[row * 8 + myh] = lf * LOG2E;
                } else {
                    float lg[8];
#pragma unroll
                    for (int e = 0; e < 8; ++e) lg[e] = shi(d1, ((e & 4) >> 2) | (e & 2) | ((e & 1) << 2));
                    int e0 = 0; float v0 = lg[0];
#pragma unroll
                    for (int e = 1; e < 8; ++e) if (lg[e] > v0) { v0 = lg[e]; e0 = e; }
                    int e1 = -1; float v1 = -INFINITY;
#pragma unroll
                    for (int e = 0; e < 8; ++e) if (e != e0 && lg[e] > v1) { v1 = lg[e]; e1 = e; }
                    const float w1 = 1.f / (1.f + expf(v0 - v1)), w0 = 1.f - w1;
                    if (lane == 0) { EL[2 * lr] = e0; EL[2 * lr + 1] = e1;
                        ((int*)(ws + WS_RE))[2 * row] = e0; ((int*)(ws + WS_RE))[2 * row + 1] = e1;
                        ((float*)(ws + WS_RW))[2 * row] = w0; ((float*)(ws + WS_RW))[2 * row + 1] = w1; }
                }
            }
        }
        if (EXTRA == 2) {
            __syncthreads();
            int msk[4]; int cnt = 0; unsigned long long bm[4];
#pragma unroll
            for (int q = 0; q < 4; ++q) { msk[q] = (EL[q * 64 + lane] == wid); bm[q] = __ballot(msk[q]); cnt += __popcll(bm[q]); }
            int base = 0;
            if (lane == 0) base = (int)__hip_atomic_fetch_add(F.ctl + F.cofs + wid, (unsigned)cnt, RLX_AGENT);
            base = __builtin_amdgcn_readfirstlane(base);
            int run = base;
#pragma unroll
            for (int q = 0; q < 4; ++q) { const int entry = q * 64 + lane; const int rk = run + __popcll(bm[q] & ((1ull << lane) - 1ull));
                if (msk[q]) ((int*)(ws + WS_RR))[(size_t)blk * 256 + entry] = rk;
                run += __popcll(bm[q]); }
            __syncthreads();
        }
    }
#undef ROW_LOAD
    __syncthreads();
}

__device__ __forceinline__ void moe_starts(Frame& F, int (&rs)[9]) {
    int a = 0;
#pragma unroll
    for (int e = 0; e < 8; ++e) { rs[e] = a; const int c = __builtin_amdgcn_readfirstlane((int)__hip_atomic_load(F.ctl + F.cofs + e, RLX_AGENT)); a += (c + 255) & ~255; }
    rs[8] = a;
}
__device__ __forceinline__ void moe_gather(Frame& F) {
    int rs[9]; moe_starts(F, rs);
    unsigned char* ws = F.ws;
    const int gw = F.vcu * NWAVES + F.wave, NGW = F.G * NWAVES;
    const v4u* XB8 = (const v4u*)(ws + WS_ACT + A_XB8); v4u* XS = (v4u*)(ws + WS_ACT + A_XS);
    for (int t = gw; t < M; t += NGW) {
        const v4u a = XB8[(size_t)t * 64 + F.lane];
#pragma unroll
        for (int k = 0; k < 2; ++k) {
            const int e = ((const int*)(ws + WS_RE))[2 * t + k], rel = ((const int*)(ws + WS_RR))[2 * t + k];
            int st = 0;
#pragma unroll
            for (int j = 0; j < 8; ++j) st = (e == j) ? rs[j] : st;
            const int row = st + rel;
            if (F.lane == 0) ((int*)(ws + WS_RROW))[2 * t + k] = row;
            XS[(size_t)row * 64 + F.lane] = a;
        }
    }
}

__device__ __forceinline__ void cs_table(Frame& F, const int* pos) {
    float* cosT = (float*)(F.ws + WS_COS); float* sinT = (float*)(F.ws + WS_SIN);
    const int gt = F.vcu * NTHR + F.tid, NG = F.G * NTHR;
    for (int idx = gt; idx < M * 32; idx += NG) {
        const int row = idx >> 5, i = idx & 31;
        const float inv = powf(10000.0f, -(float)i / 32.0f);
        const float ang = (float)pos[row] * inv;
        cosT[idx] = cosf(ang); sinT[idx] = sinf(ang);
    }
}

__device__ __forceinline__ void ret_state(Frame& F) {
    unsigned char* ws = F.ws;
    const bf16* KB = (const bf16*)(ws + WS_ACT + A_KB); const bf16* VB = (const bf16*)(ws + WS_ACT + A_VB); bf16* PT = (bf16*)(ws + WS_ACT + A_PT);
    const int tid = F.tid, lane = F.lane, wid = F.wave, et = wid >> 2, dt = wid & 3, fr = lane & 15, fq = lane >> 4;
    for (int it = F.vcu; it < 256; it += F.G) {
        const int b = it >> 5, h = (it >> 2) & 7, eq = it & 3;
        const float l2g = log2f(1.f - exp2f(-5.f - (float)h));
        const int j = tid & 127, pp = tid >> 7;
        const float kdec = exp2f((float)(127 - j) * l2g), cd = exp2f(128.f * l2g);
        const bf16* kp = KB + ((size_t)b * SEQ + j) * 512 + h * 64 + pp * 8;
        const bf16* vp = VB + ((size_t)b * SEQ + j) * 1024 + h * 128 + eq * 32 + pp * 8;
        f32x4 acc = {0.f, 0.f, 0.f, 0.f};
        v4u k0 = *(const v4u*)kp, k1 = *(const v4u*)(kp + 32), vv = *(const v4u*)vp;
        for (int n = 0; n < 32; ++n) {
            LAS bf16* KT = (LAS bf16*)(F.lds + (n & 1) * 26112); LAS bf16* VT = KT + 64 * 136;
#pragma unroll
            for (int i = 0; i < 4; ++i) { const unsigned a = k0[i], c = k1[i], d = vv[i];
                KT[(pp * 8 + 2 * i) * 136 + j] = (bf16)f2bf(bflo(a) * kdec); KT[(pp * 8 + 2 * i + 1) * 136 + j] = (bf16)f2bf(bfhi(a) * kdec);
                KT[(pp * 8 + 32 + 2 * i) * 136 + j] = (bf16)f2bf(bflo(c) * kdec); KT[(pp * 8 + 33 + 2 * i) * 136 + j] = (bf16)f2bf(bfhi(c) * kdec);
                VT[(pp * 8 + 2 * i) * 136 + j] = (bf16)(d & 0xffffu); VT[(pp * 8 + 2 * i + 1) * 136 + j] = (bf16)(d >> 16); }
            if (n + 1 < 32) { const size_t o = (size_t)(n + 1) * 128; k0 = *(const v4u*)(kp + o * 512); k1 = *(const v4u*)(kp + o * 512 + 32); vv = *(const v4u*)(vp + o * 1024); }
            __syncthreads();
            bf16* pt = PT + ((((size_t)b * 32 + n) * 8 + h) * 128 + eq * 32 + et * 16 + 4 * fq) * 64 + dt * 16 + fr;
#pragma unroll
            for (int q = 0; q < 4; ++q) pt[q * 64] = (bf16)f2bf(acc[q]);
            acc = acc * cd;
#pragma unroll
            for (int ks = 0; ks < 4; ++ks) {
                const bf16x8 a = *(const LAS bf16x8*)(VT + (et * 16 + fr) * 136 + ks * 32 + 8 * fq);
                const bf16x8 bb = *(const LAS bf16x8*)(KT + (dt * 16 + fr) * 136 + ks * 32 + 8 * fq);
                acc = __builtin_amdgcn_mfma_f32_16x16x32_bf16(a, bb, acc, 0, 0, 0);
            }
        }
        __syncthreads();
    }
}
template <bool FULL>
__device__ __forceinline__ void ret_out(Frame& F, const float* rng) {
    unsigned char* ws = F.ws;
    const bf16* QB = (const bf16*)(ws + WS_ACT + A_QB); const bf16* KB = (const bf16*)(ws + WS_ACT + A_KB); const bf16* VB = (const bf16*)(ws + WS_ACT + A_VB);
    const bf16* GB = (const bf16*)(ws + WS_ACT + A_GB); const bf16* PT = (const bf16*)(ws + WS_ACT + A_PT); bf16* OB = (bf16*)(ws + WS_ACT + A_OB);
    LAS bf16* Qs = (LAS bf16*)F.lds; LAS bf16* Ks = Qs + 128 * 72; LAS bf16* Ps = Ks + 128 * 72; LAS bf16* VT = Ps + 128 * 72; LAS bf16* Ss = VT + 128 * 136;
    const int tid = F.tid, lane = F.lane, wid = F.wave, fr = lane & 15, fq = lane >> 4;
    const int il = 16 * wid + fr;
    int u = F.vcu; if (u >= 2048) return;
    v4u rq[2], rk[2], rp[2], rv[4];
#define RET_LOAD(uu) do { const int b_ = (uu) >> 8, n_ = ((uu) >> 3) & 31, h_ = (uu) & 7; const size_t t0_ = (size_t)b_ * SEQ + n_ * 128; \
        _Pragma("unroll") for (int i = 0; i < 2; ++i) { const int p = tid + 512 * i, r = p >> 3, c = p & 7; \
            rq[i] = *(const v4u*)(QB + (t0_ + r) * 512 + h_ * 64 + c * 8); rk[i] = *(const v4u*)(KB + (t0_ + r) * 512 + h_ * 64 + c * 8); \
            rp[i] = *(const v4u*)(PT + ((((size_t)b_ * 32 + n_) * 8 + h_) * 128 + r) * 64 + c * 8); } \
        _Pragma("unroll") for (int i = 0; i < 4; ++i) { const int p = tid + 512 * i, ep = p >> 7, j = p & 127; rv[i] = *(const v4u*)(VB + (t0_ + j) * 1024 + h_ * 128 + ep * 8); } } while (0)
    RET_LOAD(u);
    for (;;) {
        const int b = u >> 8, n = (u >> 3) & 31, h = u & 7;
        const float l2g = log2f(1.f - exp2f(-5.f - (float)h));
        const size_t tok0 = (size_t)b * SEQ + n * 128;
#pragma unroll
        for (int i = 0; i < 2; ++i) { const int p = tid + 512 * i, r = p >> 3, c = p & 7;
            *(LAS v4u*)(Qs + r * 72 + c * 8) = rq[i]; *(LAS v4u*)(Ks + r * 72 + c * 8) = rk[i]; *(LAS v4u*)(Ps + r * 72 + c * 8) = rp[i]; }
#pragma unroll
        for (int i = 0; i < 4; ++i) { const int p = tid + 512 * i, ep = p >> 7, j = p & 127;
#pragma unroll
            for (int q = 0; q < 4; ++q) { VT[(ep * 8 + 2 * q) * 136 + j] = (bf16)(rv[i][q] & 0xffffu); VT[(ep * 8 + 2 * q + 1) * 136 + j] = (bf16)(rv[i][q] >> 16); } }
        asm volatile("s_waitcnt lgkmcnt(0)\n\ts_barrier" ::: "memory");
        const int un = u + F.G;
        const size_t row = tok0 + il;
        v2u gbr[8]; f32x4 g4[8];
        if (FULL) {
#pragma unroll
        for (int et = 0; et < 8; ++et) { const int e = h * 128 + et * 16 + 4 * fq; gbr[et] = *(const v2u*)(GB + row * 1024 + e); g4[et] = *(const f32x4*)(rng + e); }
        }
        if (un < 2048) RET_LOAD(un);
        if (FULL) {
        bf16x8 qf[2];
#pragma unroll
        for (int ks = 0; ks < 2; ++ks) qf[ks] = *(const LAS bf16x8*)(Qs + il * 72 + ks * 32 + 8 * fq);
        const int nks = (wid >> 1) + 1;
#pragma unroll
        for (int jt = 0; jt < 8; ++jt) {
            if (jt <= wid) {
                f32x4 st = {0.f, 0.f, 0.f, 0.f};
#pragma unroll
                for (int ks = 0; ks < 2; ++ks) { const bf16x8 kf = *(const LAS bf16x8*)(Ks + (jt * 16 + fr) * 72 + ks * 32 + 8 * fq); st = __builtin_amdgcn_mfma_f32_16x16x32_bf16(kf, qf[ks], st, 0, 0, 0); }
                f32x4 o;
#pragma unroll
                for (int q = 0; q < 4; ++q) { const int jj = jt * 16 + 4 * fq + q; o[q] = (il >= jj) ? st[q] * exp2f((float)(il - jj) * l2g) : 0.f; }
                v2u w; w.x = pk2(o[0], o[1]); w.y = pk2(o[2], o[3]);
                *(LAS v2u*)(Ss + il * 136 + jt * 16 + 4 * fq) = w;
            } else if (jt < 2 * nks) { *(LAS v2u*)(Ss + il * 136 + jt * 16 + 4 * fq) = (v2u){0u, 0u}; }
        }
        LDS_WAIT();
        f32x4 acc[8];
        const float qd = exp2f((float)(il + 1) * l2g);
#pragma unroll
        for (int et = 0; et < 8; ++et) { f32x4 a = {0.f, 0.f, 0.f, 0.f};
#pragma unroll
            for (int ks = 0; ks < 2; ++ks) { const bf16x8 pf = *(const LAS bf16x8*)(Ps + (et * 16 + fr) * 72 + ks * 32 + 8 * fq); a = __builtin_amdgcn_mfma_f32_16x16x32_bf16(pf, qf[ks], a, 0, 0, 0); }
            acc[et] = a * qd; }
#pragma unroll
        for (int ks = 0; ks < 4; ++ks) { if (ks < nks) { const bf16x8 sf = *(const LAS bf16x8*)(Ss + il * 136 + ks * 32 + 8 * fq);
#pragma unroll
            for (int et = 0; et < 8; ++et) { const bf16x8 vf = *(const LAS bf16x8*)(VT + (et * 16 + fr) * 136 + ks * 32 + 8 * fq); acc[et] = __builtin_amdgcn_mfma_f32_16x16x32_bf16(vf, sf, acc[et], 0, 0, 0); } } }
        float ss = 0.f;
#pragma unroll
        for (int et = 0; et < 8; ++et) ss += (acc[et][0] * acc[et][0] + acc[et][1] * acc[et][1]) + (acc[et][2] * acc[et][2] + acc[et][3] * acc[et][3]);
        ss += shx(ss, 16, lane); ss += shx(ss, 32, lane);
        const float rn = 1.f / sqrtf(ss * (1.f / 128.f) + RMS_EPS);
#pragma unroll
        for (int et = 0; et < 8; ++et) { const int e = h * 128 + et * 16 + 4 * fq;
            const f32x4 gg = {bflo(gbr[et].x), bfhi(gbr[et].x), bflo(gbr[et].y), bfhi(gbr[et].y)};
            const f32x4 o = acc[et] * rn * g4[et] * (f32x4){gg[0] * fsigmoid(gg[0]), gg[1] * fsigmoid(gg[1]), gg[2] * fsigmoid(gg[2]), gg[3] * fsigmoid(gg[3])};
            v2u w; w.x = pk2(o[0], o[1]); w.y = pk2(o[2], o[3]); *(v2u*)(OB + row * 1024 + e) = w; }
        }
        asm volatile("s_waitcnt lgkmcnt(0)\n\ts_barrier" ::: "memory");
        if (un >= 2048) break;
        u = un;
    }
#undef RET_LOAD
}

#ifdef RETCHK
__device__ __forceinline__ int qerr(float e) { return e > 0.25f ? 0 : e > 0.03f ? 1 : e > 0.004f ? 2 : e > 0.0005f ? 3 : 4; }
__device__ __forceinline__ void ret_check(Frame& F, const float* const* in, const float* rng) {
    if (blockIdx.x != 0) return;
    unsigned char* ws = F.ws;
    const bf16* QB = (const bf16*)(ws + WS_ACT + A_QB); const bf16* KB = (const bf16*)(ws + WS_ACT + A_KB); const bf16* VB = (const bf16*)(ws + WS_ACT + A_VB);
    const bf16* GB = (const bf16*)(ws + WS_ACT + A_GB); const bf16* PT = (const bf16*)(ws + WS_ACT + A_PT); const bf16* OB = (const bf16*)(ws + WS_ACT + A_OB);
    const int lane = F.lane;
    float w1 = 0.f, w2 = 0.f, w3 = 0.f;
    for (int p = F.wave; p < 64; p += 8) {
        const int ti = p >> 3, h = p & 7;
        const int row = ti == 0 ? 0 : ti == 1 ? 1 : ti == 2 ? 127 : ti == 3 ? 128 : ti == 4 ? 200 : ti == 5 ? 1000 : ti == 6 ? 4095 : 4096 + 2500;
        const int b = row / SEQ, t = row % SEQ, n = t >> 7, i = t & 127;
        const float l2g = log2f(1.f - exp2f(-5.f - (float)h));
        float q[64];
#pragma unroll
        for (int d = 0; d < 64; ++d) q[d] = bf2f(QB[(size_t)row * 512 + h * 64 + d]);
        float y0 = 0.f, y1 = 0.f, yi0 = 0.f, yi1 = 0.f;
        for (int s = 0; s <= t; ++s) {
            const bf16* kr = KB + ((size_t)b * SEQ + s) * 512 + h * 64; float dot = 0.f;
#pragma unroll
            for (int d = 0; d < 64; ++d) dot += q[d] * bf2f(kr[d]);
            const float w = dot * exp2f((float)(t - s) * l2g);
            const float v0 = bf2f(VB[((size_t)b * SEQ + s) * 1024 + h * 128 + 2 * lane]), v1 = bf2f(VB[((size_t)b * SEQ + s) * 1024 + h * 128 + 2 * lane + 1]);
            y0 += w * v0; y1 += w * v1; if (s >= n * 128) { yi0 += w * v0; yi1 += w * v1; }
        }
        const bf16* pt = PT + ((((size_t)b * 32 + n) * 8 + h) * 128 + 2 * lane) * 64; float c0 = 0.f, c1 = 0.f;
#pragma unroll
        for (int d = 0; d < 64; ++d) { c0 += q[d] * bf2f(pt[d]); c1 += q[d] * bf2f(pt[64 + d]); }
        const float qd = exp2f((float)(i + 1) * l2g);
        const float z0 = yi0 + qd * c0, z1 = yi1 + qd * c1;
        const float ms = wave_sum(y0 * y0 + y1 * y1, lane) * (1.f / 128.f), rms = sqrtf(ms) + 1e-20f;
        float e1 = fmaxf(fabsf(z0 - y0), fabsf(z1 - y1)) / rms;
#pragma unroll
        for (int o = 1; o < 64; o <<= 1) e1 = fmaxf(e1, shx(e1, o, lane));
        w1 = fmaxf(w1, e1);
        const float rn = 1.f / sqrtf(ms + RMS_EPS); const int e = h * 128 + 2 * lane;
        const float o0 = y0 * rn * rng[e] * bf2f(GB[(size_t)row * 1024 + e]), o1 = y1 * rn * rng[e + 1] * bf2f(GB[(size_t)row * 1024 + e + 1]);
        const float os = sqrtf(wave_sum(o0 * o0 + o1 * o1, lane) * (1.f / 128.f)) + 1e-20f;
        float e2 = fmaxf(fabsf(o0 - bf2f(OB[(size_t)row * 1024 + e])), fabsf(o1 - bf2f(OB[(size_t)row * 1024 + e + 1]))) / os;
#pragma unroll
        for (int o = 1; o < 64; o <<= 1) e2 = fmaxf(e2, shx(e2, o, lane));
        w2 = fmaxf(w2, e2);
    }
    {
        const int sel = (lane >> 1) & 3; const int cc = (3 + 37 * (lane >> 3) + F.wave * 101) % 1024;
        const int r = (sel == 0 ? 2560 : sel == 1 ? 4608 : sel == 2 ? 5632 : 3584) + cc; const int rho = r & 31; const int col = r - rho + 8 + pg8::perm32(rho);
        const bf16* WT = (const bf16*)(ws + WS_WIN); const float* W = in[2];
        float e3 = 0.f;
        for (int kk = 0; kk < 16; ++kk) { const int k = kk * 64 + ((lane & 1) * 32 + (lane >> 3) * 3 + F.wave) % 64; e3 += fabsf(bf2f(WT[(size_t)r * D + k]) - W[(size_t)k * INC + col]); }
        e3 *= (1.f / 16.f) * 30.f;
        e3 += shx(e3, 1, lane); e3 += shx(e3, 8, lane); e3 += shx(e3, 16, lane); e3 += shx(e3, 32, lane);
        w3 = e3 * (1.f / 16.f);
    }
    LAS float* red = (LAS float*)F.lds;
    if (lane == 0 || lane == 2 || lane == 4 || lane == 6) red[F.wave * 4 + (lane >> 1)] = w3;
    __syncthreads();
    if (F.tid == 0) { float s[4] = {0.f, 0.f, 0.f, 0.f}; for (int w = 0; w < 8; ++w) { s[0] += red[w * 4] * 0.125f; s[1] += red[w * 4 + 1] * 0.125f; s[2] += red[w * 4 + 2] * 0.125f; s[3] += red[w * 4 + 3] * 0.125f; }
        ((float*)F.ctl)[200] = 1000.f * (1.f + floorf(100.f * s[CHKSEL] + 0.5f)); }
    __syncthreads();
}
#endif
#define XB_TMO      128
#define XB_XCNT(j)  (256  + 64 * (j))
#define XB_XSUB(j)  (1280 + 64 * (j))
#define XB_XGEN(j)  (2304 + 64 * (j))
#define XB_TOP      3328
#define XB_TOPGEN   3392
#define XCD_BAR_WORDS 3456
#define XB_SPIN_CAP (1u << 18)

__device__ __forceinline__ unsigned xb_ld(unsigned* p)              { return __hip_atomic_load(p, __ATOMIC_RELAXED, __HIP_MEMORY_SCOPE_AGENT); }
__device__ __forceinline__ unsigned xb_add(unsigned* p, unsigned v) { return __hip_atomic_fetch_add(p, v, __ATOMIC_RELAXED, __HIP_MEMORY_SCOPE_AGENT); }
__device__ __forceinline__ unsigned xb_xcc_id() { return (unsigned)__builtin_amdgcn_s_getreg((3 << 11) | 20) & 0xFu; }
#define XB_SPIN(cond, bar) do { unsigned _sp = 0; while (cond) { __builtin_amdgcn_s_sleep(1); \
    if ((++_sp & 255u) == 0u) { if (xb_ld(&(bar)[XB_TMO])) break; if (_sp > XB_SPIN_CAP) { atomicAdd(&(bar)[XB_TMO], 1u); break; } } } } while (0)

struct XcdBarrier {
    unsigned* bar; unsigned x;
    volatile LAS unsigned* st;
};

__device__ __forceinline__ XcdBarrier xcd_barrier_post(unsigned* bar, volatile LAS unsigned* st) {
    XcdBarrier b; b.bar = bar; b.x = xb_xcc_id(); b.st = st;
    if (threadIdx.x == 0) (void)xb_add(&bar[XB_XCNT(b.x)], 1u);
    return b;
}
__device__ __forceinline__ void xcd_barrier_complete(unsigned* bar, unsigned x, unsigned& nloc, unsigned& nx) {
    const unsigned G = gridDim.x * gridDim.y * gridDim.z;
    unsigned sum, cnt, mine, sp = 0u;
    for (;;) {
        sum = 0u; cnt = 0u; mine = 0u;
#pragma unroll
        for (unsigned j = 0; j < 16; ++j) { const unsigned c = xb_ld(&bar[XB_XCNT(j)]); sum += c; cnt += (c > 0u) ? 1u : 0u; mine = (j == x) ? c : mine; }
        if (sum == G) break;
        __builtin_amdgcn_s_sleep(1);
        if ((++sp & 255u) == 0u) { if (xb_ld(&bar[XB_TMO])) break; if (sp > XB_SPIN_CAP) { atomicAdd(&bar[XB_TMO], 1u); break; } }
    }
    nloc = mine > 0u ? mine : 1u; nx = cnt > 0u ? cnt : 1u;
}

__device__ __forceinline__ void xcd_barrier(const XcdBarrier& b) {
    asm volatile("s_waitcnt vmcnt(0)" ::: "memory");
    __syncthreads();
    if (threadIdx.x == 0) {
        unsigned* bar = b.bar; asm volatile("" : "+s"(bar));
        __builtin_amdgcn_s_waitcnt(0);
        const unsigned bx_ = (unsigned)__builtin_amdgcn_readfirstlane((int)b.x);
        unsigned nloc = b.st[0], nx = b.st[1];
        if (nloc == 0u) { xcd_barrier_complete(bar, bx_, nloc, nx); b.st[0] = nloc; b.st[1] = nx; }
        const unsigned old = xb_add(&bar[XB_XSUB(bx_)], 1u);
        const unsigned gen = old / nloc;
        if (old + 1u == (gen + 1u) * nloc) {
            __builtin_amdgcn_fence(__ATOMIC_RELEASE, "agent");
            asm volatile("s_waitcnt vmcnt(0)" ::: "memory");
            const unsigned og = xb_add(&bar[XB_TOP], 1u);
            const unsigned tg = og / nx;
            if (og + 1u == (tg + 1u) * nx) xb_add(&bar[XB_TOPGEN], 1u);
            else XB_SPIN(xb_ld(&bar[XB_TOPGEN]) == tg, bar);
            __builtin_amdgcn_fence(__ATOMIC_ACQUIRE, "agent");
            xb_add(&bar[XB_XGEN(bx_)], 1u);
            asm volatile("s_waitcnt vmcnt(0)" ::: "memory");
        } else {
            XB_SPIN(xb_ld(&bar[XB_XGEN(bx_)]) == gen, bar);
            __builtin_amdgcn_fence(__ATOMIC_ACQUIRE, "agent");
            asm volatile("s_waitcnt vmcnt(0)" ::: "memory");
        }
    }
    __syncthreads();
}

#ifndef PHM
#define PHM 0xffff
#endif
#ifndef ZH
#define ZH 0
#endif
#ifndef ZB
#define ZB 0
#endif
#ifndef DUP
#define DUP 0
#endif
struct Args { const float* in[19]; float* out; unsigned char* ws; };
__global__ void __launch_bounds__(NTHR, 2) mega_fwd(Args args) {
    extern __shared__ __attribute__((aligned(16))) unsigned char lds[];
    cg::grid_group grid = cg::this_grid();
    Frame F;
    F.lds = (LAS unsigned char*)lds; F.ws = args.ws; F.ctl = (unsigned*)(args.ws + WS_CTL);
    F.tid = threadIdx.x; F.lane = F.tid & 63; F.wave = __builtin_amdgcn_readfirstlane(F.tid >> 6);
    F.cofs = 64; F.trow = 1 << 30; F.G = gridDim.x; { const int bx = blockIdx.x; F.vcu = (F.G % 8 == 0) ? (bx % 8) * (F.G / 8) + bx / 8 : bx; }
    unsigned char* ws = args.ws; unsigned char* act = ws + WS_ACT;
    volatile LAS unsigned* xst = (volatile LAS unsigned*)(F.lds + 131072 + 512);
    if (F.tid < 2) xst[F.tid] = 0u;
    __syncthreads();
    const float* const* in = args.in;
    float* X = args.out;
    bf16* XB = (bf16*)(ws + WS_XB); bf16* HB = (bf16*)(ws + WS_HB);
    typedef pg8::StaticOrder SO;
#define GSYNC0() do { asm volatile("s_waitcnt vmcnt(0) lgkmcnt(0)" ::: "memory"); grid.sync(); __builtin_amdgcn_fence(__ATOMIC_ACQUIRE, "agent"); asm volatile("s_waitcnt vmcnt(0)" ::: "memory"); } while (0)
#define GSYNC() xcd_barrier(xbar)
#define OPQ() do { asm volatile("" : "+s"(F.wave), "+s"(F.vcu), "+s"(ws), "+s"(act)); F.ws = ws; F.lane = pg8::lane_id_opaque(); F.tid = F.wave * 64 + F.lane; } while (0)
#define GEMM(EpiT, OrdT, g, S, E) pg8::gemm_phase<EpiT, OrdT, true, true>(F.lds, g, S, E, F.wave)
#define GEMM8(EpiT, OrdT, g, S, E) pg8::gemm_phase<EpiT, OrdT, true, true, true>(F.lds, g, S, E, F.wave)

    if (blockIdx.x == 0) { for (int i_ = F.tid; i_ < 8192; i_ += NTHR) F.ctl[i_] = 0u; }
    GSYNC0();
    const XcdBarrier xbar = xcd_barrier_post(F.ctl + 4096, xst);
    if (PHM & 1) cs_table(F, (const int*)in[1]);
    if (PHM & 2) row_pass<0, 1>(F, in[0], X, nullptr, nullptr, in[2] + 1536, INC, in[3]);
    if (PHM & 4) conv_layer(F, in, 0, 0);
    GSYNC();

#pragma unroll 1
    for (int l = 0; l < DEPTH; ++l) {
        const int fi = l >> 1; const bool moe = (l & 1) != 0; F.cofs = 64 + 16 * fi; OPQ();
        if (DUP & 32) { for (int k_ = 0; k_ < 10; ++k_) { GSYNC(); } }
        if (PHM & 8) { pg8::Gemm g{XB, (const bf16*)(ws + WS_WIN), M, NPROJ, D}; SO S; S.init(M, NPROJ, F.G, (int)blockIdx.x);
          epi::EpiInProj E{act, (const float*)(ws + WS_COS), (const float*)(ws + WS_SIN)};
          GEMM(epi::EpiInProj, SO, g, S, E); if (DUP & 16) { OPQ(); GEMM(epi::EpiInProj, SO, g, S, E); } }
        GSYNC(); OPQ();
        if (PHM & 16) ret_state(F);
        if (DUP & 2) { OPQ(); ret_state(F); }
        OPQ();
        if (PHM & 32) { const attn_body::AttnTensors AT{(const attn_body::bf16*)(act + A_QA), (const attn_body::bf16*)(act + A_KA), (const attn_body::bf16*)(act + A_VA), (attn_body::bf16*)(act + A_QA), (const float*)(ws + WS_FLOG)};
          const attn_body::StaticOrder S((int)F.G, (int)blockIdx.x);
          attn_body::attn_phase<attn_body::StaticOrder>((char*)lds, AT, S, F.wave); }
        GSYNC(); OPQ();
        if (PHM & 64) ret_out<true>(F, in[4] + (size_t)l * 1024);
        if (DUP & 4) { OPQ(); ret_out<true>(F, in[4] + (size_t)l * 1024); }
        if (DUP & 64) { OPQ(); ret_out<false>(F, in[4] + (size_t)l * 1024); }
        GSYNC(); OPQ();
#ifdef RETCHK
        if (l == 0) { ret_check(F, in, in[4]); OPQ(); }
#endif
        if (PHM & 128) { pg8::Gemm g{(const bf16*)(act + A_QA), (const bf16*)(ws + WS_WBF), M, D, 512}; SO S; S.init(M, D, F.G, (int)blockIdx.x);
          epi::EpiGated E{(bf16*)(act + A_T1), D, (const bf16*)(act + A_GATE), 2048, nullptr, (ZB & 1) ? 0.f : 1.f};
          GEMM(epi::EpiGated, SO, g, S, E); }
        OPQ();
        if (PHM & 128) { pg8::Gemm g{(const bf16*)(act + A_OB), (const bf16*)(ws + WS_WBR), M, D, D}; SO S; S.init(M, D, F.G, (int)blockIdx.x);
          epi::EpiGated E{(bf16*)(act + A_T1), D, (const bf16*)(act + A_GATE) + 1024, 2048, (const bf16*)(act + A_T1), (ZB & 2) ? 0.f : 1.f};
          GEMM(epi::EpiGated, SO, g, S, E); }
        GSYNC(); OPQ();
        if (PHM & 128) { pg8::Gemm g{(const bf16*)(act + A_T1), (const bf16*)(ws + WS_WOUT), M, D, D}; SO S; S.init(M, D, F.G, (int)blockIdx.x);
          epi::EpiGated E{HB, D, nullptr, 0, nullptr, 1.f};
          GEMM(epi::EpiGated, SO, g, S, E); if (DUP & 128) { OPQ(); GEMM(epi::EpiGated, SO, g, S, E); } }
        GSYNC(); OPQ();
        if (!(PHM & 256)) {} else if (moe) row_pass<(ZH & 1) ? 3 : 1, 2>(F, X, X, in[8] + (size_t)l * D, in[9] + (size_t)l * D, in[13] + (size_t)fi * D * NEXP, NEXP, nullptr);
        else row_pass<(ZH & 1) ? 3 : 1, 3>(F, l == 0 ? in[0] : (const float*)X, X, in[8] + (size_t)l * D, in[9] + (size_t)l * D, nullptr, 0, nullptr);
        OPQ();
        if ((PHM & 4) && !moe) conv_layer(F, in, l, 1);
        GSYNC(); OPQ();
#ifdef ONLYMOE
        if (!moe) {} else
#endif
        if (!(PHM & 512)) {} else if (!moe) {
            { pg8::Gemm g{(const bf16*)(act + A_XB8), (const bf16*)(ws + WS_WFF), M, 2 * DFF, D / 2, 0}; SO S; S.init(M, 2 * DFF, F.G, (int)blockIdx.x);
              epi::EpiSwiGLU8 E{(unsigned char*)(act + A_H), DFF, 1.f / F8_SW1, F8_SH};
              GEMM8(epi::EpiSwiGLU8, SO, g, S, E); }
            GSYNC(); OPQ();
            { pg8::Gemm g{(const bf16*)(act + A_H), (const bf16*)(ws + WS_WFF + 12 * MiB), M, D, DFF / 2, 0}; SO S; S.init(M, D, F.G, (int)blockIdx.x);
              epi::EpiGated E{HB, D, nullptr, 0, nullptr, 1.f / (F8_SH * F8_SW2)};
              GEMM8(epi::EpiGated, SO, g, S, E); }
            GSYNC(); OPQ();
            row_pass<(ZH & 2) ? 3 : 1, 1>(F, X, X, in[17] + (size_t)l * D, in[18] + (size_t)l * D, in[2] + (size_t)(l + 1) * D * INC + 1536, INC, in[3] + (l + 1) * 8);
        } else {
            moe_gather(F);
            OPQ();
            if (PHM & 4) conv_layer(F, in, l, 1);
            GSYNC(); OPQ();
            { epi::MoeOrder S; moe_starts(F, S.ts);
#pragma unroll
              for (int e = 0; e < 9; ++e) S.ts[e] >>= 8;
              S.NT = 2 * DFE / 256; S.G = F.G; S.c = (int)blockIdx.x; S.lim = S.ts[8] * S.NT; S.rev = 0;
              pg8::Gemm g{(const bf16*)(act + A_XS), (const bf16*)(ws + WS_WFF), XS_ROWS, 2 * DFE, D / 2, 0};
              epi::EpiSwiGLU8 E{(unsigned char*)(act + A_HS), DFE, 1.f / F8_SW1, F8_SH};
              GEMM8(epi::EpiSwiGLU8, epi::MoeOrder, g, S, E); if (DUP & 8) { OPQ(); GEMM8(epi::EpiSwiGLU8, epi::MoeOrder, g, S, E); } }
            GSYNC(); OPQ();
            { epi::MoeOrder S; moe_starts(F, S.ts);
#pragma unroll
              for (int e = 0; e < 9; ++e) S.ts[e] >>= 8;
              S.NT = D / 256; S.G = F.G; S.c = (int)blockIdx.x; S.rev = 1;
              S.lim = S.ts[8] * 4;
              pg8::Gemm g{(const bf16*)(act + A_HS), (const bf16*)(ws + WS_WFF + 56 * MiB), XS_ROWS, D, DFE / 2, 0};
              epi::EpiGated E{(bf16*)(act + A_XS), D, nullptr, 0, nullptr, 1.f / (F8_SH * F8_SW2)};
              GEMM8(epi::EpiGated, epi::MoeOrder, g, S, E);
              F.trow = 1 << 30; }
            GSYNC(); OPQ();
            if (l + 1 < DEPTH) row_pass<(ZH & 4) ? 3 : 2, 1>(F, X, X, in[17] + (size_t)l * D, in[18] + (size_t)l * D, in[2] + (size_t)(l + 1) * D * INC + 1536, INC, in[3] + (l + 1) * 8);
            else row_pass<(ZH & 4) ? 3 : 2, 0>(F, X, X, in[17] + (size_t)l * D, in[18] + (size_t)l * D, nullptr, 0, nullptr);
        }
        if (l + 1 < DEPTH) { if (PHM & 4) conv_layer(F, in, l + 1, 0); GSYNC(); }
    }
#ifdef RETCHK
    GSYNC();
    if (blockIdx.x == 0 && F.tid == 0) { X[0] = ((float*)F.ctl)[200]; }
#endif
#undef GEMM
}

constexpr int LDS_DYN = 147456;
extern "C" void kernel_launch(void* const* d_in, const int* in_sizes, int n_in, void* d_out, int out_size, void* d_ws, size_t ws_size, hipStream_t stream) {
    static int grid = 0;
    if (grid == 0) {
        if (n_in != 19 || out_size != M * D || ws_size < WS_END) { fprintf(stderr, "kernel_launch: bad shapes (n_in %d out %d ws %zu need %zu)\n", n_in, out_size, ws_size, (size_t)WS_END); grid = -1; return; }
        int dev = 0, cus = 0, per_cu = 0;
        hipGetDevice(&dev); hipDeviceGetAttribute(&cus, hipDeviceAttributeMultiprocessorCount, dev);
        if (hipFuncSetAttribute((const void*)mega_fwd, hipFuncAttributeMaxDynamicSharedMemorySize, LDS_DYN) != hipSuccess) { fprintf(stderr, "kernel_launch: hipFuncSetAttribute failed\n"); grid = -1; return; }
        if (hipOccupancyMaxActiveBlocksPerMultiprocessor(&per_cu, (const void*)mega_fwd, NTHR, LDS_DYN) != hipSuccess || per_cu < 1) { fprintf(stderr, "kernel_launch: occupancy query says %d\n", per_cu); per_cu = 1; }
        (void)hipGetLastError();
        grid = cus * per_cu;
        fprintf(stderr, "kernel_launch: grid %d (cus %d x %d)\n", grid, cus, per_cu);
    }
    if (grid < 0) return;
    (void)hipMemsetAsync((char*)d_ws + WS_CTL, 0, 65536, stream);
    Args a{};
    for (int i = 0; i < 19; ++i) a.in[i] = (const float*)d_in[i];
    a.out = (float*)d_out; a.ws = (unsigned char*)d_ws;
    void* kargs[] = {&a};
    const hipError_t e = hipLaunchCooperativeKernel((const void*)mega_fwd, dim3(grid), dim3(NTHR), kargs, LDS_DYN, stream);
    if (e != hipSuccess) fprintf(stderr, "kernel_launch: cooperative launch failed: %s (grid %d)\n", hipGetErrorString(e), grid);
}
```
